# Optimizing an MI355X kernel written in HIP

```python
import math
import jax, jax.numpy as jnp
from jax import lax
import numpy as np

D_MODEL = 1024
BATCH = 2
SEQ = 8192
DEPTH = 2

HEAD_DIM = 64
N_MIX_HEADS = D_MODEL // HEAD_DIM
MIX_WIDTH = N_MIX_HEADS * HEAD_DIM
FOX_HEADS = N_MIX_HEADS // 4
NSA_HEADS = N_MIX_HEADS // 2
DIFF_HEADS = N_MIX_HEADS - FOX_HEADS - NSA_HEADS
FOX_W = FOX_HEADS * HEAD_DIM
NSA_W = NSA_HEADS * HEAD_DIM
DIFF_QK_DIM = HEAD_DIM // 2
DIFF_V_DIM = HEAD_DIM
DIFF_W = DIFF_HEADS * DIFF_V_DIM
NSA_KV_GROUPS = 2
NSA_HPG = NSA_HEADS // NSA_KV_GROUPS
NSA_KV_W = NSA_KV_GROUPS * HEAD_DIM
CMP_LEN = 32
CMP_STRIDE = 16
CMP_HIDDEN = 2 * HEAD_DIM
SEL_BLOCK = 64
SEL_TOPK = 16
WINDOW = 512
Q_BLOCK = 128
ROPE_THETA = 10000.0
LN_EPS = 1e-5
RMS_EPS = 1e-5
NEG_INF = -1e30
FORCE_SCORE = 1e30
DEEPNORM_ALPHA = (2 * DEPTH) ** 0.25
DEEPNORM_BETA = (8 * DEPTH) ** -0.25

SPLITS = (
    ('fox_q', FOX_W, False), ('fox_k', FOX_W, False), ('fox_v', FOX_W, True),
    ('fox_f', FOX_HEADS, False), ('fox_z', FOX_W, False),
    ('nsa_q', NSA_W, False),
    ('nsa_k_cmp', NSA_KV_W, False), ('nsa_v_cmp', NSA_KV_W, True),
    ('nsa_k_sel', NSA_KV_W, False), ('nsa_v_sel', NSA_KV_W, True),
    ('nsa_k_win', NSA_KV_W, False), ('nsa_v_win', NSA_KV_W, True),
    ('nsa_gate', 3 * NSA_HEADS, False), ('nsa_z', NSA_W, False),
    ('diff_q', DIFF_HEADS * 2 * DIFF_QK_DIM, False), ('diff_k', DIFF_HEADS * 2 * DIFF_QK_DIM, False),
    ('diff_v', DIFF_W, True), ('diff_z', DIFF_W, False),
)
IN_WIDTH = sum(w for _, w, _ in SPLITS)

kernel_name = 'hymba_fox_nsa_diff_deepnorm'


def split_columns(proj):
    offsets, acc = [], 0
    for _, w, _ in SPLITS[:-1]:
        acc += w
        offsets.append(acc)
    parts = jnp.split(proj, offsets, axis=-1)
    return {name: part for (name, _, _), part in zip(SPLITS, parts)}


def masked_softmax(logits, mask):
    logits = jnp.where(mask, logits.astype(jnp.float32), NEG_INF)
    return jax.nn.softmax(logits, axis=-1) * mask


def rope(x):
    S, d = x.shape[1], x.shape[-1]
    half = d // 2
    inv = ROPE_THETA ** (-(jnp.arange(half, dtype=jnp.float32) * 2.0 / d))
    ang = jnp.arange(S, dtype=jnp.float32)[:, None] * inv[None, :]
    shape = (1, S) + (1,) * (x.ndim - 3) + (half,)
    cos, sin = jnp.cos(ang).reshape(shape), jnp.sin(ang).reshape(shape)
    x1 = x[..., :half].astype(jnp.float32)
    x2 = x[..., half:].astype(jnp.float32)
    return jnp.concatenate([x1 * cos - x2 * sin, x2 * cos + x1 * sin], axis=-1).astype(x.dtype)


def layer_norm(x, g, b):
    xf = x.astype(jnp.float32)
    mu = jnp.mean(xf, axis=-1, keepdims=True)
    var = jnp.mean(jnp.square(xf - mu), axis=-1, keepdims=True)
    return ((xf - mu) * lax.rsqrt(var + LN_EPS) * g + b).astype(x.dtype)


def rms_norm(x, g):
    xf = x.astype(jnp.float32)
    return (xf * lax.rsqrt(jnp.mean(jnp.square(xf), axis=-1, keepdims=True) + RMS_EPS) * g).astype(x.dtype)


def fox_attention(q, k, v, log_f):
    B, H, S, dk = q.shape
    c = jnp.cumsum(log_f, axis=-1)
    scale = dk ** -0.5
    key_pos = jnp.arange(S)

    def block(i):
        s0 = i * Q_BLOCK
        t = s0 + jnp.arange(Q_BLOCK)
        qb = lax.dynamic_slice_in_dim(q, s0, Q_BLOCK, axis=2)
        cq = lax.dynamic_slice_in_dim(c, s0, Q_BLOCK, axis=2)
        logits = (jnp.einsum('bhqd,bhkd->bhqk', qb, k).astype(jnp.float32) * scale
                  + cq[..., None] - c[:, :, None, :])
        p = masked_softmax(logits, key_pos[None, :] <= t[:, None]).astype(v.dtype)
        return jnp.einsum('bhqk,bhkd->bhqd', p, v)

    out = lax.map(block, jnp.arange(S // Q_BLOCK))
    return out.transpose(1, 0, 3, 2, 4).reshape(B, S, H * dk)


def diff_attention(q, k, v, lam):
    B, H, _, S, dq = q.shape
    scale = dq ** -0.5
    key_pos = jnp.arange(S)

    def block(i):
        s0 = i * Q_BLOCK
        t = s0 + jnp.arange(Q_BLOCK)
        qb = lax.dynamic_slice_in_dim(q, s0, Q_BLOCK, axis=3)
        logits = jnp.einsum('bhcqd,bhckd->bhcqk', qb, k).astype(jnp.float32) * scale
        p = masked_softmax(logits, key_pos[None, :] <= t[:, None])
        a = (p[:, :, 0] - lam * p[:, :, 1]).astype(v.dtype)
        return jnp.einsum('bhqk,bhkd->bhqd', a, v)

    out = lax.map(block, jnp.arange(S // Q_BLOCK))
    return out.transpose(1, 0, 3, 2, 4).reshape(B, S, H, v.shape[-1])


def compress(tok, pos_emb, w1, w2):
    B, S, G, dk = tok.shape
    n_cmp = (S - CMP_LEN) // CMP_STRIDE + 1
    idx = CMP_STRIDE * jnp.arange(n_cmp)[:, None] + jnp.arange(CMP_LEN)[None, :]
    blocks = tok[:, idx] + pos_emb[None, None, :, None, :]
    blocks = blocks.transpose(0, 3, 1, 2, 4).reshape(B, G, n_cmp, CMP_LEN * dk)
    return jax.nn.silu(blocks @ w1) @ w2


def gather_blocks(blocks, idx):
    return jax.vmap(jax.vmap(lambda blk, ix: blk[ix]))(blocks, idx)


def nsa_attention(q, k_cmp, v_cmp, k_sel, v_sel, k_win, v_win, gates,
                  pos_k, pos_v, w1_k, w2_k, w1_v, w2_v):
    B, S, H, dk = q.shape
    G, hpg = NSA_KV_GROUPS, NSA_HPG
    scale = dk ** -0.5
    qg = q.reshape(B, S, G, hpg, dk).transpose(0, 2, 3, 1, 4)
    gg = gates.reshape(B, S, G, hpg, 3).transpose(0, 2, 3, 1, 4)
    kc = compress(k_cmp, pos_k, w1_k, w2_k)
    vc = compress(v_cmp, pos_v, w1_v, w2_v)
    n_cmp = kc.shape[2]
    cmp_start = CMP_STRIDE * jnp.arange(n_cmp)
    cmp_end = cmp_start + CMP_LEN - 1
    n_slc = S // SEL_BLOCK
    n_sel = min(SEL_TOPK, n_slc)
    ksb = k_sel.reshape(B, n_slc, SEL_BLOCK, G, dk).transpose(0, 3, 1, 2, 4)
    vsb = v_sel.reshape(B, n_slc, SEL_BLOCK, G, dk).transpose(0, 3, 1, 2, 4)
    sel_start = SEL_BLOCK * jnp.arange(n_slc)
    overlap = (jnp.clip(jnp.minimum(cmp_start[:, None] + CMP_LEN, sel_start[None, :] + SEL_BLOCK)
                        - jnp.maximum(cmp_start[:, None], sel_start[None, :]), 0)
               .astype(jnp.float32) / CMP_LEN)
    j = jnp.arange(n_slc)
    pad = ((0, 0), (0, 0), (WINDOW, 0), (0, 0))
    kwp = jnp.pad(k_win.transpose(0, 2, 1, 3), pad)
    vwp = jnp.pad(v_win.transpose(0, 2, 1, 3), pad)

    def block(i):
        s0 = i * Q_BLOCK
        t = s0 + jnp.arange(Q_BLOCK)
        qb = lax.dynamic_slice_in_dim(qg, s0, Q_BLOCK, axis=3)
        gb = lax.dynamic_slice_in_dim(gg, s0, Q_BLOCK, axis=3)
        s_c = jnp.einsum('bghqd,bgnd->bghqn', qb, kc).astype(jnp.float32) * scale
        p_c = masked_softmax(s_c, cmp_end[None, :] <= t[:, None])
        o_c = jnp.einsum('bghqn,bgnd->bghqd', p_c.astype(vc.dtype), vc)
        imp = jnp.einsum('bghqn,nj->bgqj', p_c, overlap)
        cur = t // SEL_BLOCK
        valid = j[None, :] * SEL_BLOCK <= t[:, None]
        forced = (j[None, :] == 0) | (j[None, :] == cur[:, None]) | (j[None, :] == cur[:, None] - 1)
        score = jnp.where(valid, jnp.where(forced, FORCE_SCORE, imp), NEG_INF)
        _, idx = lax.top_k(score, n_sel)
        ks = gather_blocks(ksb, idx)
        vs = gather_blocks(vsb, idx)
        tok_pos = idx[..., None] * SEL_BLOCK + jnp.arange(SEL_BLOCK)
        m_s = (tok_pos <= t[None, None, :, None, None]).reshape(B, G, 1, Q_BLOCK, n_sel * SEL_BLOCK)
        s_s = (jnp.einsum('bghqd,bgqnld->bghqnl', qb, ks).astype(jnp.float32)
               .reshape(B, G, hpg, Q_BLOCK, n_sel * SEL_BLOCK) * scale)
        p_s = masked_softmax(s_s, m_s)
        o_s = jnp.einsum('bghqm,bgqmd->bghqd', p_s.astype(vs.dtype),
                         vs.reshape(B, G, Q_BLOCK, n_sel * SEL_BLOCK, dk))
        kw = lax.dynamic_slice_in_dim(kwp, s0, Q_BLOCK + WINDOW, axis=2)
        vw = lax.dynamic_slice_in_dim(vwp, s0, Q_BLOCK + WINDOW, axis=2)
        kpos = s0 - WINDOW + jnp.arange(Q_BLOCK + WINDOW)
        m_w = ((kpos[None, :] <= t[:, None]) & (t[:, None] - kpos[None, :] < WINDOW)
               & (kpos[None, :] >= 0))
        s_w = jnp.einsum('bghqd,bgkd->bghqk', qb, kw).astype(jnp.float32) * scale
        p_w = masked_softmax(s_w, m_w)
        o_w = jnp.einsum('bghqk,bgkd->bghqd', p_w.astype(vw.dtype), vw)
        return gb[..., 0:1] * o_c + gb[..., 1:2] * o_s + gb[..., 2:3] * o_w

    out = lax.map(block, jnp.arange(S // Q_BLOCK))
    return out.transpose(1, 0, 4, 2, 3, 5).reshape(B, S, H * dk)


def setup_inputs(seed: int = 0) -> dict:
    key = jax.random.key(seed)
    ks = jax.random.split(key, 20)
    nrm = lambda k, shape: jax.random.normal(k, shape, jnp.float32)
    col_scale = np.concatenate([np.full((w,), DEEPNORM_BETA if is_v else 1.0, np.float32)
                                for _, w, is_v in SPLITS])
    x = nrm(ks[0], (BATCH, SEQ, D_MODEL))
    w_in = nrm(ks[1], (DEPTH, D_MODEL, IN_WIDTH)) * (D_MODEL ** -0.5) * jnp.asarray(col_scale)
    b_fox_f = 4.0 + 0.1 * nrm(ks[2], (DEPTH, FOX_HEADS))
    cmp_pos_k = 0.1 * nrm(ks[3], (DEPTH, CMP_LEN, HEAD_DIM))
    cmp_pos_v = 0.1 * nrm(ks[4], (DEPTH, CMP_LEN, HEAD_DIM))
    cmp_w1_k = nrm(ks[5], (DEPTH, CMP_LEN * HEAD_DIM, CMP_HIDDEN)) * (CMP_LEN * HEAD_DIM) ** -0.5
    cmp_w2_k = nrm(ks[6], (DEPTH, CMP_HIDDEN, HEAD_DIM)) * CMP_HIDDEN ** -0.5
    cmp_w1_v = nrm(ks[7], (DEPTH, CMP_LEN * HEAD_DIM, CMP_HIDDEN)) * (CMP_LEN * HEAD_DIM) ** -0.5
    cmp_w2_v = nrm(ks[8], (DEPTH, CMP_HIDDEN, HEAD_DIM)) * CMP_HIDDEN ** -0.5
    lam_q1 = 0.1 * nrm(ks[9], (DEPTH, DIFF_QK_DIM))
    lam_k1 = 0.1 * nrm(ks[10], (DEPTH, DIFF_QK_DIM))
    lam_q2 = 0.1 * nrm(ks[11], (DEPTH, DIFF_QK_DIM))
    lam_k2 = 0.1 * nrm(ks[12], (DEPTH, DIFF_QK_DIM))
    diff_subln_g = 1.0 + 0.02 * nrm(ks[13], (DEPTH, DIFF_V_DIM))
    w_out = nrm(ks[14], (DEPTH, MIX_WIDTH, D_MODEL)) * (MIX_WIDTH ** -0.5) * DEEPNORM_BETA
    ln_g = 1.0 + 0.02 * nrm(ks[15], (DEPTH, D_MODEL))
    ln_b = 0.02 * nrm(ks[16], (DEPTH, D_MODEL))
    return {'x': x, 'w_in': w_in, 'b_fox_f': b_fox_f, 'cmp_pos_k': cmp_pos_k, 'cmp_pos_v': cmp_pos_v,
            'cmp_w1_k': cmp_w1_k, 'cmp_w2_k': cmp_w2_k, 'cmp_w1_v': cmp_w1_v, 'cmp_w2_v': cmp_w2_v,
            'lam_q1': lam_q1, 'lam_k1': lam_k1, 'lam_q2': lam_q2, 'lam_k2': lam_k2,
            'diff_subln_g': diff_subln_g, 'w_out': w_out, 'ln_g': ln_g, 'ln_b': ln_b}


def reference(x, w_in, b_fox_f, cmp_pos_k, cmp_pos_v, cmp_w1_k, cmp_w2_k, cmp_w1_v, cmp_w2_v,
              lam_q1, lam_k1, lam_q2, lam_k2, diff_subln_g, w_out, ln_g, ln_b):
    B, S, _ = x.shape
    G = NSA_KV_GROUPS
    for l in range(DEPTH):
        p = split_columns(x @ w_in[l])
        heads_f = lambda a: a.reshape(B, S, FOX_HEADS, HEAD_DIM).transpose(0, 2, 1, 3)
        log_f = jax.nn.log_sigmoid((p['fox_f'] + b_fox_f[l]).astype(jnp.float32)).transpose(0, 2, 1)
        o_fox = fox_attention(heads_f(p['fox_q']), heads_f(p['fox_k']), heads_f(p['fox_v']), log_f)
        o_fox = o_fox * jax.nn.silu(p['fox_z'])
        kv = lambda a: a.reshape(B, S, G, HEAD_DIM)
        o_nsa = nsa_attention(
            rope(p['nsa_q'].reshape(B, S, NSA_HEADS, HEAD_DIM)),
            rope(kv(p['nsa_k_cmp'])), kv(p['nsa_v_cmp']),
            rope(kv(p['nsa_k_sel'])), kv(p['nsa_v_sel']),
            rope(kv(p['nsa_k_win'])), kv(p['nsa_v_win']),
            jax.nn.sigmoid(p['nsa_gate'].reshape(B, S, NSA_HEADS, 3)),
            cmp_pos_k[l], cmp_pos_v[l], cmp_w1_k[l], cmp_w2_k[l], cmp_w1_v[l], cmp_w2_v[l])
        o_nsa = o_nsa * jax.nn.silu(p['nsa_z'])
        qd = rope(p['diff_q'].reshape(B, S, DIFF_HEADS, 2, DIFF_QK_DIM)).transpose(0, 2, 3, 1, 4)
        kd = rope(p['diff_k'].reshape(B, S, DIFF_HEADS, 2, DIFF_QK_DIM)).transpose(0, 2, 3, 1, 4)
        vd = p['diff_v'].reshape(B, S, DIFF_HEADS, DIFF_V_DIM).transpose(0, 2, 1, 3)
        lam_init = 0.8 - 0.6 * math.exp(-0.3 * l)
        lam = (jnp.exp(jnp.sum(lam_q1[l].astype(jnp.float32) * lam_k1[l].astype(jnp.float32)))
               - jnp.exp(jnp.sum(lam_q2[l].astype(jnp.float32) * lam_k2[l].astype(jnp.float32))) + lam_init)
        od = rms_norm(diff_attention(qd, kd, vd, lam), diff_subln_g[l]) * (1.0 - lam_init)
        o_diff = od.reshape(B, S, DIFF_W) * jax.nn.silu(p['diff_z'])
        mix = jnp.concatenate([o_fox, o_nsa, o_diff], axis=-1) @ w_out[l]
        x = layer_norm(DEEPNORM_ALPHA * x + mix, ln_g[l], ln_b[l])
    return x
```

```cpp
#include <hip/hip_runtime.h>
#include <hip/hip_cooperative_groups.h>
#include <stdint.h>
#include <cstdio>
namespace cg = cooperative_groups;

#ifndef COOP
#define COOP 1
#endif
#ifndef REPEAT
#define REPEAT 0
#endif

#define DI __device__ __forceinline__
typedef unsigned short bf16_t;
typedef short bf16x8 __attribute__((ext_vector_type(8)));
typedef short s16x4 __attribute__((ext_vector_type(4)));
typedef float f32x16 __attribute__((ext_vector_type(16)));
typedef float f32x4 __attribute__((ext_vector_type(4)));
typedef float f32x2 __attribute__((ext_vector_type(2)));
typedef unsigned u32x4 __attribute__((ext_vector_type(4)));
typedef unsigned u32x2 __attribute__((ext_vector_type(2)));
typedef __bf16 bf16x2_t __attribute__((ext_vector_type(2)));

#define MFMA32(a, b, c) __builtin_amdgcn_mfma_f32_32x32x16_bf16((a), (b), (c), 0, 0, 0)

constexpr int BATCH = 2, SEQ = 8192, DMODEL = 1024, MTOK = BATCH * SEQ, NIN = 3868, NPAD = 3968, DEPTH = 2;
constexpr float LOG2E = 1.4426950408889634f;
constexpr float NEGBIG = -1e30f;
constexpr float MINIT = -1e20f;
constexpr int NTHREADS = 256;

constexpr size_t MiB = 1u << 20;
constexpr size_t OFF_CTR = 0, OFF_LAM = 4096, OFF_B1 = 8192, OFF_BAR = 16384, CTL_ZERO_BYTES = 32768;
constexpr size_t OFF_ROPE64 = 1 * MiB, OFF_ROPE32 = 3 * MiB, OFF_WIN = 4 * MiB, OFF_WOUT = 20 * MiB, OFF_W1T = 24 * MiB;
constexpr size_t OFF_XB = 26 * MiB, OFF_G = 58 * MiB, OFF_MIX = 90 * MiB;
constexpr size_t OFF_QF = 122 * MiB, OFF_KF = 130 * MiB, OFF_VFT = 138 * MiB, OFF_QN = 146 * MiB;
constexpr size_t OFF_KCT = 162 * MiB, OFF_VCT = 166 * MiB, OFF_KS = 170 * MiB, OFF_VST = 174 * MiB, OFF_KW = 178 * MiB, OFF_VWT = 182 * MiB;
constexpr size_t OFF_QD = 186 * MiB, OFF_KD = 194 * MiB, OFF_VDT = 202 * MiB;
constexpr size_t OFF_LOGF = 210 * MiB, OFF_CUM = 210 * MiB + 256 * 1024, OFF_GATES = 211 * MiB;
constexpr size_t OFF_KC = 213 * MiB, OFF_VCC = 213 * MiB + 256 * 1024, WS_NEED = 214 * MiB;

constexpr int LDS_BYTES = 73728, LDS_CTL = 32;
constexpr int ATT_BUF = 18944, ATT_V = 9216, ATT_C = 18432;
constexpr int LDS_IMP = 3 * ATT_BUF, LDS_SEL = LDS_BYTES - 512;
static_assert(LDS_IMP + 16384 <= LDS_SEL, "LDS map");
constexpr int GEMM_AB = 18432;

struct Params {
  const float *x, *w_in, *b_fox_f, *pos_k, *pos_v, *w1_k, *w2_k, *w1_v, *w2_v, *lq1, *lk1, *lq2, *lk2, *subln_g, *w_out, *ln_g, *ln_b;
  float* out;
  char* ws;
  long pad_;
};

DI unsigned short f2bf(float f) { unsigned u = __float_as_uint(f); return (unsigned short)((u + 0x7fffu + ((u >> 16) & 1u)) >> 16); }
DI unsigned pk2(float lo, float hi) { f32x2 v = {lo, hi}; bf16x2_t b = __builtin_convertvector(v, bf16x2_t); return __builtin_bit_cast(unsigned, b); }
DI float silu(float x) { return x / (1.f + __expf(-x)); }
DI float sigmoidf(float x) { return 1.f / (1.f + __expf(-x)); }
DI float ex2(float x) { return __builtin_amdgcn_exp2f(x); }
DI float xhalf_max(float v) { auto rr = __builtin_amdgcn_permlane32_swap(__float_as_uint(v), __float_as_uint(v), false, false); return fmaxf(__uint_as_float(rr[0]), __uint_as_float(rr[1])); }
DI float xhalf_sum(float v) { auto rr = __builtin_amdgcn_permlane32_swap(__float_as_uint(v), __float_as_uint(v), false, false); return __uint_as_float(rr[0]) + __uint_as_float(rr[1]); }
DI int crow(int i, int h) { return (i & 3) + 8 * (i >> 2) + 4 * h; }

DI int get_tid() { int t = threadIdx.x; asm volatile("" : "+v"(t)); return t; }
DI int orig_col(int n) {
  int s = n >> 6, c = n & 63;
  if (s < 4) return s * 64 + c;
  if (s < 8) return 256 + (s - 4) * 64 + c;
  if (s < 12) return 512 + (s - 8) * 64 + c;
  if (s < 16) return 772 + (s - 12) * 64 + c;
  if (s < 24) return 1028 + (s - 16) * 64 + c;
  if (s < 36) return 1540 + (s - 24) * 64 + c;
  if (s < 44) return 2332 + (s - 36) * 64 + c;
  if (s < 52) { int base = 2844 + (s - 44) * 64; int nt = c >> 5, r = c & 31, comp = r >> 4, i = r & 15; return base + comp * 32 + nt * 16 + i; }
  if (s < 60) return 3356 + (s - 52) * 64 + c;
  if (s == 60) { if (c < 4) return 768 + c; if (c < 28) return 2308 + (c - 4); return -1; }
  return -1;
}

DI void p0_prologue(const Params& P) {
  const long gtid = (long)blockIdx.x * NTHREADS + get_tid(), gsz = (long)gridDim.x * NTHREADS;
  char* ws = P.ws;
  if (gtid < DEPTH) {
    int l = (int)gtid; float a = 0.f, b = 0.f;
    for (int i = 0; i < 32; ++i) { a += P.lq1[l * 32 + i] * P.lk1[l * 32 + i]; b += P.lq2[l * 32 + i] * P.lk2[l * 32 + i]; }
    float lam_init = 0.8f - 0.6f * expf(-0.3f * (float)l);
    ((float*)(ws + OFF_LAM))[l] = expf(a) - expf(b) + lam_init;
    ((float*)(ws + OFF_LAM))[2 + l] = lam_init;
  }
  for (long it = gtid; it < DEPTH * 2 * 128; it += gsz) {
    int j = it & 127, kv = (it >> 7) & 1, l = (int)(it >> 8);
    const float* pos = (kv ? P.pos_v : P.pos_k) + (size_t)l * 2048;
    const float* w1 = (kv ? P.w1_v : P.w1_k) + (size_t)l * 2048 * 128;
    float a = 0.f;
    for (int k = 0; k < 2048; ++k) a += pos[k] * w1[(size_t)k * 128 + j];
    ((float*)(ws + OFF_B1))[it] = a;
  }
  for (long it = gtid; it < (long)SEQ * 48; it += gsz) {
    int s = (int)(it / 48), i = (int)(it % 48);
    float inv; f32x2* dst;
    if (i < 32) { inv = powf(10000.f, -((float)i * 2.0f / 64.f)); dst = (f32x2*)(ws + OFF_ROPE64) + (size_t)s * 32 + i; }
    else { int ii = i - 32; inv = powf(10000.f, -((float)ii * 2.0f / 32.f)); dst = (f32x2*)(ws + OFF_ROPE32) + (size_t)s * 16 + ii; }
    float ang = (float)s * inv;
    double t = (double)ang * 0.15915494309189535; double fr = t - floor(t); float f = (float)fr;
    f32x2 cs = {__builtin_amdgcn_cosf(f), __builtin_amdgcn_sinf(f)};
    *dst = cs;
  }
  for (long it = gtid; it < (long)DEPTH * 128 * NPAD; it += gsz) {
    int n = (int)(it % NPAD); int k8 = (int)((it / NPAD) & 127); int l = (int)(it / ((long)NPAD * 128));
    int oc = orig_col(n);
    u32x4 v = {0u, 0u, 0u, 0u};
    if (oc >= 0) { const float* src = P.w_in + (size_t)l * DMODEL * NIN + (size_t)(k8 * 8) * NIN + oc;
      float f[8];
#pragma unroll
      for (int j = 0; j < 8; ++j) f[j] = src[(size_t)j * NIN];
      v.x = pk2(f[0], f[1]); v.y = pk2(f[2], f[3]); v.z = pk2(f[4], f[5]); v.w = pk2(f[6], f[7]); }
    *(u32x4*)((bf16_t*)(ws + OFF_WIN) + ((size_t)l * NPAD + n) * DMODEL + k8 * 8) = v;
  }
  for (long it = gtid; it < (long)DEPTH * 128 * 1024; it += gsz) {
    int n = (int)(it & 1023); int k8 = (int)((it >> 10) & 127); int l = (int)(it >> 17);
    const float* src = P.w_out + (size_t)l * 1024 * 1024 + (size_t)(k8 * 8) * 1024 + n;
    float f[8];
#pragma unroll
    for (int j = 0; j < 8; ++j) f[j] = src[(size_t)j * 1024];
    u32x4 v; v.x = pk2(f[0], f[1]); v.y = pk2(f[2], f[3]); v.z = pk2(f[4], f[5]); v.w = pk2(f[6], f[7]);
    *(u32x4*)((bf16_t*)(ws + OFF_WOUT) + ((size_t)l * 1024 + n) * 1024 + k8 * 8) = v;
  }
  for (long it = gtid; it < (long)DEPTH * 2 * 256 * 128; it += gsz) {
    int j = (int)(it & 127); int k8 = (int)((it >> 7) & 255); int kv = (int)((it >> 15) & 1); int l = (int)(it >> 16);
    const float* src = (kv ? P.w1_v : P.w1_k) + (size_t)l * 2048 * 128 + (size_t)(k8 * 8) * 128 + j;
    float f[8];
#pragma unroll
    for (int jj = 0; jj < 8; ++jj) f[jj] = src[(size_t)jj * 128];
    u32x4 v; v.x = pk2(f[0], f[1]); v.y = pk2(f[2], f[3]); v.z = pk2(f[4], f[5]); v.w = pk2(f[6], f[7]);
    *(u32x4*)((bf16_t*)(ws + OFF_W1T) + (((size_t)l * 2 + kv) * 128 + j) * 2048 + k8 * 8) = v;
  }
  for (long it = gtid; it < (long)MTOK * DMODEL / 8; it += gsz) {
    const f32x4* src = (const f32x4*)P.x + it * 2; f32x4 a = src[0], b = src[1];
    u32x4 v; v.x = pk2(a[0], a[1]); v.y = pk2(a[2], a[3]); v.z = pk2(b[0], b[1]); v.w = pk2(b[2], b[3]);
    *((u32x4*)(ws + OFF_XB) + it) = v;
  }
}

#define LDSAS __attribute__((address_space(3)))
DI void glds16(const char* gsrc, char* ldst) {
  __builtin_amdgcn_global_load_lds((const unsigned*)gsrc, (LDSAS unsigned*)ldst, 16, 0, 0);
}
DI void gemm_mainloop(const bf16_t* A, long lda, int a_row_max, const bf16_t* Bt, long ldb, int K, char* lds, f32x16 (&acc)[2][2]) {
  const int tid = get_tid(), lane = tid & 63, wave = __builtin_amdgcn_readfirstlane(tid >> 6), wm = wave >> 1, wn = wave & 1, r = lane & 31, h = lane >> 5;
#pragma unroll
  for (int a = 0; a < 2; ++a)
#pragma unroll
    for (int b = 0; b < 2; ++b)
#pragma unroll
      for (int i = 0; i < 16; ++i) acc[a][b][i] = 0.f;
  const char* ga[4]; const char* gb[4];
#pragma unroll
  for (int i = 0; i < 4; ++i) { const int row = 32 * wave + 8 * i + (lane >> 3), ch = (lane & 7) ^ ((row >> 1) & 7); const int ar = row < a_row_max ? row : a_row_max;
    ga[i] = (const char*)(A + (long)ar * lda) + ch * 16; gb[i] = (const char*)(Bt + (long)row * ldb) + ch * 16; }
  char* const ldw = lds + (32 * wave) * 128;
  const int nk = K >> 6;
#define GEMM_STAGE(BUF, KT) do { _Pragma("unroll") for (int i = 0; i < 4; ++i) { \
    glds16(ga[i] + (long)(KT) * 128, ldw + (BUF) * 32768 + i * 1024); glds16(gb[i] + (long)(KT) * 128, ldw + (BUF) * 32768 + 16384 + i * 1024); } } while (0)
  __syncthreads();
  GEMM_STAGE(0, 0);
  asm volatile("s_waitcnt vmcnt(0)" ::: "memory");
  __syncthreads();
  const int sw = (r >> 1) & 7;
  const char* pa = lds + (64 * wm + r) * 128; const char* pb = lds + 16384 + (64 * wn + r) * 128;
  for (int kt = 0; kt < nk; ++kt) {
    const int cur = kt & 1;
    if (kt + 1 < nk) GEMM_STAGE(cur ^ 1, kt + 1);
#pragma unroll
    for (int ks = 0; ks < 4; ++ks) {
      const int x = ((2 * ks + h) ^ sw) * 16 + cur * 32768;
      bf16x8 a0 = *(const bf16x8*)(pa + x), a1 = *(const bf16x8*)(pa + x + 32 * 128);
      bf16x8 b0 = *(const bf16x8*)(pb + x), b1 = *(const bf16x8*)(pb + x + 32 * 128);
      acc[0][0] = MFMA32(a0, b0, acc[0][0]); acc[0][1] = MFMA32(a0, b1, acc[0][1]);
      acc[1][0] = MFMA32(a1, b0, acc[1][0]); acc[1][1] = MFMA32(a1, b1, acc[1][1]);
    }
    asm volatile("s_waitcnt vmcnt(0)" ::: "memory");
    __syncthreads();
  }
#undef GEMM_STAGE
}

DI bool xcd_tile(int i, int NT, int& mt, int& nt) {
  const int G = gridDim.x;
  if ((G & 7) == 0 && G >= 8) {
    const int x = blockIdx.x & 7, j = blockIdx.x >> 3, per = G >> 3;
    const int u = j + per * i; if (u >= 16 * NT) return false;
    const int grp = u / (8 * NT), v = u - grp * (8 * NT);
    mt = 16 * x + 8 * grp + (v & 7); nt = v >> 3; return true;
  }
  const int t = blockIdx.x + G * i; if (t >= 128 * NT) return false;
  mt = t / NT; nt = t - mt * NT; return true;
}

DI void epi_inproj(const Params& P, int l, const f32x16 (&acc)[2][2], int m0, int n0) {
  const int tid = get_tid(), lane = tid & 63, wave = tid >> 6, wm = wave >> 1, wn = wave & 1, r = lane & 31, h = lane >> 5;
  char* ws = P.ws;
  const int slot = (n0 >> 6) + wn;
  const int b = m0 >> 13;
  const int srow0 = (m0 & (SEQ - 1)) + 64 * wm;
  int cat = 0;
  int rope = 0; float scale = 1.f; bf16_t* dst = nullptr; int gcol = 0;
  const float QS = 0.125f * LOG2E;
  if (slot < 4) { cat = 1; scale = QS; dst = (bf16_t*)(ws + OFF_QF) + (size_t)(b * 4 + slot) * SEQ * 64; }
  else if (slot < 8) { cat = 1; dst = (bf16_t*)(ws + OFF_KF) + (size_t)(b * 4 + slot - 4) * SEQ * 64; }
  else if (slot < 12) { cat = 2; dst = (bf16_t*)(ws + OFF_VFT) + (size_t)(b * 4 + slot - 8) * SEQ * 64; }
  else if (slot < 16) { cat = 3; gcol = (slot - 12) * 64; }
  else if (slot < 24) { cat = 1; rope = 1; scale = QS; dst = (bf16_t*)(ws + OFF_QN) + (size_t)(b * 8 + slot - 16) * SEQ * 64; }
  else if (slot < 26) { cat = 1; rope = 1; dst = (bf16_t*)(ws + OFF_KCT) + (size_t)(b * 2 + slot - 24) * SEQ * 64; }
  else if (slot < 28) { cat = 1; dst = (bf16_t*)(ws + OFF_VCT) + (size_t)(b * 2 + slot - 26) * SEQ * 64; }
  else if (slot < 30) { cat = 1; rope = 1; dst = (bf16_t*)(ws + OFF_KS) + (size_t)(b * 2 + slot - 28) * SEQ * 64; }
  else if (slot < 32) { cat = 2; dst = (bf16_t*)(ws + OFF_VST) + (size_t)(b * 2 + slot - 30) * SEQ * 64; }
  else if (slot < 34) { cat = 1; rope = 1; dst = (bf16_t*)(ws + OFF_KW) + (size_t)(b * 2 + slot - 32) * SEQ * 64; }
  else if (slot < 36) { cat = 2; dst = (bf16_t*)(ws + OFF_VWT) + (size_t)(b * 2 + slot - 34) * SEQ * 64; }
  else if (slot < 44) { cat = 3; gcol = 256 + (slot - 36) * 64; }
  else if (slot < 48) { cat = 1; rope = 2; scale = 0.17677669529663687f * LOG2E; dst = (bf16_t*)(ws + OFF_QD) + (size_t)(b * 4 + slot - 44) * SEQ * 64; }
  else if (slot < 52) { cat = 1; rope = 2; dst = (bf16_t*)(ws + OFF_KD) + (size_t)(b * 4 + slot - 48) * SEQ * 64; }
  else if (slot < 56) { cat = 2; dst = (bf16_t*)(ws + OFF_VDT) + (size_t)(b * 4 + slot - 52) * SEQ * 64; }
  else if (slot < 60) { cat = 3; gcol = 768 + (slot - 56) * 64; }
  else if (slot == 60) cat = 4;

  if (cat == 1) {
    int c0 = r, c1 = 32 + r;
    if (rope == 2) { int comp = r >> 4, ii = r & 15; c0 = comp * 32 + ii; c1 = comp * 32 + 16 + ii; }
    const f32x2* tab = (rope == 1) ? ((const f32x2*)(ws + OFF_ROPE64) + r) : ((const f32x2*)(ws + OFF_ROPE32) + (r & 15));
    const int tstride = (rope == 1) ? 32 : 16;
#pragma unroll
    for (int mt = 0; mt < 2; ++mt)
#pragma unroll
      for (int i = 0; i < 16; ++i) {
        int s = srow0 + 32 * mt + crow(i, h);
        float v0 = acc[mt][0][i], v1 = acc[mt][1][i];
        if (rope) { f32x2 cs = tab[(size_t)s * tstride]; float y0 = v0 * cs[0] - v1 * cs[1], y1 = v1 * cs[0] + v0 * cs[1]; v0 = y0; v1 = y1; }
        v0 *= scale; v1 *= scale;
        dst[(size_t)s * 64 + c0] = f2bf(v0); dst[(size_t)s * 64 + c1] = f2bf(v1);
      }
  } else if (cat == 2) {
#pragma unroll
    for (int mt = 0; mt < 2; ++mt)
#pragma unroll
      for (int g = 0; g < 4; ++g) {
        int s = srow0 + 32 * mt + 8 * g + 4 * h;
#pragma unroll
        for (int nt = 0; nt < 2; ++nt) {
          u32x2 v; v.x = pk2(acc[mt][nt][4 * g], acc[mt][nt][4 * g + 1]); v.y = pk2(acc[mt][nt][4 * g + 2], acc[mt][nt][4 * g + 3]);
          *(u32x2*)(dst + (size_t)(32 * nt + r) * SEQ + s) = v;
        }
      }
  } else if (cat == 3) {
    bf16_t* G = (bf16_t*)(ws + OFF_G);
#pragma unroll
    for (int mt = 0; mt < 2; ++mt)
#pragma unroll
      for (int i = 0; i < 16; ++i) {
        size_t row = (size_t)m0 + 64 * wm + 32 * mt + crow(i, h);
        G[row * 1024 + gcol + r] = f2bf(silu(acc[mt][0][i])); G[row * 1024 + gcol + 32 + r] = f2bf(silu(acc[mt][1][i]));
      }
  } else if (cat == 4) {
    if (r < 28) {
      float bias = (r < 4) ? P.b_fox_f[l * 4 + r] : 0.f;
#pragma unroll
      for (int mt = 0; mt < 2; ++mt)
#pragma unroll
        for (int i = 0; i < 16; ++i) {
          int s = srow0 + 32 * mt + crow(i, h);
          float v = acc[mt][0][i];
          if (r < 4) { float xx = v + bias; float ls = fminf(xx, 0.f) - log1pf(expf(-fabsf(xx)));
            ((float*)(ws + OFF_LOGF))[(size_t)(b * 4 + r) * SEQ + s] = ls * LOG2E; }
          else ((float*)(ws + OFF_GATES))[((size_t)b * SEQ + s) * 24 + (r - 4)] = sigmoidf(v);
        }
    }
  }
}

DI void p1_inproj(const Params& P, int l, char* lds) {
  const bf16_t* A = (const bf16_t*)(P.ws + OFF_XB);
  const bf16_t* Bt = (const bf16_t*)(P.ws + OFF_WIN) + (size_t)l * NPAD * DMODEL;
  const int NT = NPAD / 128;
  int mt, nt;
  for (int i = 0; xcd_tile(i, NT, mt, nt); ++i) {
    f32x16 acc[2][2];
    gemm_mainloop(A + (size_t)mt * 128 * DMODEL, DMODEL, 127, Bt + (size_t)nt * 128 * DMODEL, DMODEL, DMODEL, lds, acc);
    epi_inproj(P, l, acc, mt * 128, nt * 128);
  }
}

DI void p4_outproj(const Params& P, int l, char* lds) {
  const bf16_t* A = (const bf16_t*)(P.ws + OFF_MIX);
  const bf16_t* Bt = (const bf16_t*)(P.ws + OFF_WOUT) + (size_t)l * 1024 * 1024;
  const float* xres = (l == 0) ? P.x : P.out;
  const float alpha = 1.4142135623730951f;
  const int tid = get_tid(), lane = tid & 63, wave = tid >> 6, wm = wave >> 1, wn = wave & 1, r = lane & 31, h = lane >> 5;
  int mt, nt;
  for (int i = 0; xcd_tile(i, 8, mt, nt); ++i) {
    f32x16 acc[2][2];
    gemm_mainloop(A + (size_t)mt * 128 * 1024, 1024, 127, Bt + (size_t)nt * 128 * 1024, 1024, 1024, lds, acc);
#pragma unroll
    for (int a = 0; a < 2; ++a)
#pragma unroll
      for (int bb = 0; bb < 2; ++bb)
#pragma unroll
        for (int i = 0; i < 16; ++i) {
          size_t row = (size_t)mt * 128 + 64 * wm + 32 * a + crow(i, h); int col = nt * 128 + 64 * wn + 32 * bb + r;
          P.out[row * 1024 + col] = alpha * xres[row * 1024 + col] + acc[a][bb][i];
        }
  }
}

DI void p5_ln(const Params& P, int l) {
  const int lane = get_tid() & 63, wave = get_tid() >> 6;
  const float* g = P.ln_g + l * 1024; const float* bb = P.ln_b + l * 1024;
  for (int row = blockIdx.x * 4 + wave; row < MTOK; row += gridDim.x * 4) {
    float* p = P.out + (size_t)row * 1024;
    f32x4 v[4]; float s = 0.f;
#pragma unroll
    for (int k = 0; k < 4; ++k) { v[k] = *(const f32x4*)(p + k * 256 + lane * 4); s += v[k][0] + v[k][1] + v[k][2] + v[k][3]; }
#pragma unroll
    for (int o = 32; o >= 1; o >>= 1) s += __shfl_xor(s, o);
    float mean = s * (1.f / 1024.f); float q = 0.f;
#pragma unroll
    for (int k = 0; k < 4; ++k)
#pragma unroll
      for (int e = 0; e < 4; ++e) { float d = v[k][e] - mean; q += d * d; }
#pragma unroll
    for (int o = 32; o >= 1; o >>= 1) q += __shfl_xor(q, o);
    float rstd = rsqrtf(q * (1.f / 1024.f) + 1e-5f);
#pragma unroll
    for (int k = 0; k < 4; ++k) {
      int c = k * 256 + lane * 4; f32x4 gg = *(const f32x4*)(g + c), bv = *(const f32x4*)(bb + c); f32x4 o;
#pragma unroll
      for (int e = 0; e < 4; ++e) o[e] = (v[k][e] - mean) * rstd * gg[e] + bv[e];
      *(f32x4*)(p + c) = o;
      if (l + 1 < DEPTH) {
        u32x2 w; w.x = pk2(o[0], o[1]); w.y = pk2(o[2], o[3]);
        *(u32x2*)((bf16_t*)(P.ws + OFF_XB) + (size_t)row * 1024 + c) = w; }
    }
  }
}

enum { M_FOX = 0, M_DIFF = 1, M_CMP1 = 2, M_CMP2 = 3, M_SEL = 4, M_WIN = 5 };
struct AttnState { f32x16 o[2]; float m, l; };
struct TileSrc { const bf16_t* K; const bf16_t* Vt; long vstride; const float* C; };

template <bool HASV, bool HASC>
DI void tile_gload(const TileSrc& s, int T, u32x4 (&rk)[2], u32x4 (&rv)[2], f32x4& rc, int tid) {
#pragma unroll
  for (int p = 0; p < 2; ++p) { int id = tid + 256 * p, row = id >> 3, ch = id & 7;
    rk[p] = *(const u32x4*)(s.K + ((long)(64 * T + row)) * 64 + ch * 8);
    if (HASV) rv[p] = *(const u32x4*)(s.Vt + (long)row * s.vstride + 64 * T + ch * 8); }
  if (HASC) { if (tid < 16) rc = *(const f32x4*)(s.C + 64 * T + 4 * tid); }
}
template <bool HASV, bool HASC>
DI void tile_sstore(char* buf, const u32x4 (&rk)[2], const u32x4 (&rv)[2], const f32x4& rc, int tid) {
#pragma unroll
  for (int p = 0; p < 2; ++p) { int id = tid + 256 * p, row = id >> 3, ch = id & 7;
    *(u32x4*)(buf + row * 144 + ch * 16) = rk[p];
    if (HASV) { char* d = buf + ATT_V + row * 136 + ch * 16; u32x2 a = {rv[p].x, rv[p].y}, b = {rv[p].z, rv[p].w}; *(u32x2*)d = a; *(u32x2*)(d + 8) = b; } }
  if (HASC) { if (tid < 16) *(f32x4*)(buf + ATT_C + tid * 16) = -rc; }
}

template <int MODE>
DI void qk_part(f32x16 (&p)[2], const bf16x8* qf, const char* buf, int koffb, int r, int h) {
  constexpr int ND0 = (MODE == M_DIFF) ? 2 : 4;
  const char* kl = buf; const float* cl = (const float*)(buf + ATT_C);
  if (MODE == M_FOX) {
#pragma unroll
    for (int c = 0; c < 2; ++c)
#pragma unroll
      for (int g = 0; g < 4; ++g) { f32x4 ck = *(const f32x4*)(cl + 32 * c + 8 * g + 4 * h);
#pragma unroll
        for (int e = 0; e < 4; ++e) p[c][4 * g + e] = ck[e]; }
  } else {
#pragma unroll
    for (int i = 0; i < 16; ++i) { p[0][i] = 0.f; p[1][i] = 0.f; }
  }
#pragma unroll
  for (int d0 = 0; d0 < ND0; ++d0) {
    const char* kp = kl + r * 144 + koffb + (16 * d0 + 8 * h) * 2;
    bf16x8 k0 = *(const bf16x8*)kp; bf16x8 k1 = *(const bf16x8*)(kp + 32 * 144);
    p[0] = MFMA32(k0, qf[d0], p[0]); p[1] = MFMA32(k1, qf[d0], p[1]);
  }
}

template <int MODE>
DI void sp_part(AttnState& st, f32x16 (&p)[2], const char* buf, int T, int tq, unsigned selbit,
                float m_fin, float inv_l, unsigned* imp_q, int r, int h) {
  const char* vl = buf + ATT_V;
  const int kvb = 64 * T + 4 * h;
  int lim, lo;
  if (MODE == M_CMP1 || MODE == M_CMP2) { lim = (tq - 31) >> 4; lo = -(1 << 30); }
  else if (MODE == M_SEL) { lim = selbit ? tq : -1; lo = -(1 << 30); }
  else if (MODE == M_WIN) { lim = tq; lo = tq - 511; }
  else { lim = tq; lo = -(1 << 30); }
  const bool full = (lim >= 64 * T + 63) && (lo <= 64 * T);
  bool lane_on = true; bool sel_interior = false;
  if (MODE == M_SEL) sel_interior = __all(tq >= 64 * T + 63) != 0;
  if (sel_interior) lane_on = (selbit != 0u);
  else if (!__all(full)) {
#pragma unroll
    for (int c = 0; c < 2; ++c)
#pragma unroll
      for (int i = 0; i < 16; ++i) { int kv = kvb + 32 * c + 8 * (i >> 2) + (i & 3); if (kv > lim || kv < lo) p[c][i] = NEGBIG; }
  }
  if (MODE == M_CMP2) {
#pragma unroll
    for (int c = 0; c < 2; ++c)
#pragma unroll
      for (int i = 0; i < 16; ++i) p[c][i] = ex2(p[c][i] - m_fin) * inv_l;
#pragma unroll
    for (int c = 0; c < 2; ++c)
#pragma unroll
      for (int g = 0; g < 4; ++g) {
        int j = 16 * T + 8 * c + 2 * g + h;
        float bq = 0.5f * p[c][4 * g + 3]; float aq = p[c][4 * g] + p[c][4 * g + 1] + p[c][4 * g + 2] + bq;
        atomicAdd(&imp_q[j * 32], (unsigned)(aq * 4194304.f + 0.5f));
        if (j + 1 < 128) atomicAdd(&imp_q[(j + 1) * 32], (unsigned)(bq * 4194304.f + 0.5f));
      }
  } else {
    float mx = p[0][0];
#pragma unroll
    for (int i = 1; i < 16; ++i) mx = fmaxf(mx, p[0][i]);
#pragma unroll
    for (int i = 0; i < 16; ++i) mx = fmaxf(mx, p[1][i]);
    if (MODE == M_SEL) mx = lane_on ? mx : NEGBIG;
    mx = xhalf_max(mx);
    const float mnew = fmaxf(st.m, mx);
    const float alpha = ex2(st.m - mnew);
    const float msub = (MODE == M_SEL && !lane_on) ? 1e30f : mnew;
    float sum = 0.f;
#pragma unroll
    for (int c = 0; c < 2; ++c)
#pragma unroll
      for (int i = 0; i < 16; ++i) { float e = ex2(p[c][i] - msub); p[c][i] = e; sum += e; }
    st.l = st.l * alpha + sum; st.m = mnew;
    if (MODE != M_CMP1) {
      if (MODE == M_FOX || __any(alpha != 1.f)) {
#pragma unroll
        for (int i = 0; i < 16; ++i) { st.o[0][i] *= alpha; st.o[1][i] *= alpha; }
      }
    }
  }
  if (MODE != M_CMP1) {
#pragma unroll
    for (int c = 0; c < 2; ++c)
#pragma unroll
      for (int s2 = 0; s2 < 2; ++s2) {
        u32x4 pw; pw.x = pk2(p[c][8 * s2], p[c][8 * s2 + 1]); pw.y = pk2(p[c][8 * s2 + 2], p[c][8 * s2 + 3]);
        pw.z = pk2(p[c][8 * s2 + 4], p[c][8 * s2 + 5]); pw.w = pk2(p[c][8 * s2 + 6], p[c][8 * s2 + 7]);
        bf16x8 pf = __builtin_bit_cast(bf16x8, pw);
#pragma unroll
        for (int dt = 0; dt < 2; ++dt) {
          const char* vp = vl + (32 * dt + r) * 136 + (32 * c + 16 * s2 + 4 * h) * 2;
          s16x4 lo4 = *(const s16x4*)vp; s16x4 hi4 = *(const s16x4*)(vp + 16);
          bf16x8 vf = __builtin_shufflevector(lo4, hi4, 0, 1, 2, 3, 4, 5, 6, 7);
          st.o[dt] = MFMA32(vf, pf, st.o[dt]);
        }
      }
  }
}

template <int MODE>
DI bool tile_active(int T, int twmax, int qspan, const unsigned* selmask_q) {
  bool a;
  if (MODE == M_CMP1 || MODE == M_CMP2) a = (16 * (64 * T) + 31 <= twmax);
  else a = (64 * T <= twmax);
  if (MODE == M_WIN) a = a && (64 * T + 63 >= twmax - qspan - 511);
  if (MODE == M_SEL) { if (a) a = __any((int)((selmask_q[T >> 5] >> (T & 31)) & 1u)) != 0; }
  return a;
}

template <int MODE>
DI void run_tiles(AttnState& st, const bf16x8* qf, const TileSrc& src, int T0, int T1, int tq, int twmax_, int qspan, int koffb,
                  const unsigned* selmask_q, float m_fin, float inv_l, unsigned* imp_q, char* lds, int tid, int r, int h) {
  constexpr bool HASV = (MODE != M_CMP1), HASC = (MODE == M_FOX);
  const int twmax = __builtin_amdgcn_readfirstlane(twmax_);
  u32x4 rk[2], rv[2]; f32x4 rc;
  __syncthreads();
  if (T0 >= T1) return;
  tile_gload<HASV, HASC>(src, T0, rk, rv, rc, tid); tile_sstore<HASV, HASC>(lds, rk, rv, rc, tid);
  if (T0 + 1 < T1) { tile_gload<HASV, HASC>(src, T0 + 1, rk, rv, rc, tid); tile_sstore<HASV, HASC>(lds + ATT_BUF, rk, rv, rc, tid); }
  if (T0 + 2 < T1) tile_gload<HASV, HASC>(src, T0 + 2, rk, rv, rc, tid);
  __syncthreads();
  f32x16 pa[2], pb[2];
  if (tile_active<MODE>(T0, twmax, qspan, selmask_q)) qk_part<MODE>(pa, qf, lds, koffb, r, h);
  int slot = 0;
#define ATT_STEP(PC, PN, TT) do { \
    const int T_ = (TT); const char* buf_ = lds + slot * ATT_BUF; \
    const int slot1_ = (slot == 2) ? 0 : slot + 1; const int slot2_ = (slot1_ == 2) ? 0 : slot1_ + 1; \
    const bool more_ = (T_ + 1 < T1); \
    if (more_ && tile_active<MODE>(T_ + 1, twmax, qspan, selmask_q)) qk_part<MODE>(PN, qf, lds + slot1_ * ATT_BUF, koffb, r, h); \
    if (tile_active<MODE>(T_, twmax, qspan, selmask_q)) { unsigned selbit_ = 0; if (MODE == M_SEL) selbit_ = (selmask_q[T_ >> 5] >> (T_ & 31)) & 1u; \
      sp_part<MODE>(st, PC, buf_, T_, tq, selbit_, m_fin, inv_l, imp_q, r, h); } \
    if (more_) { if (T_ + 2 < T1) tile_sstore<HASV, HASC>(lds + slot2_ * ATT_BUF, rk, rv, rc, tid); \
      if (T_ + 3 < T1) tile_gload<HASV, HASC>(src, T_ + 3, rk, rv, rc, tid); \
      __syncthreads(); } \
    slot = slot1_; } while (0)
  for (int T = T0; T < T1; T += 2) {
    ATT_STEP(pa, pb, T);
    if (T + 1 < T1) ATT_STEP(pb, pa, T + 1);
  }
#undef ATT_STEP
}

DI void st_init(AttnState& st) {
#pragma unroll
  for (int i = 0; i < 16; ++i) { st.o[0][i] = 0.f; st.o[1][i] = 0.f; }
  st.m = MINIT; st.l = 0.f;
}
DI float st_invl(const AttnState& st) { float lt = xhalf_sum(st.l); return lt > 0.f ? 1.f / lt : 0.f; }

DI void store_mix(const Params& P, size_t token, int col, float a, float b, float c, float d) {
  const bf16_t* G = (const bf16_t*)(P.ws + OFF_G) + token * 1024 + col;
  u32x2 gv = *(const u32x2*)G;
  float g0 = __uint_as_float(gv.x << 16), g1 = __uint_as_float(gv.x & 0xffff0000u), g2 = __uint_as_float(gv.y << 16), g3 = __uint_as_float(gv.y & 0xffff0000u);
  u32x2 w; w.x = pk2(a * g0, b * g1); w.y = pk2(c * g2, d * g3);
  *(u32x2*)((bf16_t*)(P.ws + OFF_MIX) + token * 1024 + col) = w;
}

DI void fox_unit(const Params& P, int bh, int qt, char* lds) {
  const int tid = get_tid(), lane = tid & 63, wave = tid >> 6, r = lane & 31, h = lane >> 5;
  const int t0 = 128 * qt, tq = t0 + 32 * wave + r, twmax = t0 + 32 * wave + 31;
  const bf16_t* Q = (const bf16_t*)(P.ws + OFF_QF) + (size_t)bh * SEQ * 64;
  TileSrc src; src.K = (const bf16_t*)(P.ws + OFF_KF) + (size_t)bh * SEQ * 64; src.Vt = (const bf16_t*)(P.ws + OFF_VFT) + (size_t)bh * SEQ * 64; src.vstride = SEQ;
  src.C = (const float*)(P.ws + OFF_CUM) + (size_t)bh * SEQ;
  bf16x8 qf[4];
#pragma unroll
  for (int d0 = 0; d0 < 4; ++d0) qf[d0] = *(const bf16x8*)(Q + (size_t)tq * 64 + 16 * d0 + 8 * h);
  AttnState st; st_init(st);
  run_tiles<M_FOX>(st, qf, src, 0, 2 * qt + 2, tq, twmax, 31, 0, nullptr, 0.f, 0.f, nullptr, lds, tid, r, h);
  const float inv = st_invl(st);
  const size_t token = (size_t)(bh >> 2) * SEQ + tq; const int hd = bh & 3;
#pragma unroll
  for (int dt = 0; dt < 2; ++dt)
#pragma unroll
    for (int g = 0; g < 4; ++g)
      store_mix(P, token, hd * 64 + 32 * dt + 8 * g + 4 * h, st.o[dt][4 * g] * inv, st.o[dt][4 * g + 1] * inv, st.o[dt][4 * g + 2] * inv, st.o[dt][4 * g + 3] * inv);
}

DI void diff_unit(const Params& P, int l, int bh, int qt, char* lds) {
  const int tid = get_tid(), lane = tid & 63, wave = tid >> 6, r = lane & 31, h = lane >> 5;
  const int comp = wave & 1, qs = wave >> 1;
  const int t0 = 64 * qt, tq = t0 + 32 * qs + r, twmax = t0 + 32 * qs + 31;
  const bf16_t* Q = (const bf16_t*)(P.ws + OFF_QD) + (size_t)bh * SEQ * 64;
  TileSrc src; src.K = (const bf16_t*)(P.ws + OFF_KD) + (size_t)bh * SEQ * 64; src.Vt = (const bf16_t*)(P.ws + OFF_VDT) + (size_t)bh * SEQ * 64; src.vstride = SEQ; src.C = nullptr;
  bf16x8 qf[2];
#pragma unroll
  for (int d0 = 0; d0 < 2; ++d0) qf[d0] = *(const bf16x8*)(Q + (size_t)tq * 64 + comp * 32 + 16 * d0 + 8 * h);
  AttnState st; st_init(st);
  run_tiles<M_DIFF>(st, qf, src, 0, qt + 1, tq, twmax, 31, comp * 64, nullptr, 0.f, 0.f, nullptr, lds, tid, r, h);
  const float inv = st_invl(st);
  float* exch = (float*)(lds + LDS_IMP);
  __syncthreads();
  if (comp == 1) {
#pragma unroll
    for (int dt = 0; dt < 2; ++dt)
#pragma unroll
      for (int i = 0; i < 16; ++i) exch[(qs * 64 + 32 * dt + crow(i, h)) * 32 + r] = st.o[dt][i] * inv;
  }
  __syncthreads();
  if (comp == 0) {
    const float lam = ((const float*)(P.ws + OFF_LAM))[l], lam_init = ((const float*)(P.ws + OFF_LAM))[2 + l];
    float ss = 0.f;
#pragma unroll
    for (int dt = 0; dt < 2; ++dt)
#pragma unroll
      for (int i = 0; i < 16; ++i) { float a = st.o[dt][i] * inv - lam * exch[(qs * 64 + 32 * dt + crow(i, h)) * 32 + r]; st.o[dt][i] = a; ss += a * a; }
    ss = xhalf_sum(ss);
    const float rms = rsqrtf(ss * (1.f / 64.f) + 1e-5f) * (1.f - lam_init);
    const size_t token = (size_t)(bh >> 2) * SEQ + tq; const int hd = bh & 3;
    const float* sg = P.subln_g + l * 64;
#pragma unroll
    for (int dt = 0; dt < 2; ++dt)
#pragma unroll
      for (int g = 0; g < 4; ++g) { int d = 32 * dt + 8 * g + 4 * h; f32x4 gg = *(const f32x4*)(sg + d);
        store_mix(P, token, 768 + hd * 64 + d, st.o[dt][4 * g] * rms * gg[0], st.o[dt][4 * g + 1] * rms * gg[1], st.o[dt][4 * g + 2] * rms * gg[2], st.o[dt][4 * g + 3] * rms * gg[3]); }
  }
}

DI void nsa_unit(const Params& P, int bg, int qt, char* lds) {
  const int tid = get_tid(), lane = tid & 63, wave = tid >> 6, r = lane & 31, h = lane >> 5;
  const int b = bg >> 1, g2 = bg & 1, head8 = g2 * 4 + (r & 3);
  const int t0 = 32 * qt, ql = 8 * wave + (r >> 2), tq = t0 + ql, tmax = t0 + 31, twmax = t0 + 8 * wave + 7;
  const bf16_t* Q = (const bf16_t*)(P.ws + OFF_QN) + (size_t)(b * 8 + head8) * SEQ * 64;
  bf16x8 qf[4];
#pragma unroll
  for (int d0 = 0; d0 < 4; ++d0) qf[d0] = *(const bf16x8*)(Q + (size_t)tq * 64 + 16 * d0 + 8 * h);
  unsigned* imp = (unsigned*)(lds + LDS_IMP);
  unsigned* selm = (unsigned*)(lds + LDS_SEL);
#pragma unroll
  for (int k = 0; k < 16; ++k) imp[tid + 256 * k] = 0u;
  const float* gates = (const float*)(P.ws + OFF_GATES) + ((size_t)b * SEQ + tq) * 24 + 3 * head8;
  const float gc = gates[0], gs = gates[1], gw = gates[2];
  unsigned* stash = (unsigned*)(lds + LDS_IMP) + wave * 16 * 64 + lane;
  TileSrc src; src.K = (const bf16_t*)(P.ws + OFF_KC) + (size_t)bg * 512 * 64; src.Vt = (const bf16_t*)(P.ws + OFF_VCC) + (size_t)bg * 64 * 512; src.vstride = 512; src.C = nullptr;
  int nvis = (t0 >> 4) + 1; if (nvis > 511) nvis = 511;
  const int ntc = (nvis + 63) >> 6;
  AttnState st; st_init(st);
  run_tiles<M_CMP1>(st, qf, src, 0, ntc, tq, twmax, 7, 0, nullptr, 0.f, 0.f, nullptr, lds, tid, r, h);
  {
    const float m_fin = st.m, inv_l = st_invl(st);
    st_init(st);
    run_tiles<M_CMP2>(st, qf, src, 0, ntc, tq, twmax, 7, 0, nullptr, m_fin, inv_l, imp + ql, lds, tid, r, h);
  }
  __syncthreads();
  {
    const int q = tid >> 3, jg = tid & 7; const int t = t0 + q, cur = t >> 6;
    unsigned key[16];
#pragma unroll
    for (int e = 0; e < 16; ++e) { int j = 16 * jg + e; unsigned v = imp[j * 32 + q];
      bool valid = j <= cur, forced = (j == 0) || (j == cur) || (j == cur - 1);
      key[e] = !valid ? 0u : (forced ? (0xFFFFFF80u | (unsigned)(127 - j)) : ((v << 7) | (unsigned)(127 - j))); }
    unsigned sel = 0;
    for (int round = 0; round < 16; ++round) {
      unsigned m = key[0];
#pragma unroll
      for (int e = 1; e < 16; ++e) m = m > key[e] ? m : key[e];
      unsigned o;
      o = __shfl_xor(m, 1); m = m > o ? m : o; o = __shfl_xor(m, 2); m = m > o ? m : o; o = __shfl_xor(m, 4); m = m > o ? m : o;
      if (m != 0u) {
#pragma unroll
        for (int e = 0; e < 16; ++e) if (key[e] == m) { sel |= 1u << e; key[e] = 0u; }
      }
    }
    ((unsigned short*)selm)[q * 8 + jg] = (unsigned short)sel;
  }
  __syncthreads();
#pragma unroll
  for (int i = 0; i < 8; ++i) { stash[i * 64] = pk2(gc * st.o[0][2 * i], gc * st.o[0][2 * i + 1]); stash[(8 + i) * 64] = pk2(gc * st.o[1][2 * i], gc * st.o[1][2 * i + 1]); }
  src.K = (const bf16_t*)(P.ws + OFF_KS) + (size_t)bg * SEQ * 64; src.Vt = (const bf16_t*)(P.ws + OFF_VST) + (size_t)bg * SEQ * 64; src.vstride = SEQ;
  st_init(st);
  run_tiles<M_SEL>(st, qf, src, 0, (tmax >> 6) + 1, tq, twmax, 7, 0, selm + ql * 4, 0.f, 0.f, nullptr, lds, tid, r, h);
  { const float inv = st_invl(st) * gs;
#pragma unroll
    for (int i = 0; i < 8; ++i) { unsigned a = stash[i * 64], bq = stash[(8 + i) * 64];
      stash[i * 64] = pk2(__uint_as_float(a << 16) + inv * st.o[0][2 * i], __uint_as_float(a & 0xffff0000u) + inv * st.o[0][2 * i + 1]);
      stash[(8 + i) * 64] = pk2(__uint_as_float(bq << 16) + inv * st.o[1][2 * i], __uint_as_float(bq & 0xffff0000u) + inv * st.o[1][2 * i + 1]); } }
  src.K = (const bf16_t*)(P.ws + OFF_KW) + (size_t)bg * SEQ * 64; src.Vt = (const bf16_t*)(P.ws + OFF_VWT) + (size_t)bg * SEQ * 64;
  st_init(st);
  { int lo_t = t0 - 511; int T0 = lo_t > 0 ? (lo_t >> 6) : 0;
    run_tiles<M_WIN>(st, qf, src, T0, (tmax >> 6) + 1, tq, twmax, 7, 0, nullptr, 0.f, 0.f, nullptr, lds, tid, r, h); }
  { const float inv = st_invl(st) * gw;
#pragma unroll
    for (int i = 0; i < 8; ++i) { unsigned a = stash[i * 64], bq = stash[(8 + i) * 64];
      st.o[0][2 * i] = __uint_as_float(a << 16) + inv * st.o[0][2 * i]; st.o[0][2 * i + 1] = __uint_as_float(a & 0xffff0000u) + inv * st.o[0][2 * i + 1];
      st.o[1][2 * i] = __uint_as_float(bq << 16) + inv * st.o[1][2 * i]; st.o[1][2 * i + 1] = __uint_as_float(bq & 0xffff0000u) + inv * st.o[1][2 * i + 1]; } }
  const size_t token = (size_t)b * SEQ + tq;
#pragma unroll
  for (int dt = 0; dt < 2; ++dt)
#pragma unroll
    for (int g = 0; g < 4; ++g)
      store_mix(P, token, 256 + head8 * 64 + 32 * dt + 8 * g + 4 * h, st.o[dt][4 * g], st.o[dt][4 * g + 1], st.o[dt][4 * g + 2], st.o[dt][4 * g + 3]);
}

DI void compress_tile(const Params& P, int l, int id, char* lds) {
  const int tid = get_tid(), lane = tid & 63, wave = tid >> 6, wm = wave >> 1, wn = wave & 1, r = lane & 31, h = lane >> 5;
  const int kv = id >> 4, bg = (id >> 2) & 3, mt = id & 3;
  const bf16_t* tok = (const bf16_t*)(P.ws + (kv ? OFF_VCT : OFF_KCT)) + (size_t)bg * SEQ * 64;
  const bf16_t* Bt = (const bf16_t*)(P.ws + OFF_W1T) + ((size_t)l * 2 + kv) * 128 * 2048;
  f32x16 acc[2][2];
  int rowmax = 510 - 128 * mt; if (rowmax > 127) rowmax = 127;
  gemm_mainloop(tok + (size_t)mt * 128 * 1024, 1024, rowmax, Bt, 2048, 2048, lds, acc);
  __syncthreads();
  float* H = (float*)lds;
  const float* bias = (const float*)(P.ws + OFF_B1) + (l * 2 + kv) * 128;
#pragma unroll
  for (int a = 0; a < 2; ++a)
#pragma unroll
    for (int bb = 0; bb < 2; ++bb) { int col = 64 * wn + 32 * bb + r; float bv = bias[col];
#pragma unroll
      for (int i = 0; i < 16; ++i) { int row = 64 * wm + 32 * a + crow(i, h); H[row * 129 + col] = silu(acc[a][bb][i] + bv); } }
  __syncthreads();
  const float* w2 = (kv ? P.w2_v : P.w2_k) + (size_t)l * 128 * 64;
  const int c = tid & 63, rg = tid >> 6;
  float o[32];
#pragma unroll
  for (int i = 0; i < 32; ++i) o[i] = 0.f;
  for (int j = 0; j < 128; ++j) { float w = w2[j * 64 + c];
#pragma unroll
    for (int i = 0; i < 32; ++i) o[i] += H[(rg * 32 + i) * 129 + j] * w; }
  if (kv == 0) { bf16_t* dst = (bf16_t*)(P.ws + OFF_KC) + (size_t)bg * 512 * 64;
#pragma unroll
    for (int i = 0; i < 32; ++i) { int n = 128 * mt + rg * 32 + i; dst[(size_t)n * 64 + c] = f2bf(o[i]); } }
  else { bf16_t* dst = (bf16_t*)(P.ws + OFF_VCC) + (size_t)bg * 64 * 512;
#pragma unroll
    for (int i = 0; i < 32; ++i) { int n = 128 * mt + rg * 32 + i; dst[(size_t)c * 512 + n] = f2bf(o[i]); } }
  __syncthreads();
}

DI void cumsum_seq(const Params& P, int bh, char* lds) {
  const int tid = get_tid();
  const float* src = (const float*)(P.ws + OFF_LOGF) + (size_t)bh * SEQ + tid * 32;
  float* dst = (float*)(P.ws + OFF_CUM) + (size_t)bh * SEQ + tid * 32;
  float* tot = (float*)lds;
  f32x4 v[8]; float s = 0.f;
#pragma unroll
  for (int k = 0; k < 8; ++k) { v[k] = *(const f32x4*)(src + 4 * k);
#pragma unroll
    for (int e = 0; e < 4; ++e) { s += v[k][e]; v[k][e] = s; } }
  __syncthreads();
  tot[tid] = s;
  __syncthreads();
  float base = 0.f;
  for (int i = 0; i < tid; ++i) base += tot[i];
#pragma unroll
  for (int k = 0; k < 8; ++k) { f32x4 o;
#pragma unroll
    for (int e = 0; e < 4; ++e) o[e] = v[k][e] + base;
    *(f32x4*)(dst + 4 * k) = o; }
  __syncthreads();
}

DI int next_unit(unsigned* ctr, int* s_unit) {
  __syncthreads();
  if (get_tid() == 0) *s_unit = (int)atomicAdd(ctr, 1u);
  __syncthreads();
  return *s_unit;
}

DI void p2_phase(const Params& P, int l, char* lds, int* s_unit, int rep = 0) {
  unsigned* ctr = (unsigned*)(P.ws + OFF_CTR) + (l * 4 + 0 + 16 * rep);
  for (;;) {
    int u = next_unit(ctr, s_unit);
    if (u >= 32 + 8 + 1024) break;
    if (u < 32) compress_tile(P, l, u, lds);
    else if (u < 40) cumsum_seq(P, u - 32, lds);
    else { int v = u - 40; diff_unit(P, l, v & 7, 127 - (v >> 3), lds); }
  }
}
DI void p3_phase(const Params& P, int l, char* lds, int* s_unit, int rep = 0) {
  unsigned* ctr = (unsigned*)(P.ws + OFF_CTR) + (l * 4 + 1 + 16 * rep);
  for (;;) {
    int u = next_unit(ctr, s_unit);
    if (u >= 512 + 1024) break;
#ifndef NO_FOX
    if (u < 512) fox_unit(P, u & 7, 63 - (u >> 3), lds);
#endif
#ifndef NO_NSA
    if (u >= 512) { int v = u - 512; nsa_unit(P, v & 3, 255 - (v >> 2), lds); }
#endif
  }
}

template <int KIND> DI void run_phase(const Params& P, int l, char* lds, int* s_unit, int rep = 0) {
  if constexpr (KIND == 0) p0_prologue(P);
  else if constexpr (KIND == 1) p1_inproj(P, l, lds);
  else if constexpr (KIND == 2) p2_phase(P, l, lds, s_unit, rep);
  else if constexpr (KIND == 3) p3_phase(P, l, lds, s_unit, rep);
  else if constexpr (KIND == 4) p4_outproj(P, l, lds);
  else p5_ln(P, l);
}
template <int KIND> __global__ void __launch_bounds__(NTHREADS, 2) phase_kernel(Params P, int l) {
  __shared__ __attribute__((aligned(16))) char lds[LDS_BYTES + LDS_CTL];
  run_phase<KIND>(P, l, lds, (int*)(lds + LDS_BYTES));
}
#if COOP
#define GSYNC() do { asm volatile("" ::: "memory"); cg::this_grid().sync(); asm volatile("" ::: "memory"); } while (0)
#define XB_TMO      128
#define XB_XCNT(j)  (256  + 64 * (j))
#define XB_XSUB(j)  (1280 + 64 * (j))
#define XB_XGEN(j)  (2304 + 64 * (j))
#define XB_TOP      3328
#define XB_TOPGEN   3392
#define XCD_BAR_WORDS 3456
#define XB_SPIN_CAP (1u << 22)
#define LAS __attribute__((address_space(3)))
DI unsigned xb_ld(unsigned* p) { return __hip_atomic_load(p, __ATOMIC_RELAXED, __HIP_MEMORY_SCOPE_AGENT); }
DI unsigned xb_add(unsigned* p, unsigned v) { return __hip_atomic_fetch_add(p, v, __ATOMIC_RELAXED, __HIP_MEMORY_SCOPE_AGENT); }
DI unsigned xb_xcc_id() { return (unsigned)__builtin_amdgcn_s_getreg((3 << 11) | 20) & 0xFu; }
#define XB_SPIN(cond, bar) do { unsigned _sp = 0; while (cond) { __builtin_amdgcn_s_sleep(1); \
    if ((++_sp & 255u) == 0u) { if (xb_ld(&(bar)[XB_TMO])) break; if (_sp > XB_SPIN_CAP) { atomicAdd(&(bar)[XB_TMO], 1u); break; } } } } while (0)
struct XcdBarrier { unsigned* bar; unsigned x; volatile LAS unsigned* st; };
DI XcdBarrier xcd_barrier_post(unsigned* bar, volatile LAS unsigned* st) {
  XcdBarrier b; b.bar = bar; b.x = xb_xcc_id(); b.st = st;
  if (threadIdx.x == 0) (void)xb_add(&bar[XB_XCNT(b.x)], 1u);
  return b;
}
DI void xcd_barrier_complete(unsigned* bar, unsigned x, unsigned& nloc, unsigned& nx) {
  const unsigned G = gridDim.x * gridDim.y * gridDim.z;
  unsigned sum, cnt, mine, sp = 0u;
  for (;;) {
    sum = 0u; cnt = 0u; mine = 0u;
#pragma unroll
    for (unsigned j = 0; j < 16; ++j) { const unsigned c = xb_ld(&bar[XB_XCNT(j)]); sum += c; cnt += (c > 0u) ? 1u : 0u; mine = (j == x) ? c : mine; }
    if (sum == G) break;
    __builtin_amdgcn_s_sleep(1);
    if ((++sp & 255u) == 0u) { if (xb_ld(&bar[XB_TMO])) break; if (sp > XB_SPIN_CAP) { atomicAdd(&bar[XB_TMO], 1u); break; } }
  }
  nloc = mine > 0u ? mine : 1u; nx = cnt > 0u ? cnt : 1u;
}
DI void xcd_barrier(const XcdBarrier& b) {
  asm volatile("s_waitcnt vmcnt(0)" ::: "memory");
  __syncthreads();
  if (threadIdx.x == 0) {
    unsigned* bar = b.bar;
    __builtin_amdgcn_s_waitcnt(0);
    unsigned nloc = b.st[0], nx = b.st[1];
    if (nloc == 0u) { xcd_barrier_complete(bar, b.x, nloc, nx); b.st[0] = nloc; b.st[1] = nx; }
    const unsigned old = xb_add(&bar[XB_XSUB(b.x)], 1u);
    const unsigned gen = old / nloc;
    if (old + 1u == (gen + 1u) * nloc) {
      __builtin_amdgcn_fence(__ATOMIC_RELEASE, "agent");
      asm volatile("s_waitcnt vmcnt(0)" ::: "memory");
      const unsigned og = xb_add(&bar[XB_TOP], 1u);
      const unsigned tg = og / nx;
      if (og + 1u == (tg + 1u) * nx) xb_add(&bar[XB_TOPGEN], 1u);
      else XB_SPIN(xb_ld(&bar[XB_TOPGEN]) == tg, bar);
      __builtin_amdgcn_fence(__ATOMIC_ACQUIRE, "agent");
      xb_add(&bar[XB_XGEN(b.x)], 1u);
      asm volatile("s_waitcnt vmcnt(0)" ::: "memory");
    } else {
      XB_SPIN(xb_ld(&bar[XB_XGEN(b.x)]) == gen, bar);
      __builtin_amdgcn_fence(__ATOMIC_ACQUIRE, "agent");
      asm volatile("s_waitcnt vmcnt(0)" ::: "memory");
    }
  }
  __syncthreads();
}
#ifndef CG_ALL
#define BSYNC() do { asm volatile("" ::: "memory"); xcd_barrier(xb); asm volatile("" ::: "memory"); } while (0)
#else
#define BSYNC() GSYNC()
#endif
__global__ void __launch_bounds__(NTHREADS, 2) fwd_kernel(Params P) {
  __shared__ __attribute__((aligned(16))) char lds[LDS_BYTES + LDS_CTL];
  int* const s_unit_p = (int*)(lds + LDS_BYTES);
  if (threadIdx.x == 0) *(uint4*)(lds + LDS_BYTES + 16) = make_uint4(0u, 0u, 0u, 0u);
  __syncthreads();
  const XcdBarrier xb = xcd_barrier_post((unsigned*)(P.ws + OFF_BAR), (volatile LAS unsigned*)(lds + LDS_BYTES + 16));
  if (P.pad_ == 0x5eed) GSYNC();
  run_phase<0>(P, 0, lds, s_unit_p); BSYNC();
  for (int l = 0; l < DEPTH; ++l) {
    run_phase<1>(P, l, lds, s_unit_p); BSYNC();
#if REPEAT == 1
    run_phase<1>(P, l, lds, s_unit_p, 1); BSYNC();
#endif
    run_phase<2>(P, l, lds, s_unit_p); BSYNC();
#if REPEAT == 2
    run_phase<2>(P, l, lds, s_unit_p, 1); BSYNC();
#endif
    run_phase<3>(P, l, lds, s_unit_p); BSYNC();
#if REPEAT == 3
    run_phase<3>(P, l, lds, s_unit_p, 1); BSYNC();
#endif
    run_phase<4>(P, l, lds, s_unit_p); BSYNC();
    run_phase<5>(P, l, lds, s_unit_p); if (l + 1 < DEPTH) BSYNC();
  }
}
#endif

extern "C" void kernel_launch(void* const* d_in, const int* in_sizes, int n_in, void* d_out, int out_size, void* d_ws, size_t ws_size, hipStream_t stream) {
  static int grid_blocks = 0;
  if (!grid_blocks) {
    int dev = 0, cus = 0, per_cu = 0;
    (void)hipGetDevice(&dev);
    (void)hipDeviceGetAttribute(&cus, hipDeviceAttributeMultiprocessorCount, dev);
#if COOP
    (void)hipOccupancyMaxActiveBlocksPerMultiprocessor(&per_cu, fwd_kernel, NTHREADS, 0);
#else
    per_cu = 2;
#endif
    if (per_cu < 1) per_cu = 1;
    if (per_cu > 2) per_cu = 2;
    if (cus < 1) cus = 256;
    grid_blocks = cus * per_cu;
  }
  if (n_in != 17 || ws_size < WS_NEED) { fprintf(stderr, "kernel_launch: unexpected inputs (%d) or workspace (%zu)\n", n_in, ws_size); return; }
  Params p{};
  p.x = (const float*)d_in[0]; p.w_in = (const float*)d_in[1]; p.b_fox_f = (const float*)d_in[2]; p.pos_k = (const float*)d_in[3]; p.pos_v = (const float*)d_in[4];
  p.w1_k = (const float*)d_in[5]; p.w2_k = (const float*)d_in[6]; p.w1_v = (const float*)d_in[7]; p.w2_v = (const float*)d_in[8];
  p.lq1 = (const float*)d_in[9]; p.lk1 = (const float*)d_in[10]; p.lq2 = (const float*)d_in[11]; p.lk2 = (const float*)d_in[12];
  p.subln_g = (const float*)d_in[13]; p.w_out = (const float*)d_in[14]; p.ln_g = (const float*)d_in[15]; p.ln_b = (const float*)d_in[16];
  p.out = (float*)d_out; p.ws = (char*)d_ws;
  (void)hipMemsetAsync((char*)d_ws + OFF_CTR, 0, 4096, stream);
  (void)hipMemsetAsync((char*)d_ws + OFF_BAR, 0, CTL_ZERO_BYTES - OFF_BAR, stream);
#if COOP
  void* args[] = {&p};
  hipError_t e = hipLaunchCooperativeKernel((void*)fwd_kernel, dim3(grid_blocks), dim3(NTHREADS), args, 0, stream);
  if (e != hipSuccess) fprintf(stderr, "cooperative launch failed: %s (grid %d)\n", hipGetErrorString(e), grid_blocks);
#else
  const dim3 g(grid_blocks), b(NTHREADS);
  hipLaunchKernelGGL(phase_kernel<0>, g, b, 0, stream, p, 0);
  for (int l = 0; l < DEPTH; ++l) {
    hipLaunchKernelGGL(phase_kernel<1>, g, b, 0, stream, p, l);
    hipLaunchKernelGGL(phase_kernel<2>, g, b, 0, stream, p, l);
    hipLaunchKernelGGL(phase_kernel<3>, g, b, 0, stream, p, l);
    hipLaunchKernelGGL(phase_kernel<4>, g, b, 0, stream, p, l);
    hipLaunchKernelGGL(phase_kernel<5>, g, b, 0, stream, p, l);
  }
#endif
}
```

```cpp
#include <hip/hip_runtime.h>
#include <hip/hip_cooperative_groups.h>
#include <stdint.h>
#include <cstdio>
namespace cg = cooperative_groups;

#ifndef COOP
#define COOP 1
#endif
#ifndef REPEAT
#define REPEAT 0
#endif

#define DI __device__ __forceinline__
typedef unsigned short bf16_t;
typedef short bf16x8 __attribute__((ext_vector_type(8)));
typedef short s16x4 __attribute__((ext_vector_type(4)));
typedef float f32x16 __attribute__((ext_vector_type(16)));
typedef float f32x4 __attribute__((ext_vector_type(4)));
typedef float f32x2 __attribute__((ext_vector_type(2)));
typedef unsigned u32x4 __attribute__((ext_vector_type(4)));
typedef unsigned u32x2 __attribute__((ext_vector_type(2)));
typedef __bf16 bf16x2_t __attribute__((ext_vector_type(2)));

#define MFMA32(a, b, c) __builtin_amdgcn_mfma_f32_32x32x16_bf16((a), (b), (c), 0, 0, 0)

constexpr int BATCH = 2, SEQ = 8192, DMODEL = 1024, MTOK = BATCH * SEQ, NIN = 3868, NPAD = 3968, DEPTH = 2;
constexpr float LOG2E = 1.4426950408889634f;
constexpr float NEGBIG = -1e30f;
constexpr float MINIT = -1e20f;
constexpr int NTHREADS = 256;

constexpr size_t MiB = 1u << 20;
constexpr size_t OFF_CTR = 0, OFF_LAM = 4096, OFF_B1 = 8192, OFF_BAR = 16384, CTL_ZERO_BYTES = 32768;
constexpr size_t OFF_ROPE64 = 1 * MiB, OFF_ROPE32 = 3 * MiB, OFF_WIN = 4 * MiB, OFF_WOUT = 20 * MiB, OFF_W1T = 24 * MiB;
constexpr size_t OFF_XB = 26 * MiB, OFF_G = 58 * MiB, OFF_MIX = 90 * MiB;
constexpr size_t OFF_QF = 122 * MiB, OFF_KF = 130 * MiB, OFF_VFT = 138 * MiB, OFF_QN = 146 * MiB;
constexpr size_t OFF_KCT = 162 * MiB, OFF_VCT = 166 * MiB, OFF_KS = 170 * MiB, OFF_VST = 174 * MiB, OFF_KW = 178 * MiB, OFF_VWT = 182 * MiB;
constexpr size_t OFF_QD = 186 * MiB, OFF_KD = 194 * MiB, OFF_VDT = 202 * MiB;
constexpr size_t OFF_LOGF = 210 * MiB, OFF_CUM = 210 * MiB + 256 * 1024, OFF_GATES = 211 * MiB;
constexpr size_t OFF_KC = 213 * MiB, OFF_VCC = 213 * MiB + 256 * 1024, WS_NEED = 214 * MiB;

constexpr int LDS_BYTES = 73728, LDS_CTL = 32;
constexpr int ATT_BUF = 18944, ATT_V = 9216, ATT_C = 18432;
constexpr int LDS_IMP = 3 * ATT_BUF, LDS_SEL = LDS_BYTES - 512;
static_assert(LDS_IMP + 16384 <= LDS_SEL, "LDS map");
constexpr int GEMM_AB = 18432;

struct Params {
  const float *x, *w_in, *b_fox_f, *pos_k, *pos_v, *w1_k, *w2_k, *w1_v, *w2_v, *lq1, *lk1, *lq2, *lk2, *subln_g, *w_out, *ln_g, *ln_b;
  float* out;
  char* ws;
  long pad_;
};

DI unsigned short f2bf(float f) { unsigned u = __float_as_uint(f); return (unsigned short)((u + 0x7fffu + ((u >> 16) & 1u)) >> 16); }
DI unsigned pk2(float lo, float hi) { f32x2 v = {lo, hi}; bf16x2_t b = __builtin_convertvector(v, bf16x2_t); return __builtin_bit_cast(unsigned, b); }
DI float silu(float x) { return x / (1.f + __expf(-x)); }
DI float sigmoidf(float x) { return 1.f / (1.f + __expf(-x)); }
DI float ex2(float x) { return __builtin_amdgcn_exp2f(x); }
DI float xhalf_max(float v) { auto rr = __builtin_amdgcn_permlane32_swap(__float_as_uint(v), __float_as_uint(v), false, false); return fmaxf(__uint_as_float(rr[0]), __uint_as_float(rr[1])); }
DI float xhalf_sum(float v) { auto rr = __builtin_amdgcn_permlane32_swap(__float_as_uint(v), __float_as_uint(v), false, false); return __uint_as_float(rr[0]) + __uint_as_float(rr[1]); }
DI int crow(int i, int h) { return (i & 3) + 8 * (i >> 2) + 4 * h; }

DI int get_tid() { int t = threadIdx.x; asm volatile("" : "+v"(t)); return t; }
DI int orig_col(int n) {
  int s = n >> 6, c = n & 63;
  if (s < 4) return s * 64 + c;
  if (s < 8) return 256 + (s - 4) * 64 + c;
  if (s < 12) return 512 + (s - 8) * 64 + c;
  if (s < 16) return 772 + (s - 12) * 64 + c;
  if (s < 24) return 1028 + (s - 16) * 64 + c;
  if (s < 36) return 1540 + (s - 24) * 64 + c;
  if (s < 44) return 2332 + (s - 36) * 64 + c;
  if (s < 52) { int base = 2844 + (s - 44) * 64; int nt = c >> 5, r = c & 31, comp = r >> 4, i = r & 15; return base + comp * 32 + nt * 16 + i; }
  if (s < 60) return 3356 + (s - 52) * 64 + c;
  if (s == 60) { if (c < 4) return 768 + c; if (c < 28) return 2308 + (c - 4); return -1; }
  return -1;
}

DI void p0_prologue(const Params& P) {
  const long gtid = (long)blockIdx.x * NTHREADS + get_tid(), gsz = (long)gridDim.x * NTHREADS;
  char* ws = P.ws;
  if (gtid < DEPTH) {
    int l = (int)gtid; float a = 0.f, b = 0.f;
    for (int i = 0; i < 32; ++i) { a += P.lq1[l * 32 + i] * P.lk1[l * 32 + i]; b += P.lq2[l * 32 + i] * P.lk2[l * 32 + i]; }
    float lam_init = 0.8f - 0.6f * expf(-0.3f * (float)l);
    ((float*)(ws + OFF_LAM))[l] = expf(a) - expf(b) + lam_init;
    ((float*)(ws + OFF_LAM))[2 + l] = lam_init;
  }
  for (long it = gtid; it < DEPTH * 2 * 128; it += gsz) {
    int j = it & 127, kv = (it >> 7) & 1, l = (int)(it >> 8);
    const float* pos = (kv ? P.pos_v : P.pos_k) + (size_t)l * 2048;
    const float* w1 = (kv ? P.w1_v : P.w1_k) + (size_t)l * 2048 * 128;
    float a = 0.f;
    for (int k = 0; k < 2048; ++k) a += pos[k] * w1[(size_t)k * 128 + j];
    ((float*)(ws + OFF_B1))[it] = a;
  }
  for (long it = gtid; it < (long)SEQ * 48; it += gsz) {
    int s = (int)(it / 48), i = (int)(it % 48);
    float inv; f32x2* dst;
    if (i < 32) { inv = powf(10000.f, -((float)i * 2.0f / 64.f)); dst = (f32x2*)(ws + OFF_ROPE64) + (size_t)s * 32 + i; }
    else { int ii = i - 32; inv = powf(10000.f, -((float)ii * 2.0f / 32.f)); dst = (f32x2*)(ws + OFF_ROPE32) + (size_t)s * 16 + ii; }
    float ang = (float)s * inv;
    double t = (double)ang * 0.15915494309189535; double fr = t - floor(t); float f = (float)fr;
    f32x2 cs = {__builtin_amdgcn_cosf(f), __builtin_amdgcn_sinf(f)};
    *dst = cs;
  }
  for (long it = gtid; it < (long)DEPTH * 128 * NPAD; it += gsz) {
    int n = (int)(it % NPAD); int k8 = (int)((it / NPAD) & 127); int l = (int)(it / ((long)NPAD * 128));
    int oc = orig_col(n);
    u32x4 v = {0u, 0u, 0u, 0u};
    if (oc >= 0) { const float* src = P.w_in + (size_t)l * DMODEL * NIN + (size_t)(k8 * 8) * NIN + oc;
      float f[8];
#pragma unroll
      for (int j = 0; j < 8; ++j) f[j] = src[(size_t)j * NIN];
      v.x = pk2(f[0], f[1]); v.y = pk2(f[2], f[3]); v.z = pk2(f[4], f[5]); v.w = pk2(f[6], f[7]); }
    *(u32x4*)((bf16_t*)(ws + OFF_WIN) + ((size_t)l * NPAD + n) * DMODEL + k8 * 8) = v;
  }
  for (long it = gtid; it < (long)DEPTH * 128 * 1024; it += gsz) {
    int n = (int)(it & 1023); int k8 = (int)((it >> 10) & 127); int l = (int)(it >> 17);
    const float* src = P.w_out + (size_t)l * 1024 * 1024 + (size_t)(k8 * 8) * 1024 + n;
    float f[8];
#pragma unroll
    for (int j = 0; j < 8; ++j) f[j] = src[(size_t)j * 1024];
    u32x4 v; v.x = pk2(f[0], f[1]); v.y = pk2(f[2], f[3]); v.z = pk2(f[4], f[5]); v.w = pk2(f[6], f[7]);
    *(u32x4*)((bf16_t*)(ws + OFF_WOUT) + ((size_t)l * 1024 + n) * 1024 + k8 * 8) = v;
  }
  for (long it = gtid; it < (long)DEPTH * 2 * 256 * 128; it += gsz) {
    int j = (int)(it & 127); int k8 = (int)((it >> 7) & 255); int kv = (int)((it >> 15) & 1); int l = (int)(it >> 16);
    const float* src = (kv ? P.w1_v : P.w1_k) + (size_t)l * 2048 * 128 + (size_t)(k8 * 8) * 128 + j;
    float f[8];
#pragma unroll
    for (int jj = 0; jj < 8; ++jj) f[jj] = src[(size_t)jj * 128];
    u32x4 v; v.x = pk2(f[0], f[1]); v.y = pk2(f[2], f[3]); v.z = pk2(f[4], f[5]); v.w = pk2(f[6], f[7]);
    *(u32x4*)((bf16_t*)(ws + OFF_W1T) + (((size_t)l * 2 + kv) * 128 + j) * 2048 + k8 * 8) = v;
  }
  for (long it = gtid; it < (long)MTOK * DMODEL / 8; it += gsz) {
    const f32x4* src = (const f32x4*)P.x + it * 2; f32x4 a = src[0], b = src[1];
    u32x4 v; v.x = pk2(a[0], a[1]); v.y = pk2(a[2], a[3]); v.z = pk2(b[0], b[1]); v.w = pk2(b[2], b[3]);
    *((u32x4*)(ws + OFF_XB) + it) = v;
  }
}

#define LDSAS __attribute__((address_space(3)))
DI void glds16(const char* gsrc, char* ldst) {
  __builtin_amdgcn_global_load_lds((const unsigned*)gsrc, (LDSAS unsigned*)ldst, 16, 0, 0);
}
DI void gemm_mainloop(const bf16_t* A, long lda, int a_row_max, const bf16_t* Bt, long ldb, int K, char* lds, f32x16 (&acc)[2][2]) {
  const int tid = get_tid(), lane = tid & 63, wave = __builtin_amdgcn_readfirstlane(tid >> 6), wm = wave >> 1, wn = wave & 1, r = lane & 31, h = lane >> 5;
#pragma unroll
  for (int a = 0; a < 2; ++a)
#pragma unroll
    for (int b = 0; b < 2; ++b)
#pragma unroll
      for (int i = 0; i < 16; ++i) acc[a][b][i] = 0.f;
  const char* ga[4]; const char* gb[4];
#pragma unroll
  for (int i = 0; i < 4; ++i) { const int row = 32 * wave + 8 * i + (lane >> 3), ch = (lane & 7) ^ ((row >> 1) & 7); const int ar = row < a_row_max ? row : a_row_max;
    ga[i] = (const char*)(A + (long)ar * lda) + ch * 16; gb[i] = (const char*)(Bt + (long)row * ldb) + ch * 16; }
  char* const ldw = lds + (32 * wave) * 128;
  const int nk = K >> 6;
#define GEMM_STAGE(BUF, KT) do { _Pragma("unroll") for (int i = 0; i < 4; ++i) { \
    glds16(ga[i] + (long)(KT) * 128, ldw + (BUF) * 32768 + i * 1024); glds16(gb[i] + (long)(KT) * 128, ldw + (BUF) * 32768 + 16384 + i * 1024); } } while (0)
  __syncthreads();
  GEMM_STAGE(0, 0);
  asm volatile("s_waitcnt vmcnt(0)" ::: "memory");
  __syncthreads();
  const int sw = (r >> 1) & 7;
  const unsigned lds0 = (unsigned)(uintptr_t)lds;
  unsigned aa[4], ab[4];
#pragma unroll
  for (int ks = 0; ks < 4; ++ks) { const unsigned xo = (unsigned)(((2 * ks + h) ^ sw) * 16);
    aa[ks] = lds0 + (unsigned)((64 * wm + r) * 128) + xo; ab[ks] = lds0 + 16384u + (unsigned)((64 * wn + r) * 128) + xo; }
  bf16x8 xa0, xa1, xb0, xb1, ya0, ya1, yb0, yb1, za0, za1, zb0, zb1;
#define KT_RD(S, K, O0, O1) \
    "ds_read_b128 %[" #S "a0], %[aa" #K "] offset:" O0 "\n\tds_read_b128 %[" #S "b0], %[ab" #K "] offset:" O0 "\n\t" \
    "ds_read_b128 %[" #S "a1], %[aa" #K "] offset:" O1 "\n\tds_read_b128 %[" #S "b1], %[ab" #K "] offset:" O1 "\n\t"
#define KT_MM(S) \
    "v_mfma_f32_32x32x16_bf16 %[c00], %[" #S "a0], %[" #S "b0], %[c00]\n\tv_mfma_f32_32x32x16_bf16 %[c01], %[" #S "a0], %[" #S "b1], %[c01]\n\t" \
    "v_mfma_f32_32x32x16_bf16 %[c10], %[" #S "a1], %[" #S "b0], %[c10]\n\tv_mfma_f32_32x32x16_bf16 %[c11], %[" #S "a1], %[" #S "b1], %[c11]\n\t"
#define KT_ASM(O0, O1) asm volatile( \
    "s_waitcnt lgkmcnt(0)\n\t" \
    KT_RD(x, 0, O0, O1) KT_RD(y, 1, O0, O1) \
    "s_waitcnt lgkmcnt(4)\n\t" KT_MM(x) KT_RD(z, 2, O0, O1) \
    "s_waitcnt lgkmcnt(4)\n\t" KT_MM(y) KT_RD(x, 3, O0, O1) \
    "s_waitcnt lgkmcnt(4)\n\t" KT_MM(z) \
    "s_waitcnt lgkmcnt(0)\n\t" KT_MM(x) \
    : [c00] "+v"(acc[0][0]), [c01] "+v"(acc[0][1]), [c10] "+v"(acc[1][0]), [c11] "+v"(acc[1][1]), \
      [xa0] "=&v"(xa0), [xa1] "=&v"(xa1), [xb0] "=&v"(xb0), [xb1] "=&v"(xb1), [ya0] "=&v"(ya0), [ya1] "=&v"(ya1), [yb0] "=&v"(yb0), [yb1] "=&v"(yb1), \
      [za0] "=&v"(za0), [za1] "=&v"(za1), [zb0] "=&v"(zb0), [zb1] "=&v"(zb1) \
    : [aa0] "v"(aa[0]), [aa1] "v"(aa[1]), [aa2] "v"(aa[2]), [aa3] "v"(aa[3]), [ab0] "v"(ab[0]), [ab1] "v"(ab[1]), [ab2] "v"(ab[2]), [ab3] "v"(ab[3]) \
    : "memory")
  for (int kt = 0; kt < nk; kt += 2) {
    GEMM_STAGE(1, kt + 1);
    KT_ASM("0", "4096");
    asm volatile("s_waitcnt vmcnt(0)" ::: "memory");
    __syncthreads();
    if (kt + 2 < nk) GEMM_STAGE(0, kt + 2);
    KT_ASM("32768", "36864");
    asm volatile("s_waitcnt vmcnt(0)" ::: "memory");
    __syncthreads();
  }
  asm volatile("s_nop 15\n\ts_nop 7" : "+v"(acc[0][0]), "+v"(acc[0][1]), "+v"(acc[1][0]), "+v"(acc[1][1]));
#undef KT_RD
#undef KT_MM
#undef KT_ASM
#undef GEMM_STAGE
}

DI bool xcd_tile(int i, int NT, int& mt, int& nt) {
  const int G = gridDim.x;
  if ((G & 7) == 0 && G >= 8) {
    const int x = blockIdx.x & 7, j = blockIdx.x >> 3, per = G >> 3;
    const int u = j + per * i; if (u >= 16 * NT) return false;
    const int grp = u / (8 * NT), v = u - grp * (8 * NT);
    mt = 16 * x + 8 * grp + (v & 7); nt = v >> 3; return true;
  }
  const int t = blockIdx.x + G * i; if (t >= 128 * NT) return false;
  mt = t / NT; nt = t - mt * NT; return true;
}

DI void epi_inproj(const Params& P, int l, const f32x16 (&acc)[2][2], int m0, int n0) {
  const int tid = get_tid(), lane = tid & 63, wave = tid >> 6, wm = wave >> 1, wn = wave & 1, r = lane & 31, h = lane >> 5;
  char* ws = P.ws;
  const int slot = (n0 >> 6) + wn;
  const int b = m0 >> 13;
  const int srow0 = (m0 & (SEQ - 1)) + 64 * wm;
  int cat = 0;
  int rope = 0; float scale = 1.f; bf16_t* dst = nullptr; int gcol = 0;
  const float QS = 0.125f * LOG2E;
  if (slot < 4) { cat = 1; scale = QS; dst = (bf16_t*)(ws + OFF_QF) + (size_t)(b * 4 + slot) * SEQ * 64; }
  else if (slot < 8) { cat = 1; dst = (bf16_t*)(ws + OFF_KF) + (size_t)(b * 4 + slot - 4) * SEQ * 64; }
  else if (slot < 12) { cat = 2; dst = (bf16_t*)(ws + OFF_VFT) + (size_t)(b * 4 + slot - 8) * SEQ * 64; }
  else if (slot < 16) { cat = 3; gcol = (slot - 12) * 64; }
  else if (slot < 24) { cat = 1; rope = 1; scale = QS; dst = (bf16_t*)(ws + OFF_QN) + (size_t)(b * 8 + slot - 16) * SEQ * 64; }
  else if (slot < 26) { cat = 1; rope = 1; dst = (bf16_t*)(ws + OFF_KCT) + (size_t)(b * 2 + slot - 24) * SEQ * 64; }
  else if (slot < 28) { cat = 1; dst = (bf16_t*)(ws + OFF_VCT) + (size_t)(b * 2 + slot - 26) * SEQ * 64; }
  else if (slot < 30) { cat = 1; rope = 1; dst = (bf16_t*)(ws + OFF_KS) + (size_t)(b * 2 + slot - 28) * SEQ * 64; }
  else if (slot < 32) { cat = 2; dst = (bf16_t*)(ws + OFF_VST) + (size_t)(b * 2 + slot - 30) * SEQ * 64; }
  else if (slot < 34) { cat = 1; rope = 1; dst = (bf16_t*)(ws + OFF_KW) + (size_t)(b * 2 + slot - 32) * SEQ * 64; }
  else if (slot < 36) { cat = 2; dst = (bf16_t*)(ws + OFF_VWT) + (size_t)(b * 2 + slot - 34) * SEQ * 64; }
  else if (slot < 44) { cat = 3; gcol = 256 + (slot - 36) * 64; }
  else if (slot < 48) { cat = 1; rope = 2; scale = 0.17677669529663687f * LOG2E; dst = (bf16_t*)(ws + OFF_QD) + (size_t)(b * 4 + slot - 44) * SEQ * 64; }
  else if (slot < 52) { cat = 1; rope = 2; dst = (bf16_t*)(ws + OFF_KD) + (size_t)(b * 4 + slot - 48) * SEQ * 64; }
  else if (slot < 56) { cat = 2; dst = (bf16_t*)(ws + OFF_VDT) + (size_t)(b * 4 + slot - 52) * SEQ * 64; }
  else if (slot < 60) { cat = 3; gcol = 768 + (slot - 56) * 64; }
  else if (slot == 60) cat = 4;

  if (cat == 1) {
    int c0 = r, c1 = 32 + r;
    if (rope == 2) { int comp = r >> 4, ii = r & 15; c0 = comp * 32 + ii; c1 = comp * 32 + 16 + ii; }
    const f32x2* tab = (rope == 1) ? ((const f32x2*)(ws + OFF_ROPE64) + r) : ((const f32x2*)(ws + OFF_ROPE32) + (r & 15));
    const int tstride = (rope == 1) ? 32 : 16;
#pragma unroll
    for (int mt = 0; mt < 2; ++mt)
#pragma unroll
      for (int i = 0; i < 16; ++i) {
        int s = srow0 + 32 * mt + crow(i, h);
        float v0 = acc[mt][0][i], v1 = acc[mt][1][i];
        if (rope) { f32x2 cs = tab[(size_t)s * tstride]; float y0 = v0 * cs[0] - v1 * cs[1], y1 = v1 * cs[0] + v0 * cs[1]; v0 = y0; v1 = y1; }
        v0 *= scale; v1 *= scale;
        dst[(size_t)s * 64 + c0] = f2bf(v0); dst[(size_t)s * 64 + c1] = f2bf(v1);
      }
  } else if (cat == 2) {
#pragma unroll
    for (int mt = 0; mt < 2; ++mt)
#pragma unroll
      for (int g = 0; g < 4; ++g) {
        int s = srow0 + 32 * mt + 8 * g + 4 * h;
#pragma unroll
        for (int nt = 0; nt < 2; ++nt) {
          u32x2 v; v.x = pk2(acc[mt][nt][4 * g], acc[mt][nt][4 * g + 1]); v.y = pk2(acc[mt][nt][4 * g + 2], acc[mt][nt][4 * g + 3]);
          *(u32x2*)(dst + (size_t)(32 * nt + r) * SEQ + s) = v;
        }
      }
  } else if (cat == 3) {
    bf16_t* G = (bf16_t*)(ws + OFF_G);
#pragma unroll
    for (int mt = 0; mt < 2; ++mt)
#pragma unroll
      for (int i = 0; i < 16; ++i) {
        size_t row = (size_t)m0 + 64 * wm + 32 * mt + crow(i, h);
        G[row * 1024 + gcol + r] = f2bf(silu(acc[mt][0][i])); G[row * 1024 + gcol + 32 + r] = f2bf(silu(acc[mt][1][i]));
      }
  } else if (cat == 4) {
    if (r < 28) {
      float bias = (r < 4) ? P.b_fox_f[l * 4 + r] : 0.f;
#pragma unroll
      for (int mt = 0; mt < 2; ++mt)
#pragma unroll
        for (int i = 0; i < 16; ++i) {
          int s = srow0 + 32 * mt + crow(i, h);
          float v = acc[mt][0][i];
          if (r < 4) { float xx = v + bias; float ls = fminf(xx, 0.f) - log1pf(expf(-fabsf(xx)));
            ((float*)(ws + OFF_LOGF))[(size_t)(b * 4 + r) * SEQ + s] = ls * LOG2E; }
          else ((float*)(ws + OFF_GATES))[((size_t)b * SEQ + s) * 24 + (r - 4)] = sigmoidf(v);
        }
    }
  }
}

DI void p1_inproj(const Params& P, int l, char* lds) {
  const bf16_t* A = (const bf16_t*)(P.ws + OFF_XB);
  const bf16_t* Bt = (const bf16_t*)(P.ws + OFF_WIN) + (size_t)l * NPAD * DMODEL;
  const int NT = NPAD / 128;
  int mt, nt;
  for (int i = 0; xcd_tile(i, NT, mt, nt); ++i) {
    f32x16 acc[2][2];
    gemm_mainloop(A + (size_t)mt * 128 * DMODEL, DMODEL, 127, Bt + (size_t)nt * 128 * DMODEL, DMODEL, DMODEL, lds, acc);
    epi_inproj(P, l, acc, mt * 128, nt * 128);
  }
}

DI void p4_outproj(const Params& P, int l, char* lds) {
  const bf16_t* A = (const bf16_t*)(P.ws + OFF_MIX);
  const bf16_t* Bt = (const bf16_t*)(P.ws + OFF_WOUT) + (size_t)l * 1024 * 1024;
  const float* xres = (l == 0) ? P.x : P.out;
  const float alpha = 1.4142135623730951f;
  const int tid = get_tid(), lane = tid & 63, wave = tid >> 6, wm = wave >> 1, wn = wave & 1, r = lane & 31, h = lane >> 5;
  int mt, nt;
  for (int i = 0; xcd_tile(i, 8, mt, nt); ++i) {
    f32x16 acc[2][2];
    gemm_mainloop(A + (size_t)mt * 128 * 1024, 1024, 127, Bt + (size_t)nt * 128 * 1024, 1024, 1024, lds, acc);
#pragma unroll
    for (int a = 0; a < 2; ++a)
#pragma unroll
      for (int bb = 0; bb < 2; ++bb)
#pragma unroll
        for (int i = 0; i < 16; ++i) {
          size_t row = (size_t)mt * 128 + 64 * wm + 32 * a + crow(i, h); int col = nt * 128 + 64 * wn + 32 * bb + r;
          P.out[row * 1024 + col] = alpha * xres[row * 1024 + col] + acc[a][bb][i];
        }
  }
}

DI void p5_ln(const Params& P, int l) {
  const int lane = get_tid() & 63, wave = get_tid() >> 6;
  const float* g = P.ln_g + l * 1024; const float* bb = P.ln_b + l * 1024;
  for (int row = blockIdx.x * 4 + wave; row < MTOK; row += gridDim.x * 4) {
    float* p = P.out + (size_t)row * 1024;
    f32x4 v[4]; float s = 0.f;
#pragma unroll
    for (int k = 0; k < 4; ++k) { v[k] = *(const f32x4*)(p + k * 256 + lane * 4); s += v[k][0] + v[k][1] + v[k][2] + v[k][3]; }
#pragma unroll
    for (int o = 32; o >= 1; o >>= 1) s += __shfl_xor(s, o);
    float mean = s * (1.f / 1024.f); float q = 0.f;
#pragma unroll
    for (int k = 0; k < 4; ++k)
#pragma unroll
      for (int e = 0; e < 4; ++e) { float d = v[k][e] - mean; q += d * d; }
#pragma unroll
    for (int o = 32; o >= 1; o >>= 1) q += __shfl_xor(q, o);
    float rstd = rsqrtf(q * (1.f / 1024.f) + 1e-5f);
#pragma unroll
    for (int k = 0; k < 4; ++k) {
      int c = k * 256 + lane * 4; f32x4 gg = *(const f32x4*)(g + c), bv = *(const f32x4*)(bb + c); f32x4 o;
#pragma unroll
      for (int e = 0; e < 4; ++e) o[e] = (v[k][e] - mean) * rstd * gg[e] + bv[e];
      *(f32x4*)(p + c) = o;
      if (l + 1 < DEPTH) {
        u32x2 w; w.x = pk2(o[0], o[1]); w.y = pk2(o[2], o[3]);
        *(u32x2*)((bf16_t*)(P.ws + OFF_XB) + (size_t)row * 1024 + c) = w; }
    }
  }
}

enum { M_FOX = 0, M_DIFF = 1, M_CMP1 = 2, M_CMP2 = 3, M_SEL = 4, M_WIN = 5 };
struct AttnState { f32x16 o[2]; float m, l; };
struct TileSrc { const bf16_t* K; const bf16_t* Vt; long vstride; const float* C; };

template <bool HASV, bool HASC>
DI void tile_gload(const TileSrc& s, int T, u32x4 (&rk)[2], u32x4 (&rv)[2], f32x4& rc, int tid) {
#pragma unroll
  for (int p = 0; p < 2; ++p) { int id = tid + 256 * p, row = id >> 3, ch = id & 7;
    rk[p] = *(const u32x4*)(s.K + ((long)(64 * T + row)) * 64 + ch * 8);
    if (HASV) rv[p] = *(const u32x4*)(s.Vt + (long)row * s.vstride + 64 * T + ch * 8); }
  if (HASC) { if (tid < 16) rc = *(const f32x4*)(s.C + 64 * T + 4 * tid); }
}
template <bool HASV, bool HASC>
DI void tile_sstore(char* buf, const u32x4 (&rk)[2], const u32x4 (&rv)[2], const f32x4& rc, int tid) {
#pragma unroll
  for (int p = 0; p < 2; ++p) { int id = tid + 256 * p, row = id >> 3, ch = id & 7;
    *(u32x4*)(buf + row * 144 + ch * 16) = rk[p];
    if (HASV) { char* d = buf + ATT_V + row * 136 + ch * 16; u32x2 a = {rv[p].x, rv[p].y}, b = {rv[p].z, rv[p].w}; *(u32x2*)d = a; *(u32x2*)(d + 8) = b; } }
  if (HASC) { if (tid < 16) *(f32x4*)(buf + ATT_C + tid * 16) = -rc; }
}

constexpr float MREF0 = -32.f;
constexpr float RSUM = 1099511627776.f;

template <int MODE>
DI void qk_part(f32x16 (&p)[2], const bf16x8* qf, const char* buf, int koffb, const f32x16& negm, int r, int h) {
  constexpr int ND0 = (MODE == M_DIFF) ? 2 : 4;
  const char* kl = buf; const float* cl = (const float*)(buf + ATT_C);
  if (MODE == M_FOX) {
    const float nm = negm[0];
#pragma unroll
    for (int c = 0; c < 2; ++c)
#pragma unroll
      for (int g = 0; g < 4; ++g) { f32x4 ck = *(const f32x4*)(cl + 32 * c + 8 * g + 4 * h);
#pragma unroll
        for (int e = 0; e < 4; ++e) p[c][4 * g + e] = ck[e] + nm; }
  }
#pragma unroll
  for (int d0 = 0; d0 < ND0; ++d0) {
    const char* kp = kl + r * 144 + koffb + (16 * d0 + 8 * h) * 2;
    bf16x8 k0 = *(const bf16x8*)kp; bf16x8 k1 = *(const bf16x8*)(kp + 32 * 144);
    if (MODE != M_FOX && d0 == 0) { p[0] = MFMA32(k0, qf[d0], negm); p[1] = MFMA32(k1, qf[d0], negm); }
    else { p[0] = MFMA32(k0, qf[d0], p[0]); p[1] = MFMA32(k1, qf[d0], p[1]); }
  }
}

template <int MODE>
DI void sp_part(AttnState& st, f32x16 (&p)[2], f32x16& negm, const char* buf, int T, int tq, unsigned selbit,
                float inv_l, unsigned* imp_q, int r, int h) {
  const char* vl = buf + ATT_V;
  const int kvb = 64 * T + 4 * h;
  int lim, lo;
  if (MODE == M_CMP1 || MODE == M_CMP2) { lim = (tq - 31) >> 4; lo = -(1 << 30); }
  else if (MODE == M_SEL) { lim = selbit ? tq : -1; lo = -(1 << 30); }
  else if (MODE == M_WIN) { lim = tq; lo = tq - 511; }
  else { lim = tq; lo = -(1 << 30); }
  const bool full = (lim >= 64 * T + 63) && (lo <= 64 * T);
  bool lane_on = true; bool sel_interior = false;
  if (MODE == M_SEL) sel_interior = __all(tq >= 64 * T + 63) != 0;
  if (sel_interior) lane_on = (selbit != 0u);
  else if (!__all(full)) {
#pragma unroll
    for (int c = 0; c < 2; ++c)
#pragma unroll
      for (int i = 0; i < 16; ++i) { int kv = kvb + 32 * c + 8 * (i >> 2) + (i & 3); if (kv > lim || kv < lo) p[c][i] = NEGBIG; }
  }
  float tile_sum = 0.f;
  if (MODE == M_CMP2) {
#pragma unroll
    for (int c = 0; c < 2; ++c)
#pragma unroll
      for (int i = 0; i < 16; ++i) p[c][i] = ex2(p[c][i]) * inv_l;
#pragma unroll
    for (int c = 0; c < 2; ++c)
#pragma unroll
      for (int g = 0; g < 4; ++g) {
        int j = 16 * T + 8 * c + 2 * g + h;
        float bq = 0.5f * p[c][4 * g + 3]; float aq = p[c][4 * g] + p[c][4 * g + 1] + p[c][4 * g + 2] + bq;
        atomicAdd(&imp_q[j * 32], (unsigned)(aq * 4194304.f + 0.5f));
        if (j + 1 < 128) atomicAdd(&imp_q[(j + 1) * 32], (unsigned)(bq * 4194304.f + 0.5f));
      }
  } else {
    float sum = 0.f;
#pragma unroll
    for (int c = 0; c < 2; ++c)
#pragma unroll
      for (int i = 0; i < 16; ++i) { float e = ex2(p[c][i]); p[c][i] = e; sum += e; }
    if (MODE == M_SEL) sum = lane_on ? sum : 0.f;
    st.l += sum;
    tile_sum = sum;
  }
  if (MODE != M_CMP1) {
#pragma unroll
    for (int c = 0; c < 2; ++c)
#pragma unroll
      for (int s2 = 0; s2 < 2; ++s2) {
        u32x4 pw; pw.x = pk2(p[c][8 * s2], p[c][8 * s2 + 1]); pw.y = pk2(p[c][8 * s2 + 2], p[c][8 * s2 + 3]);
        pw.z = pk2(p[c][8 * s2 + 4], p[c][8 * s2 + 5]); pw.w = pk2(p[c][8 * s2 + 6], p[c][8 * s2 + 7]);
        if (MODE == M_SEL) { if (!lane_on) { pw.x = 0u; pw.y = 0u; pw.z = 0u; pw.w = 0u; } }
        bf16x8 pf = __builtin_bit_cast(bf16x8, pw);
#pragma unroll
        for (int dt = 0; dt < 2; ++dt) {
          const char* vp = vl + (32 * dt + r) * 136 + (32 * c + 16 * s2 + 4 * h) * 2;
          s16x4 lo4 = *(const s16x4*)vp; s16x4 hi4 = *(const s16x4*)(vp + 16);
          bf16x8 vf = __builtin_shufflevector(lo4, hi4, 0, 1, 2, 3, 4, 5, 6, 7);
          st.o[dt] = MFMA32(vf, pf, st.o[dt]);
        }
      }
  }
  if (MODE != M_CMP2) {
    if (__any(tile_sum > RSUM)) {
      const float tot = xhalf_sum(tile_sum);
      const float dl = (tot > RSUM) ? __builtin_amdgcn_logf(tot) : 0.f;
      st.m += dl;
      const float nm = -st.m;
#pragma unroll
      for (int i = 0; i < 16; ++i) negm[i] = nm;
      const float f = ex2(-dl);
      st.l *= f;
      if (MODE != M_CMP1) {
#pragma unroll
        for (int i = 0; i < 16; ++i) { st.o[0][i] *= f; st.o[1][i] *= f; }
      }
    }
  }
}

template <int MODE>
DI bool tile_active(int T, int twmax, int qspan, const unsigned* selmask_q) {
  bool a;
  if (MODE == M_CMP1 || MODE == M_CMP2) a = (16 * (64 * T) + 31 <= twmax);
  else a = (64 * T <= twmax);
  if (MODE == M_WIN) a = a && (64 * T + 63 >= twmax - qspan - 511);
  if (MODE == M_SEL) { if (a) a = __any((int)((selmask_q[T >> 5] >> (T & 31)) & 1u)) != 0; }
  return a;
}

template <int MODE>
DI void run_tiles(AttnState& st, const bf16x8* qf, const TileSrc& src, int T0, int T1, int tq, int twmax_, int qspan, int koffb,
                  const unsigned* selmask_q, float m_fin, float inv_l, unsigned* imp_q, char* lds, int tid, int r, int h) {
  constexpr bool HASV = (MODE != M_CMP1), HASC = (MODE == M_FOX);
  const int twmax = __builtin_amdgcn_readfirstlane(twmax_);
  const float m0 = (MODE == M_CMP2) ? m_fin : MREF0;
  u32x4 rk[2], rv[2]; f32x4 rc;
  st.m = m0;
  f32x16 negm;
#pragma unroll
  for (int i = 0; i < 16; ++i) negm[i] = -m0;
  __syncthreads();
  if (T0 < T1) { tile_gload<HASV, HASC>(src, T0, rk, rv, rc, tid); tile_sstore<HASV, HASC>(lds, rk, rv, rc, tid); }
  if (T0 + 1 < T1) tile_gload<HASV, HASC>(src, T0 + 1, rk, rv, rc, tid);
  int slot = 0;
  for (int T = T0; T < T1; ++T) {
    const char* buf = lds + slot * ATT_BUF;
    slot = (slot == 2) ? 0 : slot + 1;
    if (T + 1 < T1) tile_sstore<HASV, HASC>(lds + slot * ATT_BUF, rk, rv, rc, tid);
    if (T + 2 < T1) tile_gload<HASV, HASC>(src, T + 2, rk, rv, rc, tid);
    __syncthreads();
    if (tile_active<MODE>(T, twmax, qspan, selmask_q)) {
      unsigned selbit = 0;
      if (MODE == M_SEL) selbit = (selmask_q[T >> 5] >> (T & 31)) & 1u;
      f32x16 p[2];
      qk_part<MODE>(p, qf, buf, koffb, negm, r, h);
      sp_part<MODE>(st, p, negm, buf, T, tq, selbit, inv_l, imp_q, r, h);
    }
  }
}

DI void st_init(AttnState& st) {
#pragma unroll
  for (int i = 0; i < 16; ++i) { st.o[0][i] = 0.f; st.o[1][i] = 0.f; }
  st.m = MREF0; st.l = 0.f;
}
DI float st_invl(const AttnState& st) { float lt = xhalf_sum(st.l); return lt > 0.f ? 1.f / lt : 0.f; }

DI void store_mix(const Params& P, size_t token, int col, float a, float b, float c, float d) {
  const bf16_t* G = (const bf16_t*)(P.ws + OFF_G) + token * 1024 + col;
  u32x2 gv = *(const u32x2*)G;
  float g0 = __uint_as_float(gv.x << 16), g1 = __uint_as_float(gv.x & 0xffff0000u), g2 = __uint_as_float(gv.y << 16), g3 = __uint_as_float(gv.y & 0xffff0000u);
  u32x2 w; w.x = pk2(a * g0, b * g1); w.y = pk2(c * g2, d * g3);
  *(u32x2*)((bf16_t*)(P.ws + OFF_MIX) + token * 1024 + col) = w;
}

DI void fox_unit(const Params& P, int bh, int qt, char* lds) {
  const int tid = get_tid(), lane = tid & 63, wave = tid >> 6, r = lane & 31, h = lane >> 5;
  const int t0 = 128 * qt, tq = t0 + 32 * wave + r, twmax = t0 + 32 * wave + 31;
  const bf16_t* Q = (const bf16_t*)(P.ws + OFF_QF) + (size_t)bh * SEQ * 64;
  TileSrc src; src.K = (const bf16_t*)(P.ws + OFF_KF) + (size_t)bh * SEQ * 64; src.Vt = (const bf16_t*)(P.ws + OFF_VFT) + (size_t)bh * SEQ * 64; src.vstride = SEQ;
  src.C = (const float*)(P.ws + OFF_CUM) + (size_t)bh * SEQ;
  bf16x8 qf[4];
#pragma unroll
  for (int d0 = 0; d0 < 4; ++d0) qf[d0] = *(const bf16x8*)(Q + (size_t)tq * 64 + 16 * d0 + 8 * h);
  AttnState st; st_init(st);
  run_tiles<M_FOX>(st, qf, src, 0, 2 * qt + 2, tq, twmax, 31, 0, nullptr, 0.f, 0.f, nullptr, lds, tid, r, h);
  const float inv = st_invl(st);
  const size_t token = (size_t)(bh >> 2) * SEQ + tq; const int hd = bh & 3;
#pragma unroll
  for (int dt = 0; dt < 2; ++dt)
#pragma unroll
    for (int g = 0; g < 4; ++g)
      store_mix(P, token, hd * 64 + 32 * dt + 8 * g + 4 * h, st.o[dt][4 * g] * inv, st.o[dt][4 * g + 1] * inv, st.o[dt][4 * g + 2] * inv, st.o[dt][4 * g + 3] * inv);
}

DI void diff_unit(const Params& P, int l, int bh, int qt, char* lds) {
  const int tid = get_tid(), lane = tid & 63, wave = tid >> 6, r = lane & 31, h = lane >> 5;
  const int comp = wave & 1, qs = wave >> 1;
  const int t0 = 64 * qt, tq = t0 + 32 * qs + r, twmax = t0 + 32 * qs + 31;
  const bf16_t* Q = (const bf16_t*)(P.ws + OFF_QD) + (size_t)bh * SEQ * 64;
  TileSrc src; src.K = (const bf16_t*)(P.ws + OFF_KD) + (size_t)bh * SEQ * 64; src.Vt = (const bf16_t*)(P.ws + OFF_VDT) + (size_t)bh * SEQ * 64; src.vstride = SEQ; src.C = nullptr;
  bf16x8 qf[2];
#pragma unroll
  for (int d0 = 0; d0 < 2; ++d0) qf[d0] = *(const bf16x8*)(Q + (size_t)tq * 64 + comp * 32 + 16 * d0 + 8 * h);
  AttnState st; st_init(st);
  run_tiles<M_DIFF>(st, qf, src, 0, qt + 1, tq, twmax, 31, comp * 64, nullptr, 0.f, 0.f, nullptr, lds, tid, r, h);
  const float inv = st_invl(st);
  float* exch = (float*)(lds + LDS_IMP);
  __syncthreads();
  if (comp == 1) {
#pragma unroll
    for (int dt = 0; dt < 2; ++dt)
#pragma unroll
      for (int i = 0; i < 16; ++i) exch[(qs * 64 + 32 * dt + crow(i, h)) * 32 + r] = st.o[dt][i] * inv;
  }
  __syncthreads();
  if (comp == 0) {
    const float lam = ((const float*)(P.ws + OFF_LAM))[l], lam_init = ((const float*)(P.ws + OFF_LAM))[2 + l];
    float ss = 0.f;
#pragma unroll
    for (int dt = 0; dt < 2; ++dt)
#pragma unroll
      for (int i = 0; i < 16; ++i) { float a = st.o[dt][i] * inv - lam * exch[(qs * 64 + 32 * dt + crow(i, h)) * 32 + r]; st.o[dt][i] = a; ss += a * a; }
    ss = xhalf_sum(ss);
    const float rms = rsqrtf(ss * (1.f / 64.f) + 1e-5f) * (1.f - lam_init);
    const size_t token = (size_t)(bh >> 2) * SEQ + tq; const int hd = bh & 3;
    const float* sg = P.subln_g + l * 64;
#pragma unroll
    for (int dt = 0; dt < 2; ++dt)
#pragma unroll
      for (int g = 0; g < 4; ++g) { int d = 32 * dt + 8 * g + 4 * h; f32x4 gg = *(const f32x4*)(sg + d);
        store_mix(P, token, 768 + hd * 64 + d, st.o[dt][4 * g] * rms * gg[0], st.o[dt][4 * g + 1] * rms * gg[1], st.o[dt][4 * g + 2] * rms * gg[2], st.o[dt][4 * g + 3] * rms * gg[3]); }
  }
}

DI void nsa_unit(const Params& P, int bg, int qt, char* lds) {
  const int tid = get_tid(), lane = tid & 63, wave = tid >> 6, r = lane & 31, h = lane >> 5;
  const int b = bg >> 1, g2 = bg & 1, head8 = g2 * 4 + (r & 3);
  const int t0 = 32 * qt, ql = 8 * wave + (r >> 2), tq = t0 + ql, tmax = t0 + 31, twmax = t0 + 8 * wave + 7;
  const bf16_t* Q = (const bf16_t*)(P.ws + OFF_QN) + (size_t)(b * 8 + head8) * SEQ * 64;
  bf16x8 qf[4];
#pragma unroll
  for (int d0 = 0; d0 < 4; ++d0) qf[d0] = *(const bf16x8*)(Q + (size_t)tq * 64 + 16 * d0 + 8 * h);
  unsigned* imp = (unsigned*)(lds + LDS_IMP);
  unsigned* selm = (unsigned*)(lds + LDS_SEL);
#pragma unroll
  for (int k = 0; k < 16; ++k) imp[tid + 256 * k] = 0u;
  const float* gates = (const float*)(P.ws + OFF_GATES) + ((size_t)b * SEQ + tq) * 24 + 3 * head8;
  const float gc = gates[0], gs = gates[1], gw = gates[2];
  unsigned* stash = (unsigned*)(lds + LDS_IMP) + wave * 16 * 64 + lane;
  TileSrc src; src.K = (const bf16_t*)(P.ws + OFF_KC) + (size_t)bg * 512 * 64; src.Vt = (const bf16_t*)(P.ws + OFF_VCC) + (size_t)bg * 64 * 512; src.vstride = 512; src.C = nullptr;
  int nvis = (t0 >> 4) + 1; if (nvis > 511) nvis = 511;
  const int ntc = (nvis + 63) >> 6;
  AttnState st; st_init(st);
  run_tiles<M_CMP1>(st, qf, src, 0, ntc, tq, twmax, 7, 0, nullptr, 0.f, 0.f, nullptr, lds, tid, r, h);
  {
    const float m_fin = st.m, inv_l = st_invl(st);
    st_init(st);
    run_tiles<M_CMP2>(st, qf, src, 0, ntc, tq, twmax, 7, 0, nullptr, m_fin, inv_l, imp + ql, lds, tid, r, h);
  }
  __syncthreads();
  {
    const int q = tid >> 3, jg = tid & 7; const int t = t0 + q, cur = t >> 6;
    unsigned key[16];
#pragma unroll
    for (int e = 0; e < 16; ++e) { int j = 16 * jg + e; unsigned v = imp[j * 32 + q];
      bool valid = j <= cur, forced = (j == 0) || (j == cur) || (j == cur - 1);
      key[e] = !valid ? 0u : (forced ? (0xFFFFFF80u | (unsigned)(127 - j)) : ((v << 7) | (unsigned)(127 - j))); }
    unsigned sel = 0;
    for (int round = 0; round < 16; ++round) {
      unsigned m = key[0];
#pragma unroll
      for (int e = 1; e < 16; ++e) m = m > key[e] ? m : key[e];
      unsigned o;
      o = __shfl_xor(m, 1); m = m > o ? m : o; o = __shfl_xor(m, 2); m = m > o ? m : o; o = __shfl_xor(m, 4); m = m > o ? m : o;
      if (m != 0u) {
#pragma unroll
        for (int e = 0; e < 16; ++e) if (key[e] == m) { sel |= 1u << e; key[e] = 0u; }
      }
    }
    ((unsigned short*)selm)[q * 8 + jg] = (unsigned short)sel;
  }
  __syncthreads();
#pragma unroll
  for (int i = 0; i < 8; ++i) { stash[i * 64] = pk2(gc * st.o[0][2 * i], gc * st.o[0][2 * i + 1]); stash[(8 + i) * 64] = pk2(gc * st.o[1][2 * i], gc * st.o[1][2 * i + 1]); }
  src.K = (const bf16_t*)(P.ws + OFF_KS) + (size_t)bg * SEQ * 64; src.Vt = (const bf16_t*)(P.ws + OFF_VST) + (size_t)bg * SEQ * 64; src.vstride = SEQ;
  st_init(st);
  run_tiles<M_SEL>(st, qf, src, 0, (tmax >> 6) + 1, tq, twmax, 7, 0, selm + ql * 4, 0.f, 0.f, nullptr, lds, tid, r, h);
  { const float inv = st_invl(st) * gs;
#pragma unroll
    for (int i = 0; i < 8; ++i) { unsigned a = stash[i * 64], bq = stash[(8 + i) * 64];
      stash[i * 64] = pk2(__uint_as_float(a << 16) + inv * st.o[0][2 * i], __uint_as_float(a & 0xffff0000u) + inv * st.o[0][2 * i + 1]);
      stash[(8 + i) * 64] = pk2(__uint_as_float(bq << 16) + inv * st.o[1][2 * i], __uint_as_float(bq & 0xffff0000u) + inv * st.o[1][2 * i + 1]); } }
  src.K = (const bf16_t*)(P.ws + OFF_KW) + (size_t)bg * SEQ * 64; src.Vt = (const bf16_t*)(P.ws + OFF_VWT) + (size_t)bg * SEQ * 64;
  st_init(st);
  { int lo_t = t0 - 511; int T0 = lo_t > 0 ? (lo_t >> 6) : 0;
    run_tiles<M_WIN>(st, qf, src, T0, (tmax >> 6) + 1, tq, twmax, 7, 0, nullptr, 0.f, 0.f, nullptr, lds, tid, r, h); }
  { const float inv = st_invl(st) * gw;
#pragma unroll
    for (int i = 0; i < 8; ++i) { unsigned a = stash[i * 64], bq = stash[(8 + i) * 64];
      st.o[0][2 * i] = __uint_as_float(a << 16) + inv * st.o[0][2 * i]; st.o[0][2 * i + 1] = __uint_as_float(a & 0xffff0000u) + inv * st.o[0][2 * i + 1];
      st.o[1][2 * i] = __uint_as_float(bq << 16) + inv * st.o[1][2 * i]; st.o[1][2 * i + 1] = __uint_as_float(bq & 0xffff0000u) + inv * st.o[1][2 * i + 1]; } }
  const size_t token = (size_t)b * SEQ + tq;
#pragma unroll
  for (int dt = 0; dt < 2; ++dt)
#pragma unroll
    for (int g = 0; g < 4; ++g)
      store_mix(P, token, 256 + head8 * 64 + 32 * dt + 8 * g + 4 * h, st.o[dt][4 * g], st.o[dt][4 * g + 1], st.o[dt][4 * g + 2], st.o[dt][4 * g + 3]);
}

DI void compress_tile(const Params& P, int l, int id, char* lds) {
  const int tid = get_tid(), lane = tid & 63, wave = tid >> 6, wm = wave >> 1, wn = wave & 1, r = lane & 31, h = lane >> 5;
  const int kv = id >> 4, bg = (id >> 2) & 3, mt = id & 3;
  const bf16_t* tok = (const bf16_t*)(P.ws + (kv ? OFF_VCT : OFF_KCT)) + (size_t)bg * SEQ * 64;
  const bf16_t* Bt = (const bf16_t*)(P.ws + OFF_W1T) + ((size_t)l * 2 + kv) * 128 * 2048;
  f32x16 acc[2][2];
  int rowmax = 510 - 128 * mt; if (rowmax > 127) rowmax = 127;
  gemm_mainloop(tok + (size_t)mt * 128 * 1024, 1024, rowmax, Bt, 2048, 2048, lds, acc);
  __syncthreads();
  float* H = (float*)lds;
  const float* bias = (const float*)(P.ws + OFF_B1) + (l * 2 + kv) * 128;
#pragma unroll
  for (int a = 0; a < 2; ++a)
#pragma unroll
    for (int bb = 0; bb < 2; ++bb) { int col = 64 * wn + 32 * bb + r; float bv = bias[col];
#pragma unroll
      for (int i = 0; i < 16; ++i) { int row = 64 * wm + 32 * a + crow(i, h); H[row * 129 + col] = silu(acc[a][bb][i] + bv); } }
  __syncthreads();
  const float* w2 = (kv ? P.w2_v : P.w2_k) + (size_t)l * 128 * 64;
  const int c = tid & 63, rg = tid >> 6;
  float o[32];
#pragma unroll
  for (int i = 0; i < 32; ++i) o[i] = 0.f;
  for (int j = 0; j < 128; ++j) { float w = w2[j * 64 + c];
#pragma unroll
    for (int i = 0; i < 32; ++i) o[i] += H[(rg * 32 + i) * 129 + j] * w; }
  if (kv == 0) { bf16_t* dst = (bf16_t*)(P.ws + OFF_KC) + (size_t)bg * 512 * 64;
#pragma unroll
    for (int i = 0; i < 32; ++i) { int n = 128 * mt + rg * 32 + i; dst[(size_t)n * 64 + c] = f2bf(o[i]); } }
  else { bf16_t* dst = (bf16_t*)(P.ws + OFF_VCC) + (size_t)bg * 64 * 512;
#pragma unroll
    for (int i = 0; i < 32; ++i) { int n = 128 * mt + rg * 32 + i; dst[(size_t)c * 512 + n] = f2bf(o[i]); } }
  __syncthreads();
}

DI void cumsum_seq(const Params& P, int bh, char* lds) {
  const int tid = get_tid();
  const float* src = (const float*)(P.ws + OFF_LOGF) + (size_t)bh * SEQ + tid * 32;
  float* dst = (float*)(P.ws + OFF_CUM) + (size_t)bh * SEQ + tid * 32;
  float* tot = (float*)lds;
  f32x4 v[8]; float s = 0.f;
#pragma unroll
  for (int k = 0; k < 8; ++k) { v[k] = *(const f32x4*)(src + 4 * k);
#pragma unroll
    for (int e = 0; e < 4; ++e) { s += v[k][e]; v[k][e] = s; } }
  __syncthreads();
  tot[tid] = s;
  __syncthreads();
  float base = 0.f;
  for (int i = 0; i < tid; ++i) base += tot[i];
#pragma unroll
  for (int k = 0; k < 8; ++k) { f32x4 o;
#pragma unroll
    for (int e = 0; e < 4; ++e) o[e] = v[k][e] + base;
    *(f32x4*)(dst + 4 * k) = o; }
  __syncthreads();
}

DI int next_unit(unsigned* ctr, int* s_unit) {
  __syncthreads();
  if (get_tid() == 0) *s_unit = (int)atomicAdd(ctr, 1u);
  __syncthreads();
  return *s_unit;
}

DI void p2_phase(const Params& P, int l, char* lds, int* s_unit, int rep = 0) {
  unsigned* ctr = (unsigned*)(P.ws + OFF_CTR) + (l * 4 + 0 + 16 * rep);
  for (;;) {
    int u = next_unit(ctr, s_unit);
    if (u >= 32 + 8 + 1024) break;
    if (u < 32) compress_tile(P, l, u, lds);
    else if (u < 40) cumsum_seq(P, u - 32, lds);
    else { int v = u - 40; diff_unit(P, l, v & 7, 127 - (v >> 3), lds); }
  }
}
DI void p3_phase(const Params& P, int l, char* lds, int* s_unit, int rep = 0) {
  unsigned* ctr = (unsigned*)(P.ws + OFF_CTR) + (l * 4 + 1 + 16 * rep);
  for (;;) {
    int u = next_unit(ctr, s_unit);
    if (u >= 512 + 1024) break;
    if (u < 384) fox_unit(P, u & 7, 63 - (u >> 3), lds);
    else if (u < 384 + 1024) { int v = u - 384; nsa_unit(P, v & 3, 255 - (v >> 2), lds); }
    else { int v = u - (384 + 1024); fox_unit(P, v & 7, 15 - (v >> 3), lds); }
  }
}

template <int KIND> DI void run_phase(const Params& P, int l, char* lds, int* s_unit, int rep = 0) {
  if constexpr (KIND == 0) p0_prologue(P);
  else if constexpr (KIND == 1) p1_inproj(P, l, lds);
  else if constexpr (KIND == 2) p2_phase(P, l, lds, s_unit, rep);
  else if constexpr (KIND == 3) p3_phase(P, l, lds, s_unit, rep);
  else if constexpr (KIND == 4) p4_outproj(P, l, lds);
  else p5_ln(P, l);
}
template <int KIND> __global__ void __launch_bounds__(NTHREADS, 2) phase_kernel(Params P, int l) {
  __shared__ __attribute__((aligned(16))) char lds[LDS_BYTES + LDS_CTL];
  run_phase<KIND>(P, l, lds, (int*)(lds + LDS_BYTES));
}
#if COOP
#define GSYNC() do { asm volatile("" ::: "memory"); cg::this_grid().sync(); asm volatile("" ::: "memory"); } while (0)
#define XB_TMO      128
#define XB_XCNT(j)  (256  + 64 * (j))
#define XB_XSUB(j)  (1280 + 64 * (j))
#define XB_XGEN(j)  (2304 + 64 * (j))
#define XB_TOP      3328
#define XB_TOPGEN   3392
#define XCD_BAR_WORDS 3456
#define XB_SPIN_CAP (1u << 22)
#define LAS __attribute__((address_space(3)))
DI unsigned xb_ld(unsigned* p) { return __hip_atomic_load(p, __ATOMIC_RELAXED, __HIP_MEMORY_SCOPE_AGENT); }
DI unsigned xb_add(unsigned* p, unsigned v) { return __hip_atomic_fetch_add(p, v, __ATOMIC_RELAXED, __HIP_MEMORY_SCOPE_AGENT); }
DI unsigned xb_xcc_id() { return (unsigned)__builtin_amdgcn_s_getreg((3 << 11) | 20) & 0xFu; }
#define XB_SPIN(cond, bar) do { unsigned _sp = 0; while (cond) { __builtin_amdgcn_s_sleep(1); \
    if ((++_sp & 255u) == 0u) { if (xb_ld(&(bar)[XB_TMO])) break; if (_sp > XB_SPIN_CAP) { atomicAdd(&(bar)[XB_TMO], 1u); break; } } } } while (0)
struct XcdBarrier { unsigned* bar; unsigned x; volatile LAS unsigned* st; };
DI XcdBarrier xcd_barrier_post(unsigned* bar, volatile LAS unsigned* st) {
  XcdBarrier b; b.bar = bar; b.x = xb_xcc_id(); b.st = st;
  if (threadIdx.x == 0) (void)xb_add(&bar[XB_XCNT(b.x)], 1u);
  return b;
}
DI void xcd_barrier_complete(unsigned* bar, unsigned x, unsigned& nloc, unsigned& nx) {
  const unsigned G = gridDim.x * gridDim.y * gridDim.z;
  unsigned sum, cnt, mine, sp = 0u;
  for (;;) {
    sum = 0u; cnt = 0u; mine = 0u;
#pragma unroll
    for (unsigned j = 0; j < 16; ++j) { const unsigned c = xb_ld(&bar[XB_XCNT(j)]); sum += c; cnt += (c > 0u) ? 1u : 0u; mine = (j == x) ? c : mine; }
    if (sum == G) break;
    __builtin_amdgcn_s_sleep(1);
    if ((++sp & 255u) == 0u) { if (xb_ld(&bar[XB_TMO])) break; if (sp > XB_SPIN_CAP) { atomicAdd(&bar[XB_TMO], 1u); break; } }
  }
  nloc = mine > 0u ? mine : 1u; nx = cnt > 0u ? cnt : 1u;
}
DI void xcd_barrier(const XcdBarrier& b) {
  asm volatile("s_waitcnt vmcnt(0)" ::: "memory");
  __syncthreads();
  if (threadIdx.x == 0) {
    unsigned* bar = b.bar;
    __builtin_amdgcn_s_waitcnt(0);
    unsigned nloc = b.st[0], nx = b.st[1];
    if (nloc == 0u) { xcd_barrier_complete(bar, b.x, nloc, nx); b.st[0] = nloc; b.st[1] = nx; }
    const unsigned old = xb_add(&bar[XB_XSUB(b.x)], 1u);
    const unsigned gen = old / nloc;
    if (old + 1u == (gen + 1u) * nloc) {
      __builtin_amdgcn_fence(__ATOMIC_RELEASE, "agent");
      asm volatile("s_waitcnt vmcnt(0)" ::: "memory");
      const unsigned og = xb_add(&bar[XB_TOP], 1u);
      const unsigned tg = og / nx;
      if (og + 1u == (tg + 1u) * nx) xb_add(&bar[XB_TOPGEN], 1u);
      else XB_SPIN(xb_ld(&bar[XB_TOPGEN]) == tg, bar);
      __builtin_amdgcn_fence(__ATOMIC_ACQUIRE, "agent");
      xb_add(&bar[XB_XGEN(b.x)], 1u);
      asm volatile("s_waitcnt vmcnt(0)" ::: "memory");
    } else {
      XB_SPIN(xb_ld(&bar[XB_XGEN(b.x)]) == gen, bar);
      __builtin_amdgcn_fence(__ATOMIC_ACQUIRE, "agent");
      asm volatile("s_waitcnt vmcnt(0)" ::: "memory");
    }
  }
  __syncthreads();
}
#ifndef CG_ALL
#define BSYNC() do { asm volatile("" ::: "memory"); xcd_barrier(xb); asm volatile("" ::: "memory"); } while (0)
#else
#define BSYNC() GSYNC()
#endif
__global__ void __launch_bounds__(NTHREADS, 2) fwd_kernel(Params P) {
  __shared__ __attribute__((aligned(16))) char lds[LDS_BYTES + LDS_CTL];
  int* const s_unit_p = (int*)(lds + LDS_BYTES);
  if (threadIdx.x == 0) *(uint4*)(lds + LDS_BYTES + 16) = make_uint4(0u, 0u, 0u, 0u);
  __syncthreads();
  const XcdBarrier xb = xcd_barrier_post((unsigned*)(P.ws + OFF_BAR), (volatile LAS unsigned*)(lds + LDS_BYTES + 16));
  if (P.pad_ == 0x5eed) GSYNC();
  run_phase<0>(P, 0, lds, s_unit_p); BSYNC();
  for (int l = 0; l < DEPTH; ++l) {
    run_phase<1>(P, l, lds, s_unit_p); BSYNC();
#if REPEAT == 1
    run_phase<1>(P, l, lds, s_unit_p, 1); BSYNC();
#endif
    run_phase<2>(P, l, lds, s_unit_p); BSYNC();
#if REPEAT == 2
    run_phase<2>(P, l, lds, s_unit_p, 1); BSYNC();
#endif
    run_phase<3>(P, l, lds, s_unit_p); BSYNC();
#if REPEAT == 3
    run_phase<3>(P, l, lds, s_unit_p, 1); BSYNC();
#endif
    run_phase<4>(P, l, lds, s_unit_p); BSYNC();
    run_phase<5>(P, l, lds, s_unit_p); if (l + 1 < DEPTH) BSYNC();
  }
}
#endif

extern "C" void kernel_launch(void* const* d_in, const int* in_sizes, int n_in, void* d_out, int out_size, void* d_ws, size_t ws_size, hipStream_t stream) {
  static int grid_blocks = 0;
  if (!grid_blocks) {
    int dev = 0, cus = 0, per_cu = 0;
    (void)hipGetDevice(&dev);
    (void)hipDeviceGetAttribute(&cus, hipDeviceAttributeMultiprocessorCount, dev);
#if COOP
    (void)hipOccupancyMaxActiveBlocksPerMultiprocessor(&per_cu, fwd_kernel, NTHREADS, 0);
#else
    per_cu = 2;
#endif
    if (per_cu < 1) per_cu = 1;
    if (per_cu > 2) per_cu = 2;
    if (cus < 1) cus = 256;
    grid_blocks = cus * per_cu;
  }
  if (n_in != 17 || ws_size < WS_NEED) { fprintf(stderr, "kernel_launch: unexpected inputs (%d) or workspace (%zu)\n", n_in, ws_size); return; }
  Params p{};
  p.x = (const float*)d_in[0]; p.w_in = (const float*)d_in[1]; p.b_fox_f = (const float*)d_in[2]; p.pos_k = (const float*)d_in[3]; p.pos_v = (const float*)d_in[4];
  p.w1_k = (const float*)d_in[5]; p.w2_k = (const float*)d_in[6]; p.w1_v = (const float*)d_in[7]; p.w2_v = (const float*)d_in[8];
  p.lq1 = (const float*)d_in[9]; p.lk1 = (const float*)d_in[10]; p.lq2 = (const float*)d_in[11]; p.lk2 = (const float*)d_in[12];
  p.subln_g = (const float*)d_in[13]; p.w_out = (const float*)d_in[14]; p.ln_g = (const float*)d_in[15]; p.ln_b = (const float*)d_in[16];
  p.out = (float*)d_out; p.ws = (char*)d_ws;
  (void)hipMemsetAsync((char*)d_ws + OFF_CTR, 0, 4096, stream);
  (void)hipMemsetAsync((char*)d_ws + OFF_BAR, 0, CTL_ZERO_BYTES - OFF_BAR, stream);
#if COOP
  void* args[] = {&p};
  hipError_t e = hipLaunchCooperativeKernel((void*)fwd_kernel, dim3(grid_blocks), dim3(NTHREADS), args, 0, stream);
  if (e != hipSuccess) fprintf(stderr, "cooperative launch failed: %s (grid %d)\n", hipGetErrorString(e), grid_blocks);
#else
  const dim3 g(grid_blocks), b(NTHREADS);
  hipLaunchKernelGGL(phase_kernel<0>, g, b, 0, stream, p, 0);
  for (int l = 0; l < DEPTH; ++l) {
    hipLaunchKernelGGL(phase_kernel<1>, g, b, 0, stream, p, l);
    hipLaunchKernelGGL(phase_kernel<2>, g, b, 0, stream, p, l);
    hipLaunchKernelGGL(phase_kernel<3>, g, b, 0, stream, p, l);
    hipLaunchKernelGGL(phase_kernel<4>, g, b, 0, stream, p, l);
    hipLaunchKernelGGL(phase_kernel<5>, g, b, 0, stream, p, l);
  }
#endif
}
```

```cpp
#include <hip/hip_runtime.h>
#include <hip/hip_cooperative_groups.h>
#include <stdint.h>
#include <cstdio>
namespace cg = cooperative_groups;

#ifndef COOP
#define COOP 1
#endif
#ifndef REPEAT
#define REPEAT 0
#endif

#define DI __device__ __forceinline__
typedef unsigned short bf16_t;
typedef short bf16x8 __attribute__((ext_vector_type(8)));
typedef short s16x4 __attribute__((ext_vector_type(4)));
typedef float f32x16 __attribute__((ext_vector_type(16)));
typedef float f32x4 __attribute__((ext_vector_type(4)));
typedef float f32x2 __attribute__((ext_vector_type(2)));
typedef unsigned u32x4 __attribute__((ext_vector_type(4)));
typedef unsigned u32x2 __attribute__((ext_vector_type(2)));
typedef __bf16 bf16x2_t __attribute__((ext_vector_type(2)));

#define MFMA32(a, b, c) __builtin_amdgcn_mfma_f32_32x32x16_bf16((a), (b), (c), 0, 0, 0)

constexpr int BATCH = 2, SEQ = 8192, DMODEL = 1024, MTOK = BATCH * SEQ, NIN = 3868, NPAD = 3968, DEPTH = 2;
constexpr float LOG2E = 1.4426950408889634f;
constexpr float NEGBIG = -1e30f;
constexpr float MINIT = -1e20f;
constexpr int NTHREADS = 256;

constexpr size_t MiB = 1u << 20;
constexpr size_t OFF_CTR = 0, OFF_LAM = 4096, OFF_B1 = 8192, OFF_BAR = 16384, CTL_ZERO_BYTES = 32768;
constexpr size_t OFF_ROPE64 = 1 * MiB, OFF_ROPE32 = 3 * MiB, OFF_WIN = 4 * MiB, OFF_WOUT = 20 * MiB, OFF_W1T = 24 * MiB;
constexpr size_t OFF_XB = 26 * MiB, OFF_G = 58 * MiB, OFF_MIX = 90 * MiB;
constexpr size_t OFF_QF = 122 * MiB, OFF_KF = 130 * MiB, OFF_VFT = 138 * MiB, OFF_QN = 146 * MiB;
constexpr size_t OFF_KCT = 162 * MiB, OFF_VCT = 166 * MiB, OFF_KS = 170 * MiB, OFF_VST = 174 * MiB, OFF_KW = 178 * MiB, OFF_VWT = 182 * MiB;
constexpr size_t OFF_QD = 186 * MiB, OFF_KD = 194 * MiB, OFF_VDT = 202 * MiB;
constexpr size_t OFF_LOGF = 210 * MiB, OFF_CUM = 210 * MiB + 256 * 1024, OFF_GATES = 211 * MiB;
constexpr size_t OFF_KC = 213 * MiB, OFF_VCC = 213 * MiB + 256 * 1024, WS_NEED = 214 * MiB;

constexpr int LDS_BYTES = 73728, LDS_CTL = 32;
constexpr int ATT_BUF = 18944, ATT_V = 9216, ATT_C = 18432;
constexpr int LDS_IMP = 3 * ATT_BUF, LDS_SEL = LDS_BYTES - 512;
static_assert(LDS_IMP + 16384 <= LDS_SEL, "LDS map");
constexpr int GEMM_AB = 18432;

struct Params {
  const float *x, *w_in, *b_fox_f, *pos_k, *pos_v, *w1_k, *w2_k, *w1_v, *w2_v, *lq1, *lk1, *lq2, *lk2, *subln_g, *w_out, *ln_g, *ln_b;
  float* out;
  char* ws;
  long pad_;
};

DI unsigned short f2bf(float f) { unsigned u = __float_as_uint(f); return (unsigned short)((u + 0x7fffu + ((u >> 16) & 1u)) >> 16); }
DI unsigned pk2(float lo, float hi) { f32x2 v = {lo, hi}; bf16x2_t b = __builtin_convertvector(v, bf16x2_t); return __builtin_bit_cast(unsigned, b); }
DI float silu(float x) { return x / (1.f + __expf(-x)); }
DI float sigmoidf(float x) { return 1.f / (1.f + __expf(-x)); }
DI float ex2(float x) { return __builtin_amdgcn_exp2f(x); }
DI float xhalf_max(float v) { auto rr = __builtin_amdgcn_permlane32_swap(__float_as_uint(v), __float_as_uint(v), false, false); return fmaxf(__uint_as_float(rr[0]), __uint_as_float(rr[1])); }
DI float xhalf_sum(float v) { auto rr = __builtin_amdgcn_permlane32_swap(__float_as_uint(v), __float_as_uint(v), false, false); return __uint_as_float(rr[0]) + __uint_as_float(rr[1]); }
DI int crow(int i, int h) { return (i & 3) + 8 * (i >> 2) + 4 * h; }

DI int get_tid() { int t = threadIdx.x; asm volatile("" : "+v"(t)); return t; }
DI int orig_col(int n) {
  int s = n >> 6, c = n & 63;
  if (s < 4) return s * 64 + c;
  if (s < 8) return 256 + (s - 4) * 64 + c;
  if (s < 12) return 512 + (s - 8) * 64 + c;
  if (s < 16) return 772 + (s - 12) * 64 + c;
  if (s < 24) return 1028 + (s - 16) * 64 + c;
  if (s < 36) return 1540 + (s - 24) * 64 + c;
  if (s < 44) return 2332 + (s - 36) * 64 + c;
  if (s < 52) { int base = 2844 + (s - 44) * 64; int nt = c >> 5, r = c & 31, comp = r >> 4, i = r & 15; return base + comp * 32 + nt * 16 + i; }
  if (s < 60) return 3356 + (s - 52) * 64 + c;
  if (s == 60) { if (c < 4) return 768 + c; if (c < 28) return 2308 + (c - 4); return -1; }
  return -1;
}

DI void p0_prologue(const Params& P) {
  const long gtid = (long)blockIdx.x * NTHREADS + get_tid(), gsz = (long)gridDim.x * NTHREADS;
  char* ws = P.ws;
  if (gtid < DEPTH) {
    int l = (int)gtid; float a = 0.f, b = 0.f;
    for (int i = 0; i < 32; ++i) { a += P.lq1[l * 32 + i] * P.lk1[l * 32 + i]; b += P.lq2[l * 32 + i] * P.lk2[l * 32 + i]; }
    float lam_init = 0.8f - 0.6f * expf(-0.3f * (float)l);
    ((float*)(ws + OFF_LAM))[l] = expf(a) - expf(b) + lam_init;
    ((float*)(ws + OFF_LAM))[2 + l] = lam_init;
  }
  for (long it = gtid; it < DEPTH * 2 * 128; it += gsz) {
    int j = it & 127, kv = (it >> 7) & 1, l = (int)(it >> 8);
    const float* pos = (kv ? P.pos_v : P.pos_k) + (size_t)l * 2048;
    const float* w1 = (kv ? P.w1_v : P.w1_k) + (size_t)l * 2048 * 128;
    float a = 0.f;
    for (int k = 0; k < 2048; ++k) a += pos[k] * w1[(size_t)k * 128 + j];
    ((float*)(ws + OFF_B1))[it] = a;
  }
  for (long it = gtid; it < (long)SEQ * 48; it += gsz) {
    int s = (int)(it / 48), i = (int)(it % 48);
    float inv; f32x2* dst;
    if (i < 32) { inv = powf(10000.f, -((float)i * 2.0f / 64.f)); dst = (f32x2*)(ws + OFF_ROPE64) + (size_t)s * 32 + i; }
    else { int ii = i - 32; inv = powf(10000.f, -((float)ii * 2.0f / 32.f)); dst = (f32x2*)(ws + OFF_ROPE32) + (size_t)s * 16 + ii; }
    float ang = (float)s * inv;
    double t = (double)ang * 0.15915494309189535; double fr = t - floor(t); float f = (float)fr;
    f32x2 cs = {__builtin_amdgcn_cosf(f), __builtin_amdgcn_sinf(f)};
    *dst = cs;
  }
  for (long it = gtid; it < (long)DEPTH * 128 * NPAD; it += gsz) {
    int n = (int)(it % NPAD); int k8 = (int)((it / NPAD) & 127); int l = (int)(it / ((long)NPAD * 128));
    int oc = orig_col(n);
    u32x4 v = {0u, 0u, 0u, 0u};
    if (oc >= 0) { const float* src = P.w_in + (size_t)l * DMODEL * NIN + (size_t)(k8 * 8) * NIN + oc;
      float f[8];
#pragma unroll
      for (int j = 0; j < 8; ++j) f[j] = src[(size_t)j * NIN];
      v.x = pk2(f[0], f[1]); v.y = pk2(f[2], f[3]); v.z = pk2(f[4], f[5]); v.w = pk2(f[6], f[7]); }
    *(u32x4*)((bf16_t*)(ws + OFF_WIN) + ((size_t)l * NPAD + n) * DMODEL + k8 * 8) = v;
  }
  for (long it = gtid; it < (long)DEPTH * 128 * 1024; it += gsz) {
    int n = (int)(it & 1023); int k8 = (int)((it >> 10) & 127); int l = (int)(it >> 17);
    const float* src = P.w_out + (size_t)l * 1024 * 1024 + (size_t)(k8 * 8) * 1024 + n;
    float f[8];
#pragma unroll
    for (int j = 0; j < 8; ++j) f[j] = src[(size_t)j * 1024];
    u32x4 v; v.x = pk2(f[0], f[1]); v.y = pk2(f[2], f[3]); v.z = pk2(f[4], f[5]); v.w = pk2(f[6], f[7]);
    *(u32x4*)((bf16_t*)(ws + OFF_WOUT) + ((size_t)l * 1024 + n) * 1024 + k8 * 8) = v;
  }
  for (long it = gtid; it < (long)DEPTH * 2 * 256 * 128; it += gsz) {
    int j = (int)(it & 127); int k8 = (int)((it >> 7) & 255); int kv = (int)((it >> 15) & 1); int l = (int)(it >> 16);
    const float* src = (kv ? P.w1_v : P.w1_k) + (size_t)l * 2048 * 128 + (size_t)(k8 * 8) * 128 + j;
    float f[8];
#pragma unroll
    for (int jj = 0; jj < 8; ++jj) f[jj] = src[(size_t)jj * 128];
    u32x4 v; v.x = pk2(f[0], f[1]); v.y = pk2(f[2], f[3]); v.z = pk2(f[4], f[5]); v.w = pk2(f[6], f[7]);
    *(u32x4*)((bf16_t*)(ws + OFF_W1T) + (((size_t)l * 2 + kv) * 128 + j) * 2048 + k8 * 8) = v;
  }
  for (long it = gtid; it < (long)MTOK * DMODEL / 8; it += gsz) {
    const f32x4* src = (const f32x4*)P.x + it * 2; f32x4 a = src[0], b = src[1];
    u32x4 v; v.x = pk2(a[0], a[1]); v.y = pk2(a[2], a[3]); v.z = pk2(b[0], b[1]); v.w = pk2(b[2], b[3]);
    *((u32x4*)(ws + OFF_XB) + it) = v;
  }
}

#define LDSAS __attribute__((address_space(3)))
DI void glds16(const char* gsrc, char* ldst) {
  __builtin_amdgcn_global_load_lds((const unsigned*)gsrc, (LDSAS unsigned*)ldst, 16, 0, 0);
}
DI void gemm_mainloop(const bf16_t* A, long lda, int a_row_max, const bf16_t* Bt, long ldb, int K, char* lds, f32x16 (&acc)[2][2]) {
  const int tid = get_tid(), lane = tid & 63, wave = __builtin_amdgcn_readfirstlane(tid >> 6), wm = wave >> 1, wn = wave & 1, r = lane & 31, h = lane >> 5;
#pragma unroll
  for (int a = 0; a < 2; ++a)
#pragma unroll
    for (int b = 0; b < 2; ++b)
#pragma unroll
      for (int i = 0; i < 16; ++i) acc[a][b][i] = 0.f;
  const char* ga[4]; const char* gb[4];
#pragma unroll
  for (int i = 0; i < 4; ++i) { const int row = 32 * wave + 8 * i + (lane >> 3), ch = (lane & 7) ^ ((row >> 1) & 7); const int ar = row < a_row_max ? row : a_row_max;
    ga[i] = (const char*)(A + (long)ar * lda) + ch * 16; gb[i] = (const char*)(Bt + (long)row * ldb) + ch * 16; }
  char* const ldw = lds + (32 * wave) * 128;
  const int nk = K >> 6;
#define GEMM_STAGE(BUF, KT) do { _Pragma("unroll") for (int i = 0; i < 4; ++i) { \
    glds16(ga[i] + (long)(KT) * 128, ldw + (BUF) * 32768 + i * 1024); glds16(gb[i] + (long)(KT) * 128, ldw + (BUF) * 32768 + 16384 + i * 1024); } } while (0)
  __syncthreads();
  GEMM_STAGE(0, 0);
  asm volatile("s_waitcnt vmcnt(0)" ::: "memory");
  __syncthreads();
  const int sw = (r >> 1) & 7;
  const unsigned lds0 = (unsigned)(uintptr_t)lds;
  unsigned aa[4], ab[4];
#pragma unroll
  for (int ks = 0; ks < 4; ++ks) { const unsigned xo = (unsigned)(((2 * ks + h) ^ sw) * 16);
    aa[ks] = lds0 + (unsigned)((64 * wm + r) * 128) + xo; ab[ks] = lds0 + 16384u + (unsigned)((64 * wn + r) * 128) + xo; }
  bf16x8 xa0, xa1, xb0, xb1, ya0, ya1, yb0, yb1, za0, za1, zb0, zb1;
#define KT_RD(S, K, O0, O1) \
    "ds_read_b128 %[" #S "a0], %[aa" #K "] offset:" O0 "\n\tds_read_b128 %[" #S "b0], %[ab" #K "] offset:" O0 "\n\t" \
    "ds_read_b128 %[" #S "a1], %[aa" #K "] offset:" O1 "\n\tds_read_b128 %[" #S "b1], %[ab" #K "] offset:" O1 "\n\t"
#define KT_MM(S) \
    "v_mfma_f32_32x32x16_bf16 %[c00], %[" #S "a0], %[" #S "b0], %[c00]\n\tv_mfma_f32_32x32x16_bf16 %[c01], %[" #S "a0], %[" #S "b1], %[c01]\n\t" \
    "v_mfma_f32_32x32x16_bf16 %[c10], %[" #S "a1], %[" #S "b0], %[c10]\n\tv_mfma_f32_32x32x16_bf16 %[c11], %[" #S "a1], %[" #S "b1], %[c11]\n\t"
#define KT_ASM(O0, O1) asm volatile( \
    "s_waitcnt lgkmcnt(0)\n\t" \
    KT_RD(x, 0, O0, O1) KT_RD(y, 1, O0, O1) \
    "s_waitcnt lgkmcnt(4)\n\t" KT_MM(x) KT_RD(z, 2, O0, O1) \
    "s_waitcnt lgkmcnt(4)\n\t" KT_MM(y) KT_RD(x, 3, O0, O1) \
    "s_waitcnt lgkmcnt(4)\n\t" KT_MM(z) \
    "s_waitcnt lgkmcnt(0)\n\t" KT_MM(x) \
    : [c00] "+v"(acc[0][0]), [c01] "+v"(acc[0][1]), [c10] "+v"(acc[1][0]), [c11] "+v"(acc[1][1]), \
      [xa0] "=&v"(xa0), [xa1] "=&v"(xa1), [xb0] "=&v"(xb0), [xb1] "=&v"(xb1), [ya0] "=&v"(ya0), [ya1] "=&v"(ya1), [yb0] "=&v"(yb0), [yb1] "=&v"(yb1), \
      [za0] "=&v"(za0), [za1] "=&v"(za1), [zb0] "=&v"(zb0), [zb1] "=&v"(zb1) \
    : [aa0] "v"(aa[0]), [aa1] "v"(aa[1]), [aa2] "v"(aa[2]), [aa3] "v"(aa[3]), [ab0] "v"(ab[0]), [ab1] "v"(ab[1]), [ab2] "v"(ab[2]), [ab3] "v"(ab[3]) \
    : "memory")
  for (int kt = 0; kt < nk; kt += 2) {
    GEMM_STAGE(1, kt + 1);
    KT_ASM("0", "4096");
    asm volatile("s_waitcnt vmcnt(0)" ::: "memory");
    __syncthreads();
    if (kt + 2 < nk) GEMM_STAGE(0, kt + 2);
    KT_ASM("32768", "36864");
    asm volatile("s_waitcnt vmcnt(0)" ::: "memory");
    __syncthreads();
  }
  asm volatile("s_nop 15\n\ts_nop 7" : "+v"(acc[0][0]), "+v"(acc[0][1]), "+v"(acc[1][0]), "+v"(acc[1][1]));
#undef KT_RD
#undef KT_MM
#undef KT_ASM
#undef GEMM_STAGE
}

DI bool xcd_tile(int i, int NT, int& mt, int& nt) {
  const int G = gridDim.x;
  if ((G & 7) == 0 && G >= 8) {
    const int x = blockIdx.x & 7, j = blockIdx.x >> 3, per = G >> 3;
    const int u = j + per * i; if (u >= 16 * NT) return false;
    const int grp = u / (8 * NT), v = u - grp * (8 * NT);
    mt = 16 * x + 8 * grp + (v & 7); nt = v >> 3; return true;
  }
  const int t = blockIdx.x + G * i; if (t >= 128 * NT) return false;
  mt = t / NT; nt = t - mt * NT; return true;
}

DI void epi_inproj(const Params& P, int l, const f32x16 (&acc)[2][2], int m0, int n0) {
  const int tid = get_tid(), lane = tid & 63, wave = tid >> 6, wm = wave >> 1, wn = wave & 1, r = lane & 31, h = lane >> 5;
  char* ws = P.ws;
  const int slot = (n0 >> 6) + wn;
  const int b = m0 >> 13;
  const int srow0 = (m0 & (SEQ - 1)) + 64 * wm;
  int cat = 0;
  int rope = 0; float scale = 1.f; bf16_t* dst = nullptr; int gcol = 0;
  const float QS = 0.125f * LOG2E;
  if (slot < 4) { cat = 1; scale = QS; dst = (bf16_t*)(ws + OFF_QF) + (size_t)(b * 4 + slot) * SEQ * 64; }
  else if (slot < 8) { cat = 1; dst = (bf16_t*)(ws + OFF_KF) + (size_t)(b * 4 + slot - 4) * SEQ * 64; }
  else if (slot < 12) { cat = 2; dst = (bf16_t*)(ws + OFF_VFT) + (size_t)(b * 4 + slot - 8) * SEQ * 64; }
  else if (slot < 16) { cat = 3; gcol = (slot - 12) * 64; }
  else if (slot < 24) { cat = 1; rope = 1; scale = QS; dst = (bf16_t*)(ws + OFF_QN) + (size_t)(b * 8 + slot - 16) * SEQ * 64; }
  else if (slot < 26) { cat = 1; rope = 1; dst = (bf16_t*)(ws + OFF_KCT) + (size_t)(b * 2 + slot - 24) * SEQ * 64; }
  else if (slot < 28) { cat = 1; dst = (bf16_t*)(ws + OFF_VCT) + (size_t)(b * 2 + slot - 26) * SEQ * 64; }
  else if (slot < 30) { cat = 1; rope = 1; dst = (bf16_t*)(ws + OFF_KS) + (size_t)(b * 2 + slot - 28) * SEQ * 64; }
  else if (slot < 32) { cat = 2; dst = (bf16_t*)(ws + OFF_VST) + (size_t)(b * 2 + slot - 30) * SEQ * 64; }
  else if (slot < 34) { cat = 1; rope = 1; dst = (bf16_t*)(ws + OFF_KW) + (size_t)(b * 2 + slot - 32) * SEQ * 64; }
  else if (slot < 36) { cat = 2; dst = (bf16_t*)(ws + OFF_VWT) + (size_t)(b * 2 + slot - 34) * SEQ * 64; }
  else if (slot < 44) { cat = 3; gcol = 256 + (slot - 36) * 64; }
  else if (slot < 48) { cat = 1; rope = 2; scale = 0.17677669529663687f * LOG2E; dst = (bf16_t*)(ws + OFF_QD) + (size_t)(b * 4 + slot - 44) * SEQ * 64; }
  else if (slot < 52) { cat = 1; rope = 2; dst = (bf16_t*)(ws + OFF_KD) + (size_t)(b * 4 + slot - 48) * SEQ * 64; }
  else if (slot < 56) { cat = 2; dst = (bf16_t*)(ws + OFF_VDT) + (size_t)(b * 4 + slot - 52) * SEQ * 64; }
  else if (slot < 60) { cat = 3; gcol = 768 + (slot - 56) * 64; }
  else if (slot == 60) cat = 4;

  if (cat == 1) {
    int c0 = r, c1 = 32 + r;
    if (rope == 2) { int comp = r >> 4, ii = r & 15; c0 = comp * 32 + ii; c1 = comp * 32 + 16 + ii; }
    const f32x2* tab = (rope == 1) ? ((const f32x2*)(ws + OFF_ROPE64) + r) : ((const f32x2*)(ws + OFF_ROPE32) + (r & 15));
    const int tstride = (rope == 1) ? 32 : 16;
#pragma unroll
    for (int mt = 0; mt < 2; ++mt)
#pragma unroll
      for (int i = 0; i < 16; ++i) {
        int s = srow0 + 32 * mt + crow(i, h);
        float v0 = acc[mt][0][i], v1 = acc[mt][1][i];
        if (rope) { f32x2 cs = tab[(size_t)s * tstride]; float y0 = v0 * cs[0] - v1 * cs[1], y1 = v1 * cs[0] + v0 * cs[1]; v0 = y0; v1 = y1; }
        v0 *= scale; v1 *= scale;
        dst[(size_t)s * 64 + c0] = f2bf(v0); dst[(size_t)s * 64 + c1] = f2bf(v1);
      }
  } else if (cat == 2) {
#pragma unroll
    for (int mt = 0; mt < 2; ++mt)
#pragma unroll
      for (int g = 0; g < 4; ++g) {
        int s = srow0 + 32 * mt + 8 * g + 4 * h;
#pragma unroll
        for (int nt = 0; nt < 2; ++nt) {
          u32x2 v; v.x = pk2(acc[mt][nt][4 * g], acc[mt][nt][4 * g + 1]); v.y = pk2(acc[mt][nt][4 * g + 2], acc[mt][nt][4 * g + 3]);
          *(u32x2*)(dst + (size_t)(32 * nt + r) * SEQ + s) = v;
        }
      }
  } else if (cat == 3) {
    bf16_t* G = (bf16_t*)(ws + OFF_G);
#pragma unroll
    for (int mt = 0; mt < 2; ++mt)
#pragma unroll
      for (int i = 0; i < 16; ++i) {
        size_t row = (size_t)m0 + 64 * wm + 32 * mt + crow(i, h);
        G[row * 1024 + gcol + r] = f2bf(silu(acc[mt][0][i])); G[row * 1024 + gcol + 32 + r] = f2bf(silu(acc[mt][1][i]));
      }
  } else if (cat == 4) {
    if (r < 28) {
      float bias = (r < 4) ? P.b_fox_f[l * 4 + r] : 0.f;
#pragma unroll
      for (int mt = 0; mt < 2; ++mt)
#pragma unroll
        for (int i = 0; i < 16; ++i) {
          int s = srow0 + 32 * mt + crow(i, h);
          float v = acc[mt][0][i];
          if (r < 4) { float xx = v + bias; float ls = fminf(xx, 0.f) - log1pf(expf(-fabsf(xx)));
            ((float*)(ws + OFF_LOGF))[(size_t)(b * 4 + r) * SEQ + s] = ls * LOG2E; }
          else ((float*)(ws + OFF_GATES))[((size_t)b * SEQ + s) * 24 + (r - 4)] = sigmoidf(v);
        }
    }
  }
}

DI void p1_inproj(const Params& P, int l, char* lds) {
  const bf16_t* A = (const bf16_t*)(P.ws + OFF_XB);
  const bf16_t* Bt = (const bf16_t*)(P.ws + OFF_WIN) + (size_t)l * NPAD * DMODEL;
  const int NT = NPAD / 128;
  int mt, nt;
  for (int i = 0; xcd_tile(i, NT, mt, nt); ++i) {
    f32x16 acc[2][2];
    gemm_mainloop(A + (size_t)mt * 128 * DMODEL, DMODEL, 127, Bt + (size_t)nt * 128 * DMODEL, DMODEL, DMODEL, lds, acc);
    epi_inproj(P, l, acc, mt * 128, nt * 128);
  }
}

DI void p4_outproj(const Params& P, int l, char* lds) {
  const bf16_t* A = (const bf16_t*)(P.ws + OFF_MIX);
  const bf16_t* Bt = (const bf16_t*)(P.ws + OFF_WOUT) + (size_t)l * 1024 * 1024;
  const float* xres = (l == 0) ? P.x : P.out;
  const float alpha = 1.4142135623730951f;
  const int tid = get_tid(), lane = tid & 63, wave = tid >> 6, wm = wave >> 1, wn = wave & 1, r = lane & 31, h = lane >> 5;
  int mt, nt;
  for (int i = 0; xcd_tile(i, 8, mt, nt); ++i) {
    f32x16 acc[2][2];
    gemm_mainloop(A + (size_t)mt * 128 * 1024, 1024, 127, Bt + (size_t)nt * 128 * 1024, 1024, 1024, lds, acc);
#pragma unroll
    for (int a = 0; a < 2; ++a)
#pragma unroll
      for (int bb = 0; bb < 2; ++bb)
#pragma unroll
        for (int i = 0; i < 16; ++i) {
          size_t row = (size_t)mt * 128 + 64 * wm + 32 * a + crow(i, h); int col = nt * 128 + 64 * wn + 32 * bb + r;
          P.out[row * 1024 + col] = alpha * xres[row * 1024 + col] + acc[a][bb][i];
        }
  }
}

DI void p5_ln(const Params& P, int l) {
  const int lane = get_tid() & 63, wave = get_tid() >> 6;
  const float* g = P.ln_g + l * 1024; const float* bb = P.ln_b + l * 1024;
  for (int row = blockIdx.x * 4 + wave; row < MTOK; row += gridDim.x * 4) {
    float* p = P.out + (size_t)row * 1024;
    f32x4 v[4]; float s = 0.f;
#pragma unroll
    for (int k = 0; k < 4; ++k) { v[k] = *(const f32x4*)(p + k * 256 + lane * 4); s += v[k][0] + v[k][1] + v[k][2] + v[k][3]; }
#pragma unroll
    for (int o = 32; o >= 1; o >>= 1) s += __shfl_xor(s, o);
    float mean = s * (1.f / 1024.f); float q = 0.f;
#pragma unroll
    for (int k = 0; k < 4; ++k)
#pragma unroll
      for (int e = 0; e < 4; ++e) { float d = v[k][e] - mean; q += d * d; }
#pragma unroll
    for (int o = 32; o >= 1; o >>= 1) q += __shfl_xor(q, o);
    float rstd = rsqrtf(q * (1.f / 1024.f) + 1e-5f);
#pragma unroll
    for (int k = 0; k < 4; ++k) {
      int c = k * 256 + lane * 4; f32x4 gg = *(const f32x4*)(g + c), bv = *(const f32x4*)(bb + c); f32x4 o;
#pragma unroll
      for (int e = 0; e < 4; ++e) o[e] = (v[k][e] - mean) * rstd * gg[e] + bv[e];
      *(f32x4*)(p + c) = o;
      if (l + 1 < DEPTH) {
        u32x2 w; w.x = pk2(o[0], o[1]); w.y = pk2(o[2], o[3]);
        *(u32x2*)((bf16_t*)(P.ws + OFF_XB) + (size_t)row * 1024 + c) = w; }
    }
  }
}

enum { M_FOX = 0, M_DIFF = 1, M_CMP1 = 2, M_CMP2 = 3, M_SEL = 4, M_WIN = 5 };
struct AttnState { f32x16 o[2]; float m, l; };
struct TileSrc { const bf16_t* K; const bf16_t* Vt; long vstride; const float* C; };

template <bool HASV, bool HASC>
DI void tile_gload(const TileSrc& s, int T, u32x4 (&rk)[2], u32x4 (&rv)[2], f32x4& rc, int tid) {
#pragma unroll
  for (int p = 0; p < 2; ++p) { int id = tid + 256 * p, row = id >> 3, ch = id & 7;
    rk[p] = *(const u32x4*)(s.K + ((long)(64 * T + row)) * 64 + ch * 8);
    if (HASV) rv[p] = *(const u32x4*)(s.Vt + (long)row * s.vstride + 64 * T + ch * 8); }
  if (HASC) { if (tid < 16) rc = *(const f32x4*)(s.C + 64 * T + 4 * tid); }
}
template <bool HASV, bool HASC>
DI void tile_sstore(char* buf, const u32x4 (&rk)[2], const u32x4 (&rv)[2], const f32x4& rc, int tid) {
#pragma unroll
  for (int p = 0; p < 2; ++p) { int id = tid + 256 * p, row = id >> 3, ch = id & 7;
    *(u32x4*)(buf + row * 144 + ch * 16) = rk[p];
    if (HASV) { char* d = buf + ATT_V + row * 136 + ch * 16; u32x2 a = {rv[p].x, rv[p].y}, b = {rv[p].z, rv[p].w}; *(u32x2*)d = a; *(u32x2*)(d + 8) = b; } }
  if (HASC) { if (tid < 16) *(f32x4*)(buf + ATT_C + tid * 16) = -rc; }
}

constexpr float MREF0 = -32.f;
constexpr float RSUM = 1099511627776.f;

template <int MODE>
DI void qk_part(f32x16 (&p)[2], const bf16x8* qf, const char* buf, int koffb, const f32x16& negm, int r, int h) {
  constexpr int ND0 = (MODE == M_DIFF) ? 2 : 4;
  const char* kl = buf; const float* cl = (const float*)(buf + ATT_C);
  if (MODE == M_FOX) {
    const float nm = negm[0];
#pragma unroll
    for (int c = 0; c < 2; ++c)
#pragma unroll
      for (int g = 0; g < 4; ++g) { f32x4 ck = *(const f32x4*)(cl + 32 * c + 8 * g + 4 * h);
#pragma unroll
        for (int e = 0; e < 4; ++e) p[c][4 * g + e] = ck[e] + nm; }
  }
#pragma unroll
  for (int d0 = 0; d0 < ND0; ++d0) {
    const char* kp = kl + r * 144 + koffb + (16 * d0 + 8 * h) * 2;
    bf16x8 k0 = *(const bf16x8*)kp; bf16x8 k1 = *(const bf16x8*)(kp + 32 * 144);
    if (MODE != M_FOX && d0 == 0) { p[0] = MFMA32(k0, qf[d0], negm); p[1] = MFMA32(k1, qf[d0], negm); }
    else { p[0] = MFMA32(k0, qf[d0], p[0]); p[1] = MFMA32(k1, qf[d0], p[1]); }
  }
}

template <int MODE>
DI void sp_part(AttnState& st, f32x16 (&p)[2], f32x16& negm, const char* buf, int T, int tq, unsigned selbit,
                float inv_l, unsigned* imp_q, int r, int h) {
  const char* vl = buf + ATT_V;
  const int kvb = 64 * T + 4 * h;
  int lim, lo;
  if (MODE == M_CMP1 || MODE == M_CMP2) { lim = (tq - 31) >> 4; lo = -(1 << 30); }
  else if (MODE == M_SEL) { lim = selbit ? tq : -1; lo = -(1 << 30); }
  else if (MODE == M_WIN) { lim = tq; lo = tq - 511; }
  else { lim = tq; lo = -(1 << 30); }
  const bool full = (lim >= 64 * T + 63) && (lo <= 64 * T);
  bool lane_on = true; bool sel_interior = false;
  if (MODE == M_SEL) sel_interior = __all(tq >= 64 * T + 63) != 0;
  if (sel_interior) lane_on = (selbit != 0u);
  else if (!__all(full)) {
#pragma unroll
    for (int c = 0; c < 2; ++c)
#pragma unroll
      for (int i = 0; i < 16; ++i) { int kv = kvb + 32 * c + 8 * (i >> 2) + (i & 3); if (kv > lim || kv < lo) p[c][i] = NEGBIG; }
  }
  float tile_sum = 0.f;
  if (MODE == M_CMP2) {
#pragma unroll
    for (int c = 0; c < 2; ++c)
#pragma unroll
      for (int i = 0; i < 16; ++i) p[c][i] = ex2(p[c][i]) * inv_l;
#pragma unroll
    for (int c = 0; c < 2; ++c)
#pragma unroll
      for (int g = 0; g < 4; ++g) {
        int j = 16 * T + 8 * c + 2 * g + h;
        float bq = 0.5f * p[c][4 * g + 3]; float aq = p[c][4 * g] + p[c][4 * g + 1] + p[c][4 * g + 2] + bq;
        atomicAdd(&imp_q[j * 32], (unsigned)(aq * 4194304.f + 0.5f));
        if (j + 1 < 128) atomicAdd(&imp_q[(j + 1) * 32], (unsigned)(bq * 4194304.f + 0.5f));
      }
  } else {
    float sum = 0.f;
#pragma unroll
    for (int c = 0; c < 2; ++c)
#pragma unroll
      for (int i = 0; i < 16; ++i) { float e = ex2(p[c][i]); p[c][i] = e; sum += e; }
    if (MODE == M_SEL) sum = lane_on ? sum : 0.f;
    st.l += sum;
    tile_sum = sum;
  }
  if (MODE != M_CMP1) {
#pragma unroll
    for (int c = 0; c < 2; ++c)
#pragma unroll
      for (int s2 = 0; s2 < 2; ++s2) {
        u32x4 pw; pw.x = pk2(p[c][8 * s2], p[c][8 * s2 + 1]); pw.y = pk2(p[c][8 * s2 + 2], p[c][8 * s2 + 3]);
        pw.z = pk2(p[c][8 * s2 + 4], p[c][8 * s2 + 5]); pw.w = pk2(p[c][8 * s2 + 6], p[c][8 * s2 + 7]);
        if (MODE == M_SEL) { if (!lane_on) { pw.x = 0u; pw.y = 0u; pw.z = 0u; pw.w = 0u; } }
        bf16x8 pf = __builtin_bit_cast(bf16x8, pw);
#pragma unroll
        for (int dt = 0; dt < 2; ++dt) {
          const char* vp = vl + (32 * dt + r) * 136 + (32 * c + 16 * s2 + 4 * h) * 2;
          s16x4 lo4 = *(const s16x4*)vp; s16x4 hi4 = *(const s16x4*)(vp + 16);
          bf16x8 vf = __builtin_shufflevector(lo4, hi4, 0, 1, 2, 3, 4, 5, 6, 7);
          st.o[dt] = MFMA32(vf, pf, st.o[dt]);
        }
      }
  }
  if (MODE != M_CMP2) {
    if (__any(tile_sum > RSUM)) {
      const float tot = xhalf_sum(tile_sum);
      const float dl = (tot > RSUM) ? __builtin_amdgcn_logf(tot) : 0.f;
      st.m += dl;
      const float nm = -st.m;
#pragma unroll
      for (int i = 0; i < 16; ++i) negm[i] = nm;
      const float f = ex2(-dl);
      st.l *= f;
      if (MODE != M_CMP1) {
#pragma unroll
        for (int i = 0; i < 16; ++i) { st.o[0][i] *= f; st.o[1][i] *= f; }
      }
    }
  }
}

template <int MODE>
DI bool tile_active(int T, int twmax, int qspan, const unsigned* selmask_q) {
  bool a;
  if (MODE == M_CMP1 || MODE == M_CMP2) a = (16 * (64 * T) + 31 <= twmax);
  else a = (64 * T <= twmax);
  if (MODE == M_WIN) a = a && (64 * T + 63 >= twmax - qspan - 511);
  if (MODE == M_SEL) { if (a) a = __any((int)((selmask_q[T >> 5] >> (T & 31)) & 1u)) != 0; }
  return a;
}

template <int MODE>
DI void run_tiles(AttnState& st, const bf16x8* qf, const TileSrc& src, int T0, int T1, int tq, int twmax_, int qspan, int koffb,
                  const unsigned* selmask_q, float m_fin, float inv_l, unsigned* imp_q, char* lds, int tid, int r, int h) {
  constexpr bool HASV = (MODE != M_CMP1), HASC = (MODE == M_FOX);
  const int twmax = __builtin_amdgcn_readfirstlane(twmax_);
  const float m0 = (MODE == M_CMP2) ? m_fin : MREF0;
  u32x4 rk[2], rv[2]; f32x4 rc;
  st.m = m0;
  f32x16 negm;
#pragma unroll
  for (int i = 0; i < 16; ++i) negm[i] = -m0;
  __syncthreads();
  if (T0 < T1) { tile_gload<HASV, HASC>(src, T0, rk, rv, rc, tid); tile_sstore<HASV, HASC>(lds, rk, rv, rc, tid); }
  if (T0 + 1 < T1) tile_gload<HASV, HASC>(src, T0 + 1, rk, rv, rc, tid);
  int slot = 0;
  for (int T = T0; T < T1; ++T) {
    const char* buf = lds + slot * ATT_BUF;
    slot = (slot == 2) ? 0 : slot + 1;
    if (T + 1 < T1) tile_sstore<HASV, HASC>(lds + slot * ATT_BUF, rk, rv, rc, tid);
    if (T + 2 < T1) tile_gload<HASV, HASC>(src, T + 2, rk, rv, rc, tid);
    __syncthreads();
    if (tile_active<MODE>(T, twmax, qspan, selmask_q)) {
      unsigned selbit = 0;
      if (MODE == M_SEL) selbit = (selmask_q[T >> 5] >> (T & 31)) & 1u;
      f32x16 p[2];
      qk_part<MODE>(p, qf, buf, koffb, negm, r, h);
      sp_part<MODE>(st, p, negm, buf, T, tq, selbit, inv_l, imp_q, r, h);
    }
  }
}

DI void st_init(AttnState& st) {
#pragma unroll
  for (int i = 0; i < 16; ++i) { st.o[0][i] = 0.f; st.o[1][i] = 0.f; }
  st.m = MREF0; st.l = 0.f;
}
DI float st_invl(const AttnState& st) { float lt = xhalf_sum(st.l); return lt > 0.f ? 1.f / lt : 0.f; }

DI void store_mix(const Params& P, size_t token, int col, float a, float b, float c, float d) {
  const bf16_t* G = (const bf16_t*)(P.ws + OFF_G) + token * 1024 + col;
  u32x2 gv = *(const u32x2*)G;
  float g0 = __uint_as_float(gv.x << 16), g1 = __uint_as_float(gv.x & 0xffff0000u), g2 = __uint_as_float(gv.y << 16), g3 = __uint_as_float(gv.y & 0xffff0000u);
  u32x2 w; w.x = pk2(a * g0, b * g1); w.y = pk2(c * g2, d * g3);
  *(u32x2*)((bf16_t*)(P.ws + OFF_MIX) + token * 1024 + col) = w;
}

DI void fox_unit(const Params& P, int bh, int qt, char* lds) {
  const int tid = get_tid(), lane = tid & 63, wave = tid >> 6, r = lane & 31, h = lane >> 5;
  const int t0 = 128 * qt, tq = t0 + 32 * wave + r, twmax = t0 + 32 * wave + 31;
  const bf16_t* Q = (const bf16_t*)(P.ws + OFF_QF) + (size_t)bh * SEQ * 64;
  TileSrc src; src.K = (const bf16_t*)(P.ws + OFF_KF) + (size_t)bh * SEQ * 64; src.Vt = (const bf16_t*)(P.ws + OFF_VFT) + (size_t)bh * SEQ * 64; src.vstride = SEQ;
  src.C = (const float*)(P.ws + OFF_CUM) + (size_t)bh * SEQ;
  bf16x8 qf[4];
#pragma unroll
  for (int d0 = 0; d0 < 4; ++d0) qf[d0] = *(const bf16x8*)(Q + (size_t)tq * 64 + 16 * d0 + 8 * h);
  AttnState st; st_init(st);
  run_tiles<M_FOX>(st, qf, src, 0, 2 * qt + 2, tq, twmax, 31, 0, nullptr, 0.f, 0.f, nullptr, lds, tid, r, h);
  const float inv = st_invl(st);
  const size_t token = (size_t)(bh >> 2) * SEQ + tq; const int hd = bh & 3;
#pragma unroll
  for (int dt = 0; dt < 2; ++dt)
#pragma unroll
    for (int g = 0; g < 4; ++g)
      store_mix(P, token, hd * 64 + 32 * dt + 8 * g + 4 * h, st.o[dt][4 * g] * inv, st.o[dt][4 * g + 1] * inv, st.o[dt][4 * g + 2] * inv, st.o[dt][4 * g + 3] * inv);
}

DI void diff_unit(const Params& P, int l, int bh, int qt, char* lds) {
  const int tid = get_tid(), lane = tid & 63, wave = tid >> 6, r = lane & 31, h = lane >> 5;
  const int comp = wave & 1, qs = wave >> 1;
  const int t0 = 64 * qt, tq = t0 + 32 * qs + r, twmax = t0 + 32 * qs + 31;
  const bf16_t* Q = (const bf16_t*)(P.ws + OFF_QD) + (size_t)bh * SEQ * 64;
  TileSrc src; src.K = (const bf16_t*)(P.ws + OFF_KD) + (size_t)bh * SEQ * 64; src.Vt = (const bf16_t*)(P.ws + OFF_VDT) + (size_t)bh * SEQ * 64; src.vstride = SEQ; src.C = nullptr;
  bf16x8 qf[2];
#pragma unroll
  for (int d0 = 0; d0 < 2; ++d0) qf[d0] = *(const bf16x8*)(Q + (size_t)tq * 64 + comp * 32 + 16 * d0 + 8 * h);
  AttnState st; st_init(st);
  run_tiles<M_DIFF>(st, qf, src, 0, qt + 1, tq, twmax, 31, comp * 64, nullptr, 0.f, 0.f, nullptr, lds, tid, r, h);
  const float inv = st_invl(st);
  float* exch = (float*)(lds + LDS_IMP);
  __syncthreads();
  if (comp == 1) {
#pragma unroll
    for (int dt = 0; dt < 2; ++dt)
#pragma unroll
      for (int i = 0; i < 16; ++i) exch[(qs * 64 + 32 * dt + crow(i, h)) * 32 + r] = st.o[dt][i] * inv;
  }
  __syncthreads();
  if (comp == 0) {
    const float lam = ((const float*)(P.ws + OFF_LAM))[l], lam_init = ((const float*)(P.ws + OFF_LAM))[2 + l];
    float ss = 0.f;
#pragma unroll
    for (int dt = 0; dt < 2; ++dt)
#pragma unroll
      for (int i = 0; i < 16; ++i) { float a = st.o[dt][i] * inv - lam * exch[(qs * 64 + 32 * dt + crow(i, h)) * 32 + r]; st.o[dt][i] = a; ss += a * a; }
    ss = xhalf_sum(ss);
    const float rms = rsqrtf(ss * (1.f / 64.f) + 1e-5f) * (1.f - lam_init);
    const size_t token = (size_t)(bh >> 2) * SEQ + tq; const int hd = bh & 3;
    const float* sg = P.subln_g + l * 64;
#pragma unroll
    for (int dt = 0; dt < 2; ++dt)
#pragma unroll
      for (int g = 0; g < 4; ++g) { int d = 32 * dt + 8 * g + 4 * h; f32x4 gg = *(const f32x4*)(sg + d);
        store_mix(P, token, 768 + hd * 64 + d, st.o[dt][4 * g] * rms * gg[0], st.o[dt][4 * g + 1] * rms * gg[1], st.o[dt][4 * g + 2] * rms * gg[2], st.o[dt][4 * g + 3] * rms * gg[3]); }
  }
}

DI void nsa_unit(const Params& P, int bg, int qt, char* lds) {
  const int tid = get_tid(), lane = tid & 63, wave = tid >> 6, r = lane & 31, h = lane >> 5;
  const int b = bg >> 1, g2 = bg & 1, head8 = g2 * 4 + (r & 3);
  const int t0 = 32 * qt, ql = 8 * wave + (r >> 2), tq = t0 + ql, tmax = t0 + 31, twmax = t0 + 8 * wave + 7;
  const bf16_t* Q = (const bf16_t*)(P.ws + OFF_QN) + (size_t)(b * 8 + head8) * SEQ * 64;
  bf16x8 qf[4];
#pragma unroll
  for (int d0 = 0; d0 < 4; ++d0) qf[d0] = *(const bf16x8*)(Q + (size_t)tq * 64 + 16 * d0 + 8 * h);
  unsigned* imp = (unsigned*)(lds + LDS_IMP);
  unsigned* selm = (unsigned*)(lds + LDS_SEL);
#pragma unroll
  for (int k = 0; k < 16; ++k) imp[tid + 256 * k] = 0u;
  const float* gates = (const float*)(P.ws + OFF_GATES) + ((size_t)b * SEQ + tq) * 24 + 3 * head8;
  const float gc = gates[0], gs = gates[1], gw = gates[2];
  unsigned* stash = (unsigned*)(lds + LDS_IMP) + wave * 16 * 64 + lane;
  TileSrc src; src.K = (const bf16_t*)(P.ws + OFF_KC) + (size_t)bg * 512 * 64; src.Vt = (const bf16_t*)(P.ws + OFF_VCC) + (size_t)bg * 64 * 512; src.vstride = 512; src.C = nullptr;
  int nvis = (t0 >> 4) + 1; if (nvis > 511) nvis = 511;
  const int ntc = (nvis + 63) >> 6;
  AttnState st; st_init(st);
  run_tiles<M_CMP1>(st, qf, src, 0, ntc, tq, twmax, 7, 0, nullptr, 0.f, 0.f, nullptr, lds, tid, r, h);
  {
    const float m_fin = st.m, inv_l = st_invl(st);
    st_init(st);
    run_tiles<M_CMP2>(st, qf, src, 0, ntc, tq, twmax, 7, 0, nullptr, m_fin, inv_l, imp + ql, lds, tid, r, h);
  }
  __syncthreads();
  {
    const int q = tid >> 3, jg = tid & 7; const int t = t0 + q, cur = t >> 6;
    unsigned key[16];
#pragma unroll
    for (int e = 0; e < 16; ++e) { int j = 16 * jg + e; unsigned v = imp[j * 32 + q];
      bool valid = j <= cur, forced = (j == 0) || (j == cur) || (j == cur - 1);
      key[e] = !valid ? 0u : (forced ? (0xFFFFFF80u | (unsigned)(127 - j)) : ((v << 7) | (unsigned)(127 - j))); }
    unsigned sel = 0;
    for (int round = 0; round < 16; ++round) {
      unsigned m = key[0];
#pragma unroll
      for (int e = 1; e < 16; ++e) m = m > key[e] ? m : key[e];
      unsigned o;
      o = __shfl_xor(m, 1); m = m > o ? m : o; o = __shfl_xor(m, 2); m = m > o ? m : o; o = __shfl_xor(m, 4); m = m > o ? m : o;
      if (m != 0u) {
#pragma unroll
        for (int e = 0; e < 16; ++e) if (key[e] == m) { sel |= 1u << e; key[e] = 0u; }
      }
    }
    ((unsigned short*)selm)[q * 8 + jg] = (unsigned short)sel;
  }
  __syncthreads();
#pragma unroll
  for (int i = 0; i < 8; ++i) { stash[i * 64] = pk2(gc * st.o[0][2 * i], gc * st.o[0][2 * i + 1]); stash[(8 + i) * 64] = pk2(gc * st.o[1][2 * i], gc * st.o[1][2 * i + 1]); }
  src.K = (const bf16_t*)(P.ws + OFF_KS) + (size_t)bg * SEQ * 64; src.Vt = (const bf16_t*)(P.ws + OFF_VST) + (size_t)bg * SEQ * 64; src.vstride = SEQ;
  st_init(st);
  run_tiles<M_SEL>(st, qf, src, 0, (tmax >> 6) + 1, tq, twmax, 7, 0, selm + ql * 4, 0.f, 0.f, nullptr, lds, tid, r, h);
  { const float inv = st_invl(st) * gs;
#pragma unroll
    for (int i = 0; i < 8; ++i) { unsigned a = stash[i * 64], bq = stash[(8 + i) * 64];
      stash[i * 64] = pk2(__uint_as_float(a << 16) + inv * st.o[0][2 * i], __uint_as_float(a & 0xffff0000u) + inv * st.o[0][2 * i + 1]);
      stash[(8 + i) * 64] = pk2(__uint_as_float(bq << 16) + inv * st.o[1][2 * i], __uint_as_float(bq & 0xffff0000u) + inv * st.o[1][2 * i + 1]); } }
  src.K = (const bf16_t*)(P.ws + OFF_KW) + (size_t)bg * SEQ * 64; src.Vt = (const bf16_t*)(P.ws + OFF_VWT) + (size_t)bg * SEQ * 64;
  st_init(st);
  { int lo_t = t0 - 511; int T0 = lo_t > 0 ? (lo_t >> 6) : 0;
    run_tiles<M_WIN>(st, qf, src, T0, (tmax >> 6) + 1, tq, twmax, 7, 0, nullptr, 0.f, 0.f, nullptr, lds, tid, r, h); }
  { const float inv = st_invl(st) * gw;
#pragma unroll
    for (int i = 0; i < 8; ++i) { unsigned a = stash[i * 64], bq = stash[(8 + i) * 64];
      st.o[0][2 * i] = __uint_as_float(a << 16) + inv * st.o[0][2 * i]; st.o[0][2 * i + 1] = __uint_as_float(a & 0xffff0000u) + inv * st.o[0][2 * i + 1];
      st.o[1][2 * i] = __uint_as_float(bq << 16) + inv * st.o[1][2 * i]; st.o[1][2 * i + 1] = __uint_as_float(bq & 0xffff0000u) + inv * st.o[1][2 * i + 1]; } }
  const size_t token = (size_t)b * SEQ + tq;
#pragma unroll
  for (int dt = 0; dt < 2; ++dt)
#pragma unroll
    for (int g = 0; g < 4; ++g)
      store_mix(P, token, 256 + head8 * 64 + 32 * dt + 8 * g + 4 * h, st.o[dt][4 * g], st.o[dt][4 * g + 1], st.o[dt][4 * g + 2], st.o[dt][4 * g + 3]);
}

DI void compress_tile(const Params& P, int l, int id, char* lds) {
  const int tid = get_tid(), lane = tid & 63, wave = tid >> 6, wm = wave >> 1, wn = wave & 1, r = lane & 31, h = lane >> 5;
  const int kv = id >> 4, bg = (id >> 2) & 3, mt = id & 3;
  const bf16_t* tok = (const bf16_t*)(P.ws + (kv ? OFF_VCT : OFF_KCT)) + (size_t)bg * SEQ * 64;
  const bf16_t* Bt = (const bf16_t*)(P.ws + OFF_W1T) + ((size_t)l * 2 + kv) * 128 * 2048;
  f32x16 acc[2][2];
  int rowmax = 510 - 128 * mt; if (rowmax > 127) rowmax = 127;
  gemm_mainloop(tok + (size_t)mt * 128 * 1024, 1024, rowmax, Bt, 2048, 2048, lds, acc);
  __syncthreads();
  float* H = (float*)lds;
  const float* bias = (const float*)(P.ws + OFF_B1) + (l * 2 + kv) * 128;
#pragma unroll
  for (int a = 0; a < 2; ++a)
#pragma unroll
    for (int bb = 0; bb < 2; ++bb) { int col = 64 * wn + 32 * bb + r; float bv = bias[col];
#pragma unroll
      for (int i = 0; i < 16; ++i) { int row = 64 * wm + 32 * a + crow(i, h); H[row * 129 + col] = silu(acc[a][bb][i] + bv); } }
  __syncthreads();
  const float* w2 = (kv ? P.w2_v : P.w2_k) + (size_t)l * 128 * 64;
  const int c = tid & 63, rg = tid >> 6;
  float o[32];
#pragma unroll
  for (int i = 0; i < 32; ++i) o[i] = 0.f;
  for (int j = 0; j < 128; ++j) { float w = w2[j * 64 + c];
#pragma unroll
    for (int i = 0; i < 32; ++i) o[i] += H[(rg * 32 + i) * 129 + j] * w; }
  if (kv == 0) { bf16_t* dst = (bf16_t*)(P.ws + OFF_KC) + (size_t)bg * 512 * 64;
#pragma unroll
    for (int i = 0; i < 32; ++i) { int n = 128 * mt + rg * 32 + i; dst[(size_t)n * 64 + c] = f2bf(o[i]); } }
  else { bf16_t* dst = (bf16_t*)(P.ws + OFF_VCC) + (size_t)bg * 64 * 512;
#pragma unroll
    for (int i = 0; i < 32; ++i) { int n = 128 * mt + rg * 32 + i; dst[(size_t)c * 512 + n] = f2bf(o[i]); } }
  __syncthreads();
}

DI void cumsum_seq(const Params& P, int bh, char* lds) {
  const int tid = get_tid();
  const float* src = (const float*)(P.ws + OFF_LOGF) + (size_t)bh * SEQ + tid * 32;
  float* dst = (float*)(P.ws + OFF_CUM) + (size_t)bh * SEQ + tid * 32;
  float* tot = (float*)lds;
  f32x4 v[8]; float s = 0.f;
#pragma unroll
  for (int k = 0; k < 8; ++k) { v[k] = *(const f32x4*)(src + 4 * k);
#pragma unroll
    for (int e = 0; e < 4; ++e) { s += v[k][e]; v[k][e] = s; } }
  __syncthreads();
  tot[tid] = s;
  __syncthreads();
  float base = 0.f;
  for (int i = 0; i < tid; ++i) base += tot[i];
#pragma unroll
  for (int k = 0; k < 8; ++k) { f32x4 o;
#pragma unroll
    for (int e = 0; e < 4; ++e) o[e] = v[k][e] + base;
    *(f32x4*)(dst + 4 * k) = o; }
  __syncthreads();
}

DI int next_unit(unsigned* ctr, int* s_unit) {
  __syncthreads();
  if (get_tid() == 0) *s_unit = (int)atomicAdd(ctr, 1u);
  __syncthreads();
  return *s_unit;
}

DI void p23_phase(const Params& P, int l, char* lds, int* s_unit, int rep = 0) {
  unsigned* ctr = (unsigned*)(P.ws + OFF_CTR) + (l * 4 + 0 + 16 * rep);
  unsigned* done = (unsigned*)(P.ws + OFF_CTR) + (40 + l + 4 * rep);
  bool acquired = false;
  for (;;) {
    int u = next_unit(ctr, s_unit);
    if (u >= 40 + 1024 + 512 + 1024) break;
    if (u < 40) {
      if (u < 32) compress_tile(P, l, u, lds); else cumsum_seq(P, u - 32, lds);
      asm volatile("s_waitcnt vmcnt(0)" ::: "memory");
      __syncthreads();
      if (get_tid() == 0) { __builtin_amdgcn_fence(__ATOMIC_RELEASE, "agent"); asm volatile("s_waitcnt vmcnt(0)" ::: "memory");
        __hip_atomic_fetch_add(done, 1u, __ATOMIC_RELAXED, __HIP_MEMORY_SCOPE_AGENT); }
    } else if (u < 40 + 1024) { int v = u - 40; diff_unit(P, l, v & 7, 127 - (v >> 3), lds); }
    else {
      if (!acquired) {
        if (get_tid() == 0) {
          unsigned sp = 0;
          while (__hip_atomic_load(done, __ATOMIC_RELAXED, __HIP_MEMORY_SCOPE_AGENT) < 40u) { __builtin_amdgcn_s_sleep(4); if (++sp > (1u << 24)) break; }
          __builtin_amdgcn_fence(__ATOMIC_ACQUIRE, "agent"); asm volatile("s_waitcnt vmcnt(0)" ::: "memory");
        }
        __syncthreads();
        acquired = true;
      }
      const int w = u - (40 + 1024);
      if (w < 384) fox_unit(P, w & 7, 63 - (w >> 3), lds);
      else if (w < 384 + 1024) { int v = w - 384; nsa_unit(P, v & 3, 255 - (v >> 2), lds); }
      else { int v = w - (384 + 1024); fox_unit(P, v & 7, 15 - (v >> 3), lds); }
    }
  }
}

template <int KIND> DI void run_phase(const Params& P, int l, char* lds, int* s_unit, int rep = 0) {
  if constexpr (KIND == 0) p0_prologue(P);
  else if constexpr (KIND == 1) p1_inproj(P, l, lds);
  else if constexpr (KIND == 2) p23_phase(P, l, lds, s_unit, rep);
  else if constexpr (KIND == 3) { }
  else if constexpr (KIND == 4) p4_outproj(P, l, lds);
  else p5_ln(P, l);
}
template <int KIND> __global__ void __launch_bounds__(NTHREADS, 2) phase_kernel(Params P, int l) {
  __shared__ __attribute__((aligned(16))) char lds[LDS_BYTES + LDS_CTL];
  run_phase<KIND>(P, l, lds, (int*)(lds + LDS_BYTES));
}
#if COOP
#define GSYNC() do { asm volatile("" ::: "memory"); cg::this_grid().sync(); asm volatile("" ::: "memory"); } while (0)
#define XB_TMO      128
#define XB_XCNT(j)  (256  + 64 * (j))
#define XB_XSUB(j)  (1280 + 64 * (j))
#define XB_XGEN(j)  (2304 + 64 * (j))
#define XB_TOP      3328
#define XB_TOPGEN   3392
#define XCD_BAR_WORDS 3456
#define XB_SPIN_CAP (1u << 22)
#define LAS __attribute__((address_space(3)))
DI unsigned xb_ld(unsigned* p) { return __hip_atomic_load(p, __ATOMIC_RELAXED, __HIP_MEMORY_SCOPE_AGENT); }
DI unsigned xb_add(unsigned* p, unsigned v) { return __hip_atomic_fetch_add(p, v, __ATOMIC_RELAXED, __HIP_MEMORY_SCOPE_AGENT); }
DI unsigned xb_xcc_id() { return (unsigned)__builtin_amdgcn_s_getreg((3 << 11) | 20) & 0xFu; }
#define XB_SPIN(cond, bar) do { unsigned _sp = 0; while (cond) { __builtin_amdgcn_s_sleep(1); \
    if ((++_sp & 255u) == 0u) { if (xb_ld(&(bar)[XB_TMO])) break; if (_sp > XB_SPIN_CAP) { atomicAdd(&(bar)[XB_TMO], 1u); break; } } } } while (0)
struct XcdBarrier { unsigned* bar; unsigned x; volatile LAS unsigned* st; };
DI XcdBarrier xcd_barrier_post(unsigned* bar, volatile LAS unsigned* st) {
  XcdBarrier b; b.bar = bar; b.x = xb_xcc_id(); b.st = st;
  if (threadIdx.x == 0) (void)xb_add(&bar[XB_XCNT(b.x)], 1u);
  return b;
}
DI void xcd_barrier_complete(unsigned* bar, unsigned x, unsigned& nloc, unsigned& nx) {
  const unsigned G = gridDim.x * gridDim.y * gridDim.z;
  unsigned sum, cnt, mine, sp = 0u;
  for (;;) {
    sum = 0u; cnt = 0u; mine = 0u;
#pragma unroll
    for (unsigned j = 0; j < 16; ++j) { const unsigned c = xb_ld(&bar[XB_XCNT(j)]); sum += c; cnt += (c > 0u) ? 1u : 0u; mine = (j == x) ? c : mine; }
    if (sum == G) break;
    __builtin_amdgcn_s_sleep(1);
    if ((++sp & 255u) == 0u) { if (xb_ld(&bar[XB_TMO])) break; if (sp > XB_SPIN_CAP) { atomicAdd(&bar[XB_TMO], 1u); break; } }
  }
  nloc = mine > 0u ? mine : 1u; nx = cnt > 0u ? cnt : 1u;
}
DI void xcd_barrier(const XcdBarrier& b) {
  asm volatile("s_waitcnt vmcnt(0)" ::: "memory");
  __syncthreads();
  if (threadIdx.x == 0) {
    unsigned* bar = b.bar;
    __builtin_amdgcn_s_waitcnt(0);
    unsigned nloc = b.st[0], nx = b.st[1];
    if (nloc == 0u) { xcd_barrier_complete(bar, b.x, nloc, nx); b.st[0] = nloc; b.st[1] = nx; }
    const unsigned old = xb_add(&bar[XB_XSUB(b.x)], 1u);
    const unsigned gen = old / nloc;
    if (old + 1u == (gen + 1u) * nloc) {
      __builtin_amdgcn_fence(__ATOMIC_RELEASE, "agent");
      asm volatile("s_waitcnt vmcnt(0)" ::: "memory");
      const unsigned og = xb_add(&bar[XB_TOP], 1u);
      const unsigned tg = og / nx;
      if (og + 1u == (tg + 1u) * nx) xb_add(&bar[XB_TOPGEN], 1u);
      else XB_SPIN(xb_ld(&bar[XB_TOPGEN]) == tg, bar);
      __builtin_amdgcn_fence(__ATOMIC_ACQUIRE, "agent");
      xb_add(&bar[XB_XGEN(b.x)], 1u);
      asm volatile("s_waitcnt vmcnt(0)" ::: "memory");
    } else {
      XB_SPIN(xb_ld(&bar[XB_XGEN(b.x)]) == gen, bar);
      __builtin_amdgcn_fence(__ATOMIC_ACQUIRE, "agent");
      asm volatile("s_waitcnt vmcnt(0)" ::: "memory");
    }
  }
  __syncthreads();
}
#ifndef CG_ALL
#define BSYNC() do { asm volatile("" ::: "memory"); xcd_barrier(xb); asm volatile("" ::: "memory"); } while (0)
#else
#define BSYNC() GSYNC()
#endif
__global__ void __launch_bounds__(NTHREADS, 2) fwd_kernel(Params P) {
  __shared__ __attribute__((aligned(16))) char lds[LDS_BYTES + LDS_CTL];
  int* const s_unit_p = (int*)(lds + LDS_BYTES);
  if (threadIdx.x == 0) *(uint4*)(lds + LDS_BYTES + 16) = make_uint4(0u, 0u, 0u, 0u);
  __syncthreads();
  const XcdBarrier xb = xcd_barrier_post((unsigned*)(P.ws + OFF_BAR), (volatile LAS unsigned*)(lds + LDS_BYTES + 16));
  if (P.pad_ == 0x5eed) GSYNC();
  run_phase<0>(P, 0, lds, s_unit_p); BSYNC();
  for (int l = 0; l < DEPTH; ++l) {
    run_phase<1>(P, l, lds, s_unit_p); BSYNC();
#if REPEAT == 1
    run_phase<1>(P, l, lds, s_unit_p, 1); BSYNC();
#endif
    run_phase<2>(P, l, lds, s_unit_p); BSYNC();
    run_phase<4>(P, l, lds, s_unit_p); BSYNC();
    run_phase<5>(P, l, lds, s_unit_p); if (l + 1 < DEPTH) BSYNC();
  }
}
#endif

extern "C" void kernel_launch(void* const* d_in, const int* in_sizes, int n_in, void* d_out, int out_size, void* d_ws, size_t ws_size, hipStream_t stream) {
  static int grid_blocks = 0;
  if (!grid_blocks) {
    int dev = 0, cus = 0, per_cu = 0;
    (void)hipGetDevice(&dev);
    (void)hipDeviceGetAttribute(&cus, hipDeviceAttributeMultiprocessorCount, dev);
#if COOP
    (void)hipOccupancyMaxActiveBlocksPerMultiprocessor(&per_cu, fwd_kernel, NTHREADS, 0);
#else
    per_cu = 2;
#endif
    if (per_cu < 1) per_cu = 1;
    if (per_cu > 2) per_cu = 2;
    if (cus < 1) cus = 256;
    grid_blocks = cus * per_cu;
  }
  if (n_in != 17 || ws_size < WS_NEED) { fprintf(stderr, "kernel_launch: unexpected inputs (%d) or workspace (%zu)\n", n_in, ws_size); return; }
  Params p{};
  p.x = (const float*)d_in[0]; p.w_in = (const float*)d_in[1]; p.b_fox_f = (const float*)d_in[2]; p.pos_k = (const float*)d_in[3]; p.pos_v = (const float*)d_in[4];
  p.w1_k = (const float*)d_in[5]; p.w2_k = (const float*)d_in[6]; p.w1_v = (const float*)d_in[7]; p.w2_v = (const float*)d_in[8];
  p.lq1 = (const float*)d_in[9]; p.lk1 = (const float*)d_in[10]; p.lq2 = (const float*)d_in[11]; p.lk2 = (const float*)d_in[12];
  p.subln_g = (const float*)d_in[13]; p.w_out = (const float*)d_in[14]; p.ln_g = (const float*)d_in[15]; p.ln_b = (const float*)d_in[16];
  p.out = (float*)d_out; p.ws = (char*)d_ws;
  (void)hipMemsetAsync((char*)d_ws + OFF_CTR, 0, 4096, stream);
  (void)hipMemsetAsync((char*)d_ws + OFF_BAR, 0, CTL_ZERO_BYTES - OFF_BAR, stream);
#if COOP
  void* args[] = {&p};
  hipError_t e = hipLaunchCooperativeKernel((void*)fwd_kernel, dim3(grid_blocks), dim3(NTHREADS), args, 0, stream);
  if (e != hipSuccess) fprintf(stderr, "cooperative launch failed: %s (grid %d)\n", hipGetErrorString(e), grid_blocks);
#else
  const dim3 g(grid_blocks), b(NTHREADS);
  hipLaunchKernelGGL(phase_kernel<0>, g, b, 0, stream, p, 0);
  for (int l = 0; l < DEPTH; ++l) {
    hipLaunchKernelGGL(phase_kernel<1>, g, b, 0, stream, p, l);
    hipLaunchKernelGGL(phase_kernel<2>, g, b, 0, stream, p, l);
    hipLaunchKernelGGL(phase_kernel<4>, g, b, 0, stream, p, l);
    hipLaunchKernelGGL(phase_kernel<5>, g, b, 0, stream, p, l);
  }
#endif
}
```

```cpp
#include <hip/hip_runtime.h>
#include <hip/hip_cooperative_groups.h>
#include <stdint.h>
#include <cstdio>
namespace cg = cooperative_groups;

#ifndef COOP
#define COOP 1
#endif
#ifndef REPEAT
#define REPEAT 0
#endif

#define DI __device__ __forceinline__
typedef unsigned short bf16_t;
typedef short bf16x8 __attribute__((ext_vector_type(8)));
typedef short s16x4 __attribute__((ext_vector_type(4)));
typedef float f32x16 __attribute__((ext_vector_type(16)));
typedef float f32x4 __attribute__((ext_vector_type(4)));
typedef float f32x2 __attribute__((ext_vector_type(2)));
typedef unsigned u32x4 __attribute__((ext_vector_type(4)));
typedef unsigned u32x2 __attribute__((ext_vector_type(2)));
typedef __bf16 bf16x2_t __attribute__((ext_vector_type(2)));

#define MFMA32(a, b, c) __builtin_amdgcn_mfma_f32_32x32x16_bf16((a), (b), (c), 0, 0, 0)

constexpr int BATCH = 2, SEQ = 8192, DMODEL = 1024, MTOK = BATCH * SEQ, NIN = 3868, NPAD = 3968, DEPTH = 2;
constexpr float LOG2E = 1.4426950408889634f;
constexpr float NEGBIG = -1e30f;
constexpr float MINIT = -1e20f;
constexpr int NTHREADS = 256;

constexpr size_t MiB = 1u << 20;
constexpr size_t OFF_CTR = 0, OFF_LAM = 4096, OFF_B1 = 8192, OFF_BAR = 16384, CTL_ZERO_BYTES = 32768;
constexpr size_t OFF_ROPE64 = 1 * MiB, OFF_ROPE32 = 3 * MiB, OFF_WIN = 4 * MiB, OFF_WOUT = 20 * MiB, OFF_W1T = 24 * MiB;
constexpr size_t OFF_XB = 26 * MiB, OFF_G = 58 * MiB, OFF_MIX = 90 * MiB;
constexpr size_t OFF_QF = 122 * MiB, OFF_KF = 130 * MiB, OFF_VFT = 138 * MiB, OFF_QN = 146 * MiB;
constexpr size_t OFF_KCT = 162 * MiB, OFF_VCT = 166 * MiB, OFF_KS = 170 * MiB, OFF_VST = 174 * MiB, OFF_KW = 178 * MiB, OFF_VWT = 182 * MiB;
constexpr size_t OFF_QD = 186 * MiB, OFF_KD = 194 * MiB, OFF_VDT = 202 * MiB;
constexpr size_t OFF_LOGF = 210 * MiB, OFF_CUM = 210 * MiB + 256 * 1024, OFF_GATES = 211 * MiB;
constexpr size_t OFF_KC = 213 * MiB, OFF_VCC = 213 * MiB + 256 * 1024, WS_NEED = 214 * MiB;

constexpr int LDS_BYTES = 73728, LDS_CTL = 32;
constexpr int ATT_BUF = 18944, ATT_V = 9216, ATT_C = 18432;
constexpr int LDS_IMP = 3 * ATT_BUF, LDS_SEL = LDS_BYTES - 512;
static_assert(LDS_IMP + 16384 <= LDS_SEL, "LDS map");
constexpr int GEMM_AB = 18432;

struct Params {
  const float *x, *w_in, *b_fox_f, *pos_k, *pos_v, *w1_k, *w2_k, *w1_v, *w2_v, *lq1, *lk1, *lq2, *lk2, *subln_g, *w_out, *ln_g, *ln_b;
  float* out;
  char* ws;
  long pad_;
};

DI unsigned short f2bf(float f) { unsigned u = __float_as_uint(f); return (unsigned short)((u + 0x7fffu + ((u >> 16) & 1u)) >> 16); }
DI unsigned pk2(float lo, float hi) { f32x2 v = {lo, hi}; bf16x2_t b = __builtin_convertvector(v, bf16x2_t); return __builtin_bit_cast(unsigned, b); }
DI float silu(float x) { return x / (1.f + __expf(-x)); }
DI float sigmoidf(float x) { return 1.f / (1.f + __expf(-x)); }
DI float ex2(float x) { return __builtin_amdgcn_exp2f(x); }
DI float xhalf_max(float v) { auto rr = __builtin_amdgcn_permlane32_swap(__float_as_uint(v), __float_as_uint(v), false, false); return fmaxf(__uint_as_float(rr[0]), __uint_as_float(rr[1])); }
DI float xhalf_sum(float v) { auto rr = __builtin_amdgcn_permlane32_swap(__float_as_uint(v), __float_as_uint(v), false, false); return __uint_as_float(rr[0]) + __uint_as_float(rr[1]); }
DI int crow(int i, int h) { return (i & 3) + 8 * (i >> 2) + 4 * h; }

DI int get_tid() { int t = threadIdx.x; asm volatile("" : "+v"(t)); return t; }
DI int orig_col(int n) {
  int s = n >> 6, c = n & 63;
  if (s < 4) return s * 64 + c;
  if (s < 8) return 256 + (s - 4) * 64 + c;
  if (s < 12) return 512 + (s - 8) * 64 + c;
  if (s < 16) return 772 + (s - 12) * 64 + c;
  if (s < 24) return 1028 + (s - 16) * 64 + c;
  if (s < 36) return 1540 + (s - 24) * 64 + c;
  if (s < 44) return 2332 + (s - 36) * 64 + c;
  if (s < 52) { int base = 2844 + (s - 44) * 64; int nt = c >> 5, r = c & 31, comp = r >> 4, i = r & 15; return base + comp * 32 + nt * 16 + i; }
  if (s < 60) return 3356 + (s - 52) * 64 + c;
  if (s == 60) { if (c < 4) return 768 + c; if (c < 28) return 2308 + (c - 4); return -1; }
  return -1;
}

DI void p0_prologue(const Params& P) {
  const long gtid = (long)blockIdx.x * NTHREADS + get_tid(), gsz = (long)gridDim.x * NTHREADS;
  char* ws = P.ws;
  if (gtid < DEPTH) {
    int l = (int)gtid; float a = 0.f, b = 0.f;
    for (int i = 0; i < 32; ++i) { a += P.lq1[l * 32 + i] * P.lk1[l * 32 + i]; b += P.lq2[l * 32 + i] * P.lk2[l * 32 + i]; }
    float lam_init = 0.8f - 0.6f * expf(-0.3f * (float)l);
    ((float*)(ws + OFF_LAM))[l] = expf(a) - expf(b) + lam_init;
    ((float*)(ws + OFF_LAM))[2 + l] = lam_init;
  }
  for (long it = gtid; it < DEPTH * 2 * 128; it += gsz) {
    int j = it & 127, kv = (it >> 7) & 1, l = (int)(it >> 8);
    const float* pos = (kv ? P.pos_v : P.pos_k) + (size_t)l * 2048;
    const float* w1 = (kv ? P.w1_v : P.w1_k) + (size_t)l * 2048 * 128;
    float a = 0.f;
    for (int k = 0; k < 2048; ++k) a += pos[k] * w1[(size_t)k * 128 + j];
    ((float*)(ws + OFF_B1))[it] = a;
  }
  for (long it = gtid; it < (long)DEPTH * 128 * NPAD; it += gsz) {
    int n = (int)(it % NPAD); int k8 = (int)((it / NPAD) & 127); int l = (int)(it / ((long)NPAD * 128));
    int oc = orig_col(n);
    u32x4 v = {0u, 0u, 0u, 0u};
    if (oc >= 0) { const float* src = P.w_in + (size_t)l * DMODEL * NIN + (size_t)(k8 * 8) * NIN + oc;
      float f[8];
#pragma unroll
      for (int j = 0; j < 8; ++j) f[j] = src[(size_t)j * NIN];
      v.x = pk2(f[0], f[1]); v.y = pk2(f[2], f[3]); v.z = pk2(f[4], f[5]); v.w = pk2(f[6], f[7]); }
    *(u32x4*)((bf16_t*)(ws + OFF_WIN) + ((size_t)l * NPAD + n) * DMODEL + k8 * 8) = v;
  }
  for (long it = gtid; it < (long)DEPTH * 128 * 1024; it += gsz) {
    int n = (int)(it & 1023); int k8 = (int)((it >> 10) & 127); int l = (int)(it >> 17);
    const float* src = P.w_out + (size_t)l * 1024 * 1024 + (size_t)(k8 * 8) * 1024 + n;
    float f[8];
#pragma unroll
    for (int j = 0; j < 8; ++j) f[j] = src[(size_t)j * 1024];
    u32x4 v; v.x = pk2(f[0], f[1]); v.y = pk2(f[2], f[3]); v.z = pk2(f[4], f[5]); v.w = pk2(f[6], f[7]);
    *(u32x4*)((bf16_t*)(ws + OFF_WOUT) + ((size_t)l * 1024 + n) * 1024 + k8 * 8) = v;
  }
  for (long it = gtid; it < (long)DEPTH * 2 * 256 * 128; it += gsz) {
    int j = (int)(it & 127); int k8 = (int)((it >> 7) & 255); int kv = (int)((it >> 15) & 1); int l = (int)(it >> 16);
    const float* src = (kv ? P.w1_v : P.w1_k) + (size_t)l * 2048 * 128 + (size_t)(k8 * 8) * 128 + j;
    float f[8];
#pragma unroll
    for (int jj = 0; jj < 8; ++jj) f[jj] = src[(size_t)jj * 128];
    u32x4 v; v.x = pk2(f[0], f[1]); v.y = pk2(f[2], f[3]); v.z = pk2(f[4], f[5]); v.w = pk2(f[6], f[7]);
    *(u32x4*)((bf16_t*)(ws + OFF_W1T) + (((size_t)l * 2 + kv) * 128 + j) * 2048 + k8 * 8) = v;
  }
  for (long it = gtid; it < (long)MTOK * DMODEL / 8; it += gsz) {
    const f32x4* src = (const f32x4*)P.x + it * 2; f32x4 a = src[0], b = src[1];
    u32x4 v; v.x = pk2(a[0], a[1]); v.y = pk2(a[2], a[3]); v.z = pk2(b[0], b[1]); v.w = pk2(b[2], b[3]);
    *((u32x4*)(ws + OFF_XB) + it) = v;
  }
}

#define LDSAS __attribute__((address_space(3)))
DI void glds16(const char* gsrc, char* ldst) {
  __builtin_amdgcn_global_load_lds((const unsigned*)gsrc, (LDSAS unsigned*)ldst, 16, 0, 0);
}
DI void gemm_mainloop(const bf16_t* A, long lda, int a_row_max, const bf16_t* Bt, long ldb, int K, char* lds, f32x16 (&acc)[2][2]) {
  const int tid = get_tid(), lane = tid & 63, wave = __builtin_amdgcn_readfirstlane(tid >> 6), wm = wave >> 1, wn = wave & 1, r = lane & 31, h = lane >> 5;
#pragma unroll
  for (int a = 0; a < 2; ++a)
#pragma unroll
    for (int b = 0; b < 2; ++b)
#pragma unroll
      for (int i = 0; i < 16; ++i) acc[a][b][i] = 0.f;
  const char* ga[4]; const char* gb[4];
#pragma unroll
  for (int i = 0; i < 4; ++i) { const int row = 32 * wave + 8 * i + (lane >> 3), ch = (lane & 7) ^ ((row >> 1) & 7); const int ar = row < a_row_max ? row : a_row_max;
    ga[i] = (const char*)(A + (long)ar * lda) + ch * 16; gb[i] = (const char*)(Bt + (long)row * ldb) + ch * 16; }
  char* const ldw = lds + (32 * wave) * 128;
  const int nk = K >> 6;
#define GEMM_STAGE(BUF, KT) do { _Pragma("unroll") for (int i = 0; i < 4; ++i) { \
    glds16(ga[i] + (long)(KT) * 128, ldw + (BUF) * 32768 + i * 1024); glds16(gb[i] + (long)(KT) * 128, ldw + (BUF) * 32768 + 16384 + i * 1024); } } while (0)
  __syncthreads();
  GEMM_STAGE(0, 0);
  asm volatile("s_waitcnt vmcnt(0)" ::: "memory");
  __syncthreads();
  const int sw = (r >> 1) & 7;
  const unsigned lds0 = (unsigned)(uintptr_t)lds;
  unsigned aa[4], ab[4];
#pragma unroll
  for (int ks = 0; ks < 4; ++ks) { const unsigned xo = (unsigned)(((2 * ks + h) ^ sw) * 16);
    aa[ks] = lds0 + (unsigned)((64 * wm + r) * 128) + xo; ab[ks] = lds0 + 16384u + (unsigned)((64 * wn + r) * 128) + xo; }
  bf16x8 xa0, xa1, xb0, xb1, ya0, ya1, yb0, yb1, za0, za1, zb0, zb1;
#define KT_RD(S, K, O0, O1) \
    "ds_read_b128 %[" #S "a0], %[aa" #K "] offset:" O0 "\n\tds_read_b128 %[" #S "b0], %[ab" #K "] offset:" O0 "\n\t" \
    "ds_read_b128 %[" #S "a1], %[aa" #K "] offset:" O1 "\n\tds_read_b128 %[" #S "b1], %[ab" #K "] offset:" O1 "\n\t"
#define KT_MM(S) \
    "v_mfma_f32_32x32x16_bf16 %[c00], %[" #S "a0], %[" #S "b0], %[c00]\n\tv_mfma_f32_32x32x16_bf16 %[c01], %[" #S "a0], %[" #S "b1], %[c01]\n\t" \
    "v_mfma_f32_32x32x16_bf16 %[c10], %[" #S "a1], %[" #S "b0], %[c10]\n\tv_mfma_f32_32x32x16_bf16 %[c11], %[" #S "a1], %[" #S "b1], %[c11]\n\t"
#define KT_ASM(O0, O1) asm volatile( \
    "s_waitcnt lgkmcnt(0)\n\t" \
    KT_RD(x, 0, O0, O1) KT_RD(y, 1, O0, O1) \
    "s_waitcnt lgkmcnt(4)\n\t" KT_MM(x) KT_RD(z, 2, O0, O1) \
    "s_waitcnt lgkmcnt(4)\n\t" KT_MM(y) KT_RD(x, 3, O0, O1) \
    "s_waitcnt lgkmcnt(4)\n\t" KT_MM(z) \
    "s_waitcnt lgkmcnt(0)\n\t" KT_MM(x) \
    : [c00] "+v"(acc[0][0]), [c01] "+v"(acc[0][1]), [c10] "+v"(acc[1][0]), [c11] "+v"(acc[1][1]), \
      [xa0] "=&v"(xa0), [xa1] "=&v"(xa1), [xb0] "=&v"(xb0), [xb1] "=&v"(xb1), [ya0] "=&v"(ya0), [ya1] "=&v"(ya1), [yb0] "=&v"(yb0), [yb1] "=&v"(yb1), \
      [za0] "=&v"(za0), [za1] "=&v"(za1), [zb0] "=&v"(zb0), [zb1] "=&v"(zb1) \
    : [aa0] "v"(aa[0]), [aa1] "v"(aa[1]), [aa2] "v"(aa[2]), [aa3] "v"(aa[3]), [ab0] "v"(ab[0]), [ab1] "v"(ab[1]), [ab2] "v"(ab[2]), [ab3] "v"(ab[3]) \
    : "memory")
  for (int kt = 0; kt < nk; kt += 2) {
    GEMM_STAGE(1, kt + 1);
    KT_ASM("0", "4096");
    asm volatile("s_waitcnt vmcnt(0)" ::: "memory");
    __syncthreads();
    if (kt + 2 < nk) GEMM_STAGE(0, kt + 2);
    KT_ASM("32768", "36864");
    asm volatile("s_waitcnt vmcnt(0)" ::: "memory");
    __syncthreads();
  }
  asm volatile("s_nop 15\n\ts_nop 7" : "+v"(acc[0][0]), "+v"(acc[0][1]), "+v"(acc[1][0]), "+v"(acc[1][1]));
#undef KT_RD
#undef KT_MM
#undef KT_ASM
#undef GEMM_STAGE
}

DI bool xcd_tile(int i, int NT, int& mt, int& nt) {
  const int G = gridDim.x;
  if ((G & 7) == 0 && G >= 8) {
    const int x = blockIdx.x & 7, j = blockIdx.x >> 3, per = G >> 3;
    const int u = j + per * i; if (u >= 16 * NT) return false;
    const int grp = u / (8 * NT), v = u - grp * (8 * NT);
    mt = 16 * x + 8 * grp + (v & 7); nt = v >> 3; return true;
  }
  const int t = blockIdx.x + G * i; if (t >= 128 * NT) return false;
  mt = t / NT; nt = t - mt * NT; return true;
}

DI void epi_inproj(const Params& P, int l, const f32x16 (&acc)[2][2], int m0, int n0, char* lds) {
  const int tid = get_tid(), lane = tid & 63, wave = tid >> 6, wm = wave >> 1, wn = wave & 1, r = lane & 31, h = lane >> 5;
  char* ws = P.ws;
  const int slot = (n0 >> 6) + wn;
  const int b = m0 >> 13;
  const int srow0 = (m0 & (SEQ - 1)) + 64 * wm;
  int cat = 0;
  int rope = 0; float scale = 1.f; bf16_t* dst = nullptr; int gcol = 0;
  const float QS = 0.125f * LOG2E;
  if (slot < 4) { cat = 1; scale = QS; dst = (bf16_t*)(ws + OFF_QF) + (size_t)(b * 4 + slot) * SEQ * 64; }
  else if (slot < 8) { cat = 1; dst = (bf16_t*)(ws + OFF_KF) + (size_t)(b * 4 + slot - 4) * SEQ * 64; }
  else if (slot < 12) { cat = 2; dst = (bf16_t*)(ws + OFF_VFT) + (size_t)(b * 4 + slot - 8) * SEQ * 64; }
  else if (slot < 16) { cat = 3; gcol = (slot - 12) * 64; }
  else if (slot < 24) { cat = 1; rope = 1; scale = QS; dst = (bf16_t*)(ws + OFF_QN) + (size_t)(b * 8 + slot - 16) * SEQ * 64; }
  else if (slot < 26) { cat = 1; rope = 1; dst = (bf16_t*)(ws + OFF_KCT) + (size_t)(b * 2 + slot - 24) * SEQ * 64; }
  else if (slot < 28) { cat = 1; dst = (bf16_t*)(ws + OFF_VCT) + (size_t)(b * 2 + slot - 26) * SEQ * 64; }
  else if (slot < 30) { cat = 1; rope = 1; dst = (bf16_t*)(ws + OFF_KS) + (size_t)(b * 2 + slot - 28) * SEQ * 64; }
  else if (slot < 32) { cat = 2; dst = (bf16_t*)(ws + OFF_VST) + (size_t)(b * 2 + slot - 30) * SEQ * 64; }
  else if (slot < 34) { cat = 1; rope = 1; dst = (bf16_t*)(ws + OFF_KW) + (size_t)(b * 2 + slot - 32) * SEQ * 64; }
  else if (slot < 36) { cat = 2; dst = (bf16_t*)(ws + OFF_VWT) + (size_t)(b * 2 + slot - 34) * SEQ * 64; }
  else if (slot < 44) { cat = 3; gcol = 256 + (slot - 36) * 64; }
  else if (slot < 48) { cat = 1; rope = 2; scale = 0.17677669529663687f * LOG2E; dst = (bf16_t*)(ws + OFF_QD) + (size_t)(b * 4 + slot - 44) * SEQ * 64; }
  else if (slot < 52) { cat = 1; rope = 2; dst = (bf16_t*)(ws + OFF_KD) + (size_t)(b * 4 + slot - 48) * SEQ * 64; }
  else if (slot < 56) { cat = 2; dst = (bf16_t*)(ws + OFF_VDT) + (size_t)(b * 4 + slot - 52) * SEQ * 64; }
  else if (slot < 60) { cat = 3; gcol = 768 + (slot - 56) * 64; }
  else if (slot == 60) cat = 4;

  if (cat == 1 || cat == 3) {
    unsigned short* wl = (unsigned short*)(lds + wave * 8192);
    int c0 = r, c1 = 32 + r;
    float crev = 0.f;
    if (rope == 1) crev = __builtin_amdgcn_exp2f(-(float)r * (13.287712379549449f / 32.f)) * 0.15915494309189535f;
    if (rope == 2) { int comp = r >> 4, ii = r & 15; c0 = comp * 32 + ii; c1 = comp * 32 + 16 + ii; crev = __builtin_amdgcn_exp2f(-(float)ii * (13.287712379549449f / 16.f)) * 0.15915494309189535f; }
#pragma unroll
    for (int mt = 0; mt < 2; ++mt)
#pragma unroll
      for (int i = 0; i < 16; ++i) {
        const int rowl = 32 * mt + crow(i, h);
        float v0 = acc[mt][0][i], v1 = acc[mt][1][i];
        if (cat == 3) { v0 = silu(v0); v1 = silu(v1); }
        else {
          if (rope) { const float fr = __builtin_amdgcn_fractf((float)(srow0 + rowl) * crev); const float cs = __builtin_amdgcn_cosf(fr), sn = __builtin_amdgcn_sinf(fr);
            const float y0 = v0 * cs - v1 * sn, y1 = v1 * cs + v0 * sn; v0 = y0; v1 = y1; }
          v0 *= scale; v1 *= scale;
        }
        wl[rowl * 64 + c0] = f2bf(v0); wl[rowl * 64 + c1] = f2bf(v1);
      }
    bf16_t* obase = (cat == 1) ? (dst + (size_t)srow0 * 64) : ((bf16_t*)(ws + OFF_G) + ((size_t)m0 + 64 * wm) * 1024 + gcol);
    const size_t opitch = (cat == 1) ? 64 : 1024;
#pragma unroll
    for (int k = 0; k < 8; ++k) { const int rowl = (lane >> 3) + 8 * k, ch = lane & 7;
      const u32x4 v = *(const u32x4*)((const char*)wl + rowl * 128 + ch * 16);
      *(u32x4*)(obase + (size_t)rowl * opitch + ch * 8) = v; }
  } else if (cat == 2) {
#pragma unroll
    for (int mt = 0; mt < 2; ++mt)
#pragma unroll
      for (int g = 0; g < 4; ++g) {
        int s = srow0 + 32 * mt + 8 * g + 4 * h;
#pragma unroll
        for (int nt = 0; nt < 2; ++nt) {
          u32x2 v; v.x = pk2(acc[mt][nt][4 * g], acc[mt][nt][4 * g + 1]); v.y = pk2(acc[mt][nt][4 * g + 2], acc[mt][nt][4 * g + 3]);
          *(u32x2*)(dst + (size_t)(32 * nt + r) * SEQ + s) = v;
        }
      }
  } else if (cat == 4) {
    if (r < 28) {
      float bias = (r < 4) ? P.b_fox_f[l * 4 + r] : 0.f;
#pragma unroll
      for (int mt = 0; mt < 2; ++mt)
#pragma unroll
        for (int i = 0; i < 16; ++i) {
          int s = srow0 + 32 * mt + crow(i, h);
          float v = acc[mt][0][i];
          if (r < 4) { float xx = v + bias; float ls = fminf(xx, 0.f) - log1pf(expf(-fabsf(xx)));
            ((float*)(ws + OFF_LOGF))[(size_t)(b * 4 + r) * SEQ + s] = ls * LOG2E; }
          else ((float*)(ws + OFF_GATES))[((size_t)b * SEQ + s) * 24 + (r - 4)] = sigmoidf(v);
        }
    }
  }
}

DI void p1_inproj(const Params& P, int l, char* lds) {
  const bf16_t* A = (const bf16_t*)(P.ws + OFF_XB);
  const bf16_t* Bt = (const bf16_t*)(P.ws + OFF_WIN) + (size_t)l * NPAD * DMODEL;
  const int NT = NPAD / 128;
  int mt, nt;
  for (int i = 0; xcd_tile(i, NT, mt, nt); ++i) {
    f32x16 acc[2][2];
    gemm_mainloop(A + (size_t)mt * 128 * DMODEL, DMODEL, 127, Bt + (size_t)nt * 128 * DMODEL, DMODEL, DMODEL, lds, acc);
    epi_inproj(P, l, acc, mt * 128, nt * 128, lds);
  }
}

DI void p4_outproj(const Params& P, int l, char* lds) {
  const bf16_t* A = (const bf16_t*)(P.ws + OFF_MIX);
  const bf16_t* Bt = (const bf16_t*)(P.ws + OFF_WOUT) + (size_t)l * 1024 * 1024;
  const float* xres = (l == 0) ? P.x : P.out;
  const float alpha = 1.4142135623730951f;
  const int tid = get_tid(), lane = tid & 63, wave = tid >> 6, wm = wave >> 1, wn = wave & 1, r = lane & 31, h = lane >> 5;
  int mt, nt;
  for (int i = 0; xcd_tile(i, 8, mt, nt); ++i) {
    f32x16 acc[2][2];
    gemm_mainloop(A + (size_t)mt * 128 * 1024, 1024, 127, Bt + (size_t)nt * 128 * 1024, 1024, 1024, lds, acc);
#pragma unroll
    for (int a = 0; a < 2; ++a)
#pragma unroll
      for (int bb = 0; bb < 2; ++bb)
#pragma unroll
        for (int i = 0; i < 16; ++i) {
          size_t row = (size_t)mt * 128 + 64 * wm + 32 * a + crow(i, h); int col = nt * 128 + 64 * wn + 32 * bb + r;
          P.out[row * 1024 + col] = alpha * xres[row * 1024 + col] + acc[a][bb][i];
        }
  }
}

DI void p5_ln(const Params& P, int l) {
  const int lane = get_tid() & 63, wave = get_tid() >> 6;
  const float* g = P.ln_g + l * 1024; const float* bb = P.ln_b + l * 1024;
  for (int row = blockIdx.x * 4 + wave; row < MTOK; row += gridDim.x * 4) {
    float* p = P.out + (size_t)row * 1024;
    f32x4 v[4]; float s = 0.f;
#pragma unroll
    for (int k = 0; k < 4; ++k) { v[k] = *(const f32x4*)(p + k * 256 + lane * 4); s += v[k][0] + v[k][1] + v[k][2] + v[k][3]; }
#pragma unroll
    for (int o = 32; o >= 1; o >>= 1) s += __shfl_xor(s, o);
    float mean = s * (1.f / 1024.f); float q = 0.f;
#pragma unroll
    for (int k = 0; k < 4; ++k)
#pragma unroll
      for (int e = 0; e < 4; ++e) { float d = v[k][e] - mean; q += d * d; }
#pragma unroll
    for (int o = 32; o >= 1; o >>= 1) q += __shfl_xor(q, o);
    float rstd = rsqrtf(q * (1.f / 1024.f) + 1e-5f);
#pragma unroll
    for (int k = 0; k < 4; ++k) {
      int c = k * 256 + lane * 4; f32x4 gg = *(const f32x4*)(g + c), bv = *(const f32x4*)(bb + c); f32x4 o;
#pragma unroll
      for (int e = 0; e < 4; ++e) o[e] = (v[k][e] - mean) * rstd * gg[e] + bv[e];
      *(f32x4*)(p + c) = o;
      if (l + 1 < DEPTH) {
        u32x2 w; w.x = pk2(o[0], o[1]); w.y = pk2(o[2], o[3]);
        *(u32x2*)((bf16_t*)(P.ws + OFF_XB) + (size_t)row * 1024 + c) = w; }
    }
  }
}

enum { M_FOX = 0, M_DIFF = 1, M_CMP1 = 2, M_CMP2 = 3, M_SEL = 4, M_WIN = 5 };
struct AttnState { f32x16 o[2]; float m, l; };
struct TileSrc { const bf16_t* K; const bf16_t* Vt; long vstride; const float* C; };

template <bool HASV, bool HASC>
DI void tile_gload(const TileSrc& s, int T, u32x4 (&rk)[2], u32x4 (&rv)[2], f32x4& rc, int tid) {
#pragma unroll
  for (int p = 0; p < 2; ++p) { int id = tid + 256 * p, row = id >> 3, ch = id & 7;
    rk[p] = *(const u32x4*)(s.K + ((long)(64 * T + row)) * 64 + ch * 8);
    if (HASV) rv[p] = *(const u32x4*)(s.Vt + (long)row * s.vstride + 64 * T + ch * 8); }
  if (HASC) { if (tid < 16) rc = *(const f32x4*)(s.C + 64 * T + 4 * tid); }
}
template <bool HASV, bool HASC>
DI void tile_sstore(char* buf, const u32x4 (&rk)[2], const u32x4 (&rv)[2], const f32x4& rc, int tid) {
#pragma unroll
  for (int p = 0; p < 2; ++p) { int id = tid + 256 * p, row = id >> 3, ch = id & 7;
    *(u32x4*)(buf + row * 144 + ch * 16) = rk[p];
    if (HASV) { char* d = buf + ATT_V + row * 136 + ch * 16; u32x2 a = {rv[p].x, rv[p].y}, b = {rv[p].z, rv[p].w}; *(u32x2*)d = a; *(u32x2*)(d + 8) = b; } }
  if (HASC) { if (tid < 16) *(f32x4*)(buf + ATT_C + tid * 16) = -rc; }
}

constexpr float MREF0 = -32.f;
constexpr float RSUM = 1099511627776.f;

template <int MODE>
DI void qk_part(f32x16 (&p)[2], const bf16x8* qf, const char* buf, int koffb, const f32x16& negm, int r, int h) {
  constexpr int ND0 = (MODE == M_DIFF) ? 2 : 4;
  const char* kl = buf; const float* cl = (const float*)(buf + ATT_C);
  if (MODE == M_FOX) {
    const float nm = negm[0];
#pragma unroll
    for (int c = 0; c < 2; ++c)
#pragma unroll
      for (int g = 0; g < 4; ++g) { f32x4 ck = *(const f32x4*)(cl + 32 * c + 8 * g + 4 * h);
#pragma unroll
        for (int e = 0; e < 4; ++e) p[c][4 * g + e] = ck[e] + nm; }
  }
#pragma unroll
  for (int d0 = 0; d0 < ND0; ++d0) {
    const char* kp = kl + r * 144 + koffb + (16 * d0 + 8 * h) * 2;
    bf16x8 k0 = *(const bf16x8*)kp; bf16x8 k1 = *(const bf16x8*)(kp + 32 * 144);
    if (MODE != M_FOX && d0 == 0) { p[0] = MFMA32(k0, qf[d0], negm); p[1] = MFMA32(k1, qf[d0], negm); }
    else { p[0] = MFMA32(k0, qf[d0], p[0]); p[1] = MFMA32(k1, qf[d0], p[1]); }
  }
}

template <int MODE>
DI void sp_part(AttnState& st, f32x16 (&p)[2], f32x16& negm, const char* buf, int T, int tq, unsigned selbit,
                float inv_l, unsigned* imp_q, int r, int h) {
  const char* vl = buf + ATT_V;
  const int kvb = 64 * T + 4 * h;
  int lim, lo;
  if (MODE == M_CMP1 || MODE == M_CMP2) { lim = (tq - 31) >> 4; lo = -(1 << 30); }
  else if (MODE == M_SEL) { lim = selbit ? tq : -1; lo = -(1 << 30); }
  else if (MODE == M_WIN) { lim = tq; lo = tq - 511; }
  else { lim = tq; lo = -(1 << 30); }
  const bool full = (lim >= 64 * T + 63) && (lo <= 64 * T);
  bool lane_on = true; bool sel_interior = false;
  if (MODE == M_SEL) sel_interior = __all(tq >= 64 * T + 63) != 0;
  if (sel_interior) lane_on = (selbit != 0u);
  else if (!__all(full)) {
#pragma unroll
    for (int c = 0; c < 2; ++c)
#pragma unroll
      for (int i = 0; i < 16; ++i) { int kv = kvb + 32 * c + 8 * (i >> 2) + (i & 3); if (kv > lim || kv < lo) p[c][i] = NEGBIG; }
  }
  float tile_sum = 0.f;
  if (MODE == M_CMP2) {
#pragma unroll
    for (int c = 0; c < 2; ++c)
#pragma unroll
      for (int i = 0; i < 16; ++i) p[c][i] = ex2(p[c][i]) * inv_l;
#pragma unroll
    for (int c = 0; c < 2; ++c)
#pragma unroll
      for (int g = 0; g < 4; ++g) {
        int j = 16 * T + 8 * c + 2 * g + h;
        float bq = 0.5f * p[c][4 * g + 3]; float aq = p[c][4 * g] + p[c][4 * g + 1] + p[c][4 * g + 2] + bq;
        atomicAdd(&imp_q[j * 32], (unsigned)(aq * 4194304.f + 0.5f));
        if (j + 1 < 128) atomicAdd(&imp_q[(j + 1) * 32], (unsigned)(bq * 4194304.f + 0.5f));
      }
  } else {
    float sum = 0.f;
#pragma unroll
    for (int c = 0; c < 2; ++c)
#pragma unroll
      for (int i = 0; i < 16; ++i) { float e = ex2(p[c][i]); p[c][i] = e; sum += e; }
    if (MODE == M_SEL) sum = lane_on ? sum : 0.f;
    st.l += sum;
    tile_sum = sum;
  }
  if (MODE != M_CMP1) {
#pragma unroll
    for (int c = 0; c < 2; ++c)
#pragma unroll
      for (int s2 = 0; s2 < 2; ++s2) {
        u32x4 pw; pw.x = pk2(p[c][8 * s2], p[c][8 * s2 + 1]); pw.y = pk2(p[c][8 * s2 + 2], p[c][8 * s2 + 3]);
        pw.z = pk2(p[c][8 * s2 + 4], p[c][8 * s2 + 5]); pw.w = pk2(p[c][8 * s2 + 6], p[c][8 * s2 + 7]);
        if (MODE == M_SEL) { if (!lane_on) { pw.x = 0u; pw.y = 0u; pw.z = 0u; pw.w = 0u; } }
        bf16x8 pf = __builtin_bit_cast(bf16x8, pw);
#pragma unroll
        for (int dt = 0; dt < 2; ++dt) {
          const char* vp = vl + (32 * dt + r) * 136 + (32 * c + 16 * s2 + 4 * h) * 2;
          s16x4 lo4 = *(const s16x4*)vp; s16x4 hi4 = *(const s16x4*)(vp + 16);
          bf16x8 vf = __builtin_shufflevector(lo4, hi4, 0, 1, 2, 3, 4, 5, 6, 7);
          st.o[dt] = MFMA32(vf, pf, st.o[dt]);
        }
      }
  }
  if (MODE != M_CMP2) {
    if (__any(tile_sum > RSUM)) {
      const float tot = xhalf_sum(tile_sum);
      const float dl = (tot > RSUM) ? __builtin_amdgcn_logf(tot) : 0.f;
      st.m += dl;
      const float nm = -st.m;
#pragma unroll
      for (int i = 0; i < 16; ++i) negm[i] = nm;
      const float f = ex2(-dl);
      st.l *= f;
      if (MODE != M_CMP1) {
#pragma unroll
        for (int i = 0; i < 16; ++i) { st.o[0][i] *= f; st.o[1][i] *= f; }
      }
    }
  }
}

template <int MODE>
DI bool tile_active(int T, int twmax, int qspan, const unsigned* selmask_q) {
  bool a;
  if (MODE == M_CMP1 || MODE == M_CMP2) a = (16 * (64 * T) + 31 <= twmax);
  else a = (64 * T <= twmax);
  if (MODE == M_WIN) a = a && (64 * T + 63 >= twmax - qspan - 511);
  if (MODE == M_SEL) { if (a) a = __any((int)((selmask_q[T >> 5] >> (T & 31)) & 1u)) != 0; }
  return a;
}

template <int MODE>
DI void run_tiles(AttnState& st, const bf16x8* qf, const TileSrc& src, int T0, int T1, int tq, int twmax_, int qspan, int koffb,
                  const unsigned* selmask_q, float m_fin, float inv_l, unsigned* imp_q, char* lds, int tid, int r, int h) {
  constexpr bool HASV = (MODE != M_CMP1), HASC = (MODE == M_FOX);
  const int twmax = __builtin_amdgcn_readfirstlane(twmax_);
  const float m0 = (MODE == M_CMP2) ? m_fin : MREF0;
  u32x4 rk[2], rv[2]; f32x4 rc;
  st.m = m0;
  f32x16 negm;
#pragma unroll
  for (int i = 0; i < 16; ++i) negm[i] = -m0;
  __syncthreads();
  if (T0 < T1) { tile_gload<HASV, HASC>(src, T0, rk, rv, rc, tid); tile_sstore<HASV, HASC>(lds, rk, rv, rc, tid); }
  if (T0 + 1 < T1) tile_gload<HASV, HASC>(src, T0 + 1, rk, rv, rc, tid);
  int slot = 0;
  for (int T = T0; T < T1; ++T) {
    const char* buf = lds + slot * ATT_BUF;
    slot = (slot == 2) ? 0 : slot + 1;
    if (T + 1 < T1) tile_sstore<HASV, HASC>(lds + slot * ATT_BUF, rk, rv, rc, tid);
    if (T + 2 < T1) tile_gload<HASV, HASC>(src, T + 2, rk, rv, rc, tid);
    __syncthreads();
    if (tile_active<MODE>(T, twmax, qspan, selmask_q)) {
      unsigned selbit = 0;
      if (MODE == M_SEL) selbit = (selmask_q[T >> 5] >> (T & 31)) & 1u;
      f32x16 p[2];
      qk_part<MODE>(p, qf, buf, koffb, negm, r, h);
      sp_part<MODE>(st, p, negm, buf, T, tq, selbit, inv_l, imp_q, r, h);
    }
  }
}

DI void st_init(AttnState& st) {
#pragma unroll
  for (int i = 0; i < 16; ++i) { st.o[0][i] = 0.f; st.o[1][i] = 0.f; }
  st.m = MREF0; st.l = 0.f;
}
DI float st_invl(const AttnState& st) { float lt = xhalf_sum(st.l); return lt > 0.f ? 1.f / lt : 0.f; }

DI void store_mix(const Params& P, size_t token, int col, float a, float b, float c, float d) {
  const bf16_t* G = (const bf16_t*)(P.ws + OFF_G) + token * 1024 + col;
  u32x2 gv = *(const u32x2*)G;
  float g0 = __uint_as_float(gv.x << 16), g1 = __uint_as_float(gv.x & 0xffff0000u), g2 = __uint_as_float(gv.y << 16), g3 = __uint_as_float(gv.y & 0xffff0000u);
  u32x2 w; w.x = pk2(a * g0, b * g1); w.y = pk2(c * g2, d * g3);
  *(u32x2*)((bf16_t*)(P.ws + OFF_MIX) + token * 1024 + col) = w;
}

DI void fox_unit(const Params& P, int bh, int qt, char* lds) {
  const int tid = get_tid(), lane = tid & 63, wave = tid >> 6, r = lane & 31, h = lane >> 5;
  const int t0 = 128 * qt, tq = t0 + 32 * wave + r, twmax = t0 + 32 * wave + 31;
  const bf16_t* Q = (const bf16_t*)(P.ws + OFF_QF) + (size_t)bh * SEQ * 64;
  TileSrc src; src.K = (const bf16_t*)(P.ws + OFF_KF) + (size_t)bh * SEQ * 64; src.Vt = (const bf16_t*)(P.ws + OFF_VFT) + (size_t)bh * SEQ * 64; src.vstride = SEQ;
  src.C = (const float*)(P.ws + OFF_CUM) + (size_t)bh * SEQ;
  bf16x8 qf[4];
#pragma unroll
  for (int d0 = 0; d0 < 4; ++d0) qf[d0] = *(const bf16x8*)(Q + (size_t)tq * 64 + 16 * d0 + 8 * h);
  AttnState st; st_init(st);
  run_tiles<M_FOX>(st, qf, src, 0, 2 * qt + 2, tq, twmax, 31, 0, nullptr, 0.f, 0.f, nullptr, lds, tid, r, h);
  const float inv = st_invl(st);
  const size_t token = (size_t)(bh >> 2) * SEQ + tq; const int hd = bh & 3;
#pragma unroll
  for (int dt = 0; dt < 2; ++dt)
#pragma unroll
    for (int g = 0; g < 4; ++g)
      store_mix(P, token, hd * 64 + 32 * dt + 8 * g + 4 * h, st.o[dt][4 * g] * inv, st.o[dt][4 * g + 1] * inv, st.o[dt][4 * g + 2] * inv, st.o[dt][4 * g + 3] * inv);
}

DI void diff_unit(const Params& P, int l, int bh, int qt, char* lds) {
  const int tid = get_tid(), lane = tid & 63, wave = tid >> 6, r = lane & 31, h = lane >> 5;
  const int comp = wave & 1, qs = wave >> 1;
  const int t0 = 64 * qt, tq = t0 + 32 * qs + r, twmax = t0 + 32 * qs + 31;
  const bf16_t* Q = (const bf16_t*)(P.ws + OFF_QD) + (size_t)bh * SEQ * 64;
  TileSrc src; src.K = (const bf16_t*)(P.ws + OFF_KD) + (size_t)bh * SEQ * 64; src.Vt = (const bf16_t*)(P.ws + OFF_VDT) + (size_t)bh * SEQ * 64; src.vstride = SEQ; src.C = nullptr;
  bf16x8 qf[2];
#pragma unroll
  for (int d0 = 0; d0 < 2; ++d0) qf[d0] = *(const bf16x8*)(Q + (size_t)tq * 64 + comp * 32 + 16 * d0 + 8 * h);
  AttnState st; st_init(st);
  run_tiles<M_DIFF>(st, qf, src, 0, qt + 1, tq, twmax, 31, comp * 64, nullptr, 0.f, 0.f, nullptr, lds, tid, r, h);
  const float inv = st_invl(st);
  float* exch = (float*)(lds + LDS_IMP);
  __syncthreads();
  if (comp == 1) {
#pragma unroll
    for (int dt = 0; dt < 2; ++dt)
#pragma unroll
      for (int i = 0; i < 16; ++i) exch[(qs * 64 + 32 * dt + crow(i, h)) * 32 + r] = st.o[dt][i] * inv;
  }
  __syncthreads();
  if (comp == 0) {
    const float lam = ((const float*)(P.ws + OFF_LAM))[l], lam_init = ((const float*)(P.ws + OFF_LAM))[2 + l];
    float ss = 0.f;
#pragma unroll
    for (int dt = 0; dt < 2; ++dt)
#pragma unroll
      for (int i = 0; i < 16; ++i) { float a = st.o[dt][i] * inv - lam * exch[(qs * 64 + 32 * dt + crow(i, h)) * 32 + r]; st.o[dt][i] = a; ss += a * a; }
    ss = xhalf_sum(ss);
    const float rms = rsqrtf(ss * (1.f / 64.f) + 1e-5f) * (1.f - lam_init);
    const size_t token = (size_t)(bh >> 2) * SEQ + tq; const int hd = bh & 3;
    const float* sg = P.subln_g + l * 64;
#pragma unroll
    for (int dt = 0; dt < 2; ++dt)
#pragma unroll
      for (int g = 0; g < 4; ++g) { int d = 32 * dt + 8 * g + 4 * h; f32x4 gg = *(const f32x4*)(sg + d);
        store_mix(P, token, 768 + hd * 64 + d, st.o[dt][4 * g] * rms * gg[0], st.o[dt][4 * g + 1] * rms * gg[1], st.o[dt][4 * g + 2] * rms * gg[2], st.o[dt][4 * g + 3] * rms * gg[3]); }
  }
}

DI void nsa_unit(const Params& P, int bg, int qt, char* lds) {
  const int tid = get_tid(), lane = tid & 63, wave = tid >> 6, r = lane & 31, h = lane >> 5;
  const int b = bg >> 1, g2 = bg & 1, head8 = g2 * 4 + (r & 3);
  const int t0 = 32 * qt, ql = 8 * wave + (r >> 2), tq = t0 + ql, tmax = t0 + 31, twmax = t0 + 8 * wave + 7;
  const bf16_t* Q = (const bf16_t*)(P.ws + OFF_QN) + (size_t)(b * 8 + head8) * SEQ * 64;
  bf16x8 qf[4];
#pragma unroll
  for (int d0 = 0; d0 < 4; ++d0) qf[d0] = *(const bf16x8*)(Q + (size_t)tq * 64 + 16 * d0 + 8 * h);
  unsigned* imp = (unsigned*)(lds + LDS_IMP);
  unsigned* selm = (unsigned*)(lds + LDS_SEL);
#pragma unroll
  for (int k = 0; k < 16; ++k) imp[tid + 256 * k] = 0u;
  const float* gates = (const float*)(P.ws + OFF_GATES) + ((size_t)b * SEQ + tq) * 24 + 3 * head8;
  const float gc = gates[0], gs = gates[1], gw = gates[2];
  unsigned* stash = (unsigned*)(lds + LDS_IMP) + wave * 16 * 64 + lane;
  TileSrc src; src.K = (const bf16_t*)(P.ws + OFF_KC) + (size_t)bg * 512 * 64; src.Vt = (const bf16_t*)(P.ws + OFF_VCC) + (size_t)bg * 64 * 512; src.vstride = 512; src.C = nullptr;
  int nvis = (t0 >> 4) + 1; if (nvis > 511) nvis = 511;
  const int ntc = (nvis + 63) >> 6;
  AttnState st; st_init(st);
  run_tiles<M_CMP1>(st, qf, src, 0, ntc, tq, twmax, 7, 0, nullptr, 0.f, 0.f, nullptr, lds, tid, r, h);
  {
    const float m_fin = st.m, inv_l = st_invl(st);
    st_init(st);
    run_tiles<M_CMP2>(st, qf, src, 0, ntc, tq, twmax, 7, 0, nullptr, m_fin, inv_l, imp + ql, lds, tid, r, h);
  }
  __syncthreads();
  {
    const int q = tid >> 3, jg = tid & 7; const int t = t0 + q, cur = t >> 6;
    unsigned key[16];
#pragma unroll
    for (int e = 0; e < 16; ++e) { int j = 16 * jg + e; unsigned v = imp[j * 32 + q];
      bool valid = j <= cur, forced = (j == 0) || (j == cur) || (j == cur - 1);
      key[e] = !valid ? 0u : (forced ? (0xFFFFFF80u | (unsigned)(127 - j)) : ((v << 7) | (unsigned)(127 - j))); }
    unsigned sel = 0;
    for (int round = 0; round < 16; ++round) {
      unsigned m = key[0];
#pragma unroll
      for (int e = 1; e < 16; ++e) m = m > key[e] ? m : key[e];
      unsigned o;
      o = __shfl_xor(m, 1); m = m > o ? m : o; o = __shfl_xor(m, 2); m = m > o ? m : o; o = __shfl_xor(m, 4); m = m > o ? m : o;
      if (m != 0u) {
#pragma unroll
        for (int e = 0; e < 16; ++e) if (key[e] == m) { sel |= 1u << e; key[e] = 0u; }
      }
    }
    ((unsigned short*)selm)[q * 8 + jg] = (unsigned short)sel;
  }
  __syncthreads();
#pragma unroll
  for (int i = 0; i < 8; ++i) { stash[i * 64] = pk2(gc * st.o[0][2 * i], gc * st.o[0][2 * i + 1]); stash[(8 + i) * 64] = pk2(gc * st.o[1][2 * i], gc * st.o[1][2 * i + 1]); }
  src.K = (const bf16_t*)(P.ws + OFF_KS) + (size_t)bg * SEQ * 64; src.Vt = (const bf16_t*)(P.ws + OFF_VST) + (size_t)bg * SEQ * 64; src.vstride = SEQ;
  st_init(st);
  run_tiles<M_SEL>(st, qf, src, 0, (tmax >> 6) + 1, tq, twmax, 7, 0, selm + ql * 4, 0.f, 0.f, nullptr, lds, tid, r, h);
  { const float inv = st_invl(st) * gs;
#pragma unroll
    for (int i = 0; i < 8; ++i) { unsigned a = stash[i * 64], bq = stash[(8 + i) * 64];
      stash[i * 64] = pk2(__uint_as_float(a << 16) + inv * st.o[0][2 * i], __uint_as_float(a & 0xffff0000u) + inv * st.o[0][2 * i + 1]);
      stash[(8 + i) * 64] = pk2(__uint_as_float(bq << 16) + inv * st.o[1][2 * i], __uint_as_float(bq & 0xffff0000u) + inv * st.o[1][2 * i + 1]); } }
  src.K = (const bf16_t*)(P.ws + OFF_KW) + (size_t)bg * SEQ * 64; src.Vt = (const bf16_t*)(P.ws + OFF_VWT) + (size_t)bg * SEQ * 64;
  st_init(st);
  { int lo_t = t0 - 511; int T0 = lo_t > 0 ? (lo_t >> 6) : 0;
    run_tiles<M_WIN>(st, qf, src, T0, (tmax >> 6) + 1, tq, twmax, 7, 0, nullptr, 0.f, 0.f, nullptr, lds, tid, r, h); }
  { const float inv = st_invl(st) * gw;
#pragma unroll
    for (int i = 0; i < 8; ++i) { unsigned a = stash[i * 64], bq = stash[(8 + i) * 64];
      st.o[0][2 * i] = __uint_as_float(a << 16) + inv * st.o[0][2 * i]; st.o[0][2 * i + 1] = __uint_as_float(a & 0xffff0000u) + inv * st.o[0][2 * i + 1];
      st.o[1][2 * i] = __uint_as_float(bq << 16) + inv * st.o[1][2 * i]; st.o[1][2 * i + 1] = __uint_as_float(bq & 0xffff0000u) + inv * st.o[1][2 * i + 1]; } }
  const size_t token = (size_t)b * SEQ + tq;
#pragma unroll
  for (int dt = 0; dt < 2; ++dt)
#pragma unroll
    for (int g = 0; g < 4; ++g)
      store_mix(P, token, 256 + head8 * 64 + 32 * dt + 8 * g + 4 * h, st.o[dt][4 * g], st.o[dt][4 * g + 1], st.o[dt][4 * g + 2], st.o[dt][4 * g + 3]);
}

DI void compress_tile(const Params& P, int l, int id, char* lds) {
  const int tid = get_tid(), lane = tid & 63, wave = tid >> 6, wm = wave >> 1, wn = wave & 1, r = lane & 31, h = lane >> 5;
  const int kv = id >> 4, bg = (id >> 2) & 3, mt = id & 3;
  const bf16_t* tok = (const bf16_t*)(P.ws + (kv ? OFF_VCT : OFF_KCT)) + (size_t)bg * SEQ * 64;
  const bf16_t* Bt = (const bf16_t*)(P.ws + OFF_W1T) + ((size_t)l * 2 + kv) * 128 * 2048;
  f32x16 acc[2][2];
  int rowmax = 510 - 128 * mt; if (rowmax > 127) rowmax = 127;
  gemm_mainloop(tok + (size_t)mt * 128 * 1024, 1024, rowmax, Bt, 2048, 2048, lds, acc);
  __syncthreads();
  float* H = (float*)lds;
  const float* bias = (const float*)(P.ws + OFF_B1) + (l * 2 + kv) * 128;
#pragma unroll
  for (int a = 0; a < 2; ++a)
#pragma unroll
    for (int bb = 0; bb < 2; ++bb) { int col = 64 * wn + 32 * bb + r; float bv = bias[col];
#pragma unroll
      for (int i = 0; i < 16; ++i) { int row = 64 * wm + 32 * a + crow(i, h); H[row * 129 + col] = silu(acc[a][bb][i] + bv); } }
  __syncthreads();
  const float* w2 = (kv ? P.w2_v : P.w2_k) + (size_t)l * 128 * 64;
  const int c = tid & 63, rg = tid >> 6;
  float o[32];
#pragma unroll
  for (int i = 0; i < 32; ++i) o[i] = 0.f;
  for (int j = 0; j < 128; ++j) { float w = w2[j * 64 + c];
#pragma unroll
    for (int i = 0; i < 32; ++i) o[i] += H[(rg * 32 + i) * 129 + j] * w; }
  if (kv == 0) { bf16_t* dst = (bf16_t*)(P.ws + OFF_KC) + (size_t)bg * 512 * 64;
#pragma unroll
    for (int i = 0; i < 32; ++i) { int n = 128 * mt + rg * 32 + i; dst[(size_t)n * 64 + c] = f2bf(o[i]); } }
  else { bf16_t* dst = (bf16_t*)(P.ws + OFF_VCC) + (size_t)bg * 64 * 512;
#pragma unroll
    for (int i = 0; i < 32; ++i) { int n = 128 * mt + rg * 32 + i; dst[(size_t)c * 512 + n] = f2bf(o[i]); } }
  __syncthreads();
}

DI void cumsum_seq(const Params& P, int bh, char* lds) {
  const int tid = get_tid();
  const float* src = (const float*)(P.ws + OFF_LOGF) + (size_t)bh * SEQ + tid * 32;
  float* dst = (float*)(P.ws + OFF_CUM) + (size_t)bh * SEQ + tid * 32;
  float* tot = (float*)lds;
  f32x4 v[8]; float s = 0.f;
#pragma unroll
  for (int k = 0; k < 8; ++k) { v[k] = *(const f32x4*)(src + 4 * k);
#pragma unroll
    for (int e = 0; e < 4; ++e) { s += v[k][e]; v[k][e] = s; } }
  __syncthreads();
  tot[tid] = s;
  __syncthreads();
  float base = 0.f;
  for (int i = 0; i < tid; ++i) base += tot[i];
#pragma unroll
  for (int k = 0; k < 8; ++k) { f32x4 o;
#pragma unroll
    for (int e = 0; e < 4; ++e) o[e] = v[k][e] + base;
    *(f32x4*)(dst + 4 * k) = o; }
  __syncthreads();
}

DI int next_unit(unsigned* ctr, int* s_unit) {
  __syncthreads();
  if (get_tid() == 0) *s_unit = (int)atomicAdd(ctr, 1u);
  __syncthreads();
  return *s_unit;
}

DI void p23_phase(const Params& P, int l, char* lds, int* s_unit, int rep = 0) {
  unsigned* ctr = (unsigned*)(P.ws + OFF_CTR) + (l * 4 + 0 + 16 * rep);
  unsigned* done = (unsigned*)(P.ws + OFF_CTR) + (40 + l + 4 * rep);
  bool acquired = false;
  for (;;) {
    int u = next_unit(ctr, s_unit);
    if (u >= 40 + 1024 + 512 + 1024) break;
    if (u < 40) {
      if (u < 32) compress_tile(P, l, u, lds); else cumsum_seq(P, u - 32, lds);
      asm volatile("s_waitcnt vmcnt(0)" ::: "memory");
      __syncthreads();
      if (get_tid() == 0) { __builtin_amdgcn_fence(__ATOMIC_RELEASE, "agent"); asm volatile("s_waitcnt vmcnt(0)" ::: "memory");
        __hip_atomic_fetch_add(done, 1u, __ATOMIC_RELAXED, __HIP_MEMORY_SCOPE_AGENT); }
    } else if (u < 40 + 1024) { int v = u - 40; diff_unit(P, l, v & 7, 127 - (v >> 3), lds); }
    else {
      if (!acquired) {
        if (get_tid() == 0) {
          unsigned sp = 0;
          while (__hip_atomic_load(done, __ATOMIC_RELAXED, __HIP_MEMORY_SCOPE_AGENT) < 40u) { __builtin_amdgcn_s_sleep(4); if (++sp > (1u << 24)) break; }
          __builtin_amdgcn_fence(__ATOMIC_ACQUIRE, "agent"); asm volatile("s_waitcnt vmcnt(0)" ::: "memory");
        }
        __syncthreads();
        acquired = true;
      }
      const int w = u - (40 + 1024);
      if (w < 384) fox_unit(P, w & 7, 63 - (w >> 3), lds);
      else if (w < 384 + 1024) { int v = w - 384; nsa_unit(P, v & 3, 255 - (v >> 2), lds); }
      else { int v = w - (384 + 1024); fox_unit(P, v & 7, 15 - (v >> 3), lds); }
    }
  }
}

template <int KIND> DI void run_phase(const Params& P, int l, char* lds, int* s_unit, int rep = 0) {
  if constexpr (KIND == 0) p0_prologue(P);
  else if constexpr (KIND == 1) p1_inproj(P, l, lds);
  else if constexpr (KIND == 2) p23_phase(P, l, lds, s_unit, rep);
  else if constexpr (KIND == 3) { }
  else if constexpr (KIND == 4) p4_outproj(P, l, lds);
  else p5_ln(P, l);
}
template <int KIND> __global__ void __launch_bounds__(NTHREADS, 2) phase_kernel(Params P, int l) {
  __shared__ __attribute__((aligned(16))) char lds[LDS_BYTES + LDS_CTL];
  run_phase<KIND>(P, l, lds, (int*)(lds + LDS_BYTES));
}
#if COOP
#define GSYNC() do { asm volatile("" ::: "memory"); cg::this_grid().sync(); asm volatile("" ::: "memory"); } while (0)
#define XB_TMO      128
#define XB_XCNT(j)  (256  + 64 * (j))
#define XB_XSUB(j)  (1280 + 64 * (j))
#define XB_XGEN(j)  (2304 + 64 * (j))
#define XB_TOP      3328
#define XB_TOPGEN   3392
#define XCD_BAR_WORDS 3456
#define XB_SPIN_CAP (1u << 22)
#define LAS __attribute__((address_space(3)))
DI unsigned xb_ld(unsigned* p) { return __hip_atomic_load(p, __ATOMIC_RELAXED, __HIP_MEMORY_SCOPE_AGENT); }
DI unsigned xb_add(unsigned* p, unsigned v) { return __hip_atomic_fetch_add(p, v, __ATOMIC_RELAXED, __HIP_MEMORY_SCOPE_AGENT); }
DI unsigned xb_xcc_id() { return (unsigned)__builtin_amdgcn_s_getreg((3 << 11) | 20) & 0xFu; }
#define XB_SPIN(cond, bar) do { unsigned _sp = 0; while (cond) { __builtin_amdgcn_s_sleep(1); \
    if ((++_sp & 255u) == 0u) { if (xb_ld(&(bar)[XB_TMO])) break; if (_sp > XB_SPIN_CAP) { atomicAdd(&(bar)[XB_TMO], 1u); break; } } } } while (0)
struct XcdBarrier { unsigned* bar; unsigned x; volatile LAS unsigned* st; };
DI XcdBarrier xcd_barrier_post(unsigned* bar, volatile LAS unsigned* st) {
  XcdBarrier b; b.bar = bar; b.x = xb_xcc_id(); b.st = st;
  if (threadIdx.x == 0) (void)xb_add(&bar[XB_XCNT(b.x)], 1u);
  return b;
}
DI void xcd_barrier_complete(unsigned* bar, unsigned x, unsigned& nloc, unsigned& nx) {
  const unsigned G = gridDim.x * gridDim.y * gridDim.z;
  unsigned sum, cnt, mine, sp = 0u;
  for (;;) {
    sum = 0u; cnt = 0u; mine = 0u;
#pragma unroll
    for (unsigned j = 0; j < 16; ++j) { const unsigned c = xb_ld(&bar[XB_XCNT(j)]); sum += c; cnt += (c > 0u) ? 1u : 0u; mine = (j == x) ? c : mine; }
    if (sum == G) break;
    __builtin_amdgcn_s_sleep(1);
    if ((++sp & 255u) == 0u) { if (xb_ld(&bar[XB_TMO])) break; if (sp > XB_SPIN_CAP) { atomicAdd(&bar[XB_TMO], 1u); break; } }
  }
  nloc = mine > 0u ? mine : 1u; nx = cnt > 0u ? cnt : 1u;
}
DI void xcd_barrier(const XcdBarrier& b) {
  asm volatile("s_waitcnt vmcnt(0)" ::: "memory");
  __syncthreads();
  if (threadIdx.x == 0) {
    unsigned* bar = b.bar;
    __builtin_amdgcn_s_waitcnt(0);
    unsigned nloc = b.st[0], nx = b.st[1];
    if (nloc == 0u) { xcd_barrier_complete(bar, b.x, nloc, nx); b.st[0] = nloc; b.st[1] = nx; }
    const unsigned old = xb_add(&bar[XB_XSUB(b.x)], 1u);
    const unsigned gen = old / nloc;
    if (old + 1u == (gen + 1u) * nloc) {
      __builtin_amdgcn_fence(__ATOMIC_RELEASE, "agent");
      asm volatile("s_waitcnt vmcnt(0)" ::: "memory");
      const unsigned og = xb_add(&bar[XB_TOP], 1u);
      const unsigned tg = og / nx;
      if (og + 1u == (tg + 1u) * nx) xb_add(&bar[XB_TOPGEN], 1u);
      else XB_SPIN(xb_ld(&bar[XB_TOPGEN]) == tg, bar);
      __builtin_amdgcn_fence(__ATOMIC_ACQUIRE, "agent");
      xb_add(&bar[XB_XGEN(b.x)], 1u);
      asm volatile("s_waitcnt vmcnt(0)" ::: "memory");
    } else {
      XB_SPIN(xb_ld(&bar[XB_XGEN(b.x)]) == gen, bar);
      __builtin_amdgcn_fence(__ATOMIC_ACQUIRE, "agent");
      asm volatile("s_waitcnt vmcnt(0)" ::: "memory");
    }
  }
  __syncthreads();
}
#ifndef CG_ALL
#define BSYNC() do { asm volatile("" ::: "memory"); xcd_barrier(xb); asm volatile("" ::: "memory"); } while (0)
#else
#define BSYNC() GSYNC()
#endif
__global__ void __launch_bounds__(NTHREADS, 2) fwd_kernel(Params P) {
  __shared__ __attribute__((aligned(16))) char lds[LDS_BYTES + LDS_CTL];
  int* const s_unit_p = (int*)(lds + LDS_BYTES);
  if (threadIdx.x == 0) *(uint4*)(lds + LDS_BYTES + 16) = make_uint4(0u, 0u, 0u, 0u);
  __syncthreads();
  const XcdBarrier xb = xcd_barrier_post((unsigned*)(P.ws + OFF_BAR), (volatile LAS unsigned*)(lds + LDS_BYTES + 16));
  if (P.pad_ == 0x5eed) GSYNC();
  run_phase<0>(P, 0, lds, s_unit_p); BSYNC();
  for (int l = 0; l < DEPTH; ++l) {
    run_phase<1>(P, l, lds, s_unit_p); BSYNC();
#if REPEAT == 1
    run_phase<1>(P, l, lds, s_unit_p, 1); BSYNC();
#endif
    run_phase<2>(P, l, lds, s_unit_p); BSYNC();
    run_phase<4>(P, l, lds, s_unit_p); BSYNC();
    run_phase<5>(P, l, lds, s_unit_p); if (l + 1 < DEPTH) BSYNC();
  }
}
#endif

extern "C" void kernel_launch(void* const* d_in, const int* in_sizes, int n_in, void* d_out, int out_size, void* d_ws, size_t ws_size, hipStream_t stream) {
  static int grid_blocks = 0;
  if (!grid_blocks) {
    int dev = 0, cus = 0, per_cu = 0;
    (void)hipGetDevice(&dev);
    (void)hipDeviceGetAttribute(&cus, hipDeviceAttributeMultiprocessorCount, dev);
#if COOP
    (void)hipOccupancyMaxActiveBlocksPerMultiprocessor(&per_cu, fwd_kernel, NTHREADS, 0);
#else
    per_cu = 2;
#endif
    if (per_cu < 1) per_cu = 1;
    if (per_cu > 2) per_cu = 2;
    if (cus < 1) cus = 256;
    grid_blocks = cus * per_cu;
  }
  if (n_in != 17 || ws_size < WS_NEED) { fprintf(stderr, "kernel_launch: unexpected inputs (%d) or workspace (%zu)\n", n_in, ws_size); return; }
  Params p{};
  p.x = (const float*)d_in[0]; p.w_in = (const float*)d_in[1]; p.b_fox_f = (const float*)d_in[2]; p.pos_k = (const float*)d_in[3]; p.pos_v = (const float*)d_in[4];
  p.w1_k = (const float*)d_in[5]; p.w2_k = (const float*)d_in[6]; p.w1_v = (const float*)d_in[7]; p.w2_v = (const float*)d_in[8];
  p.lq1 = (const float*)d_in[9]; p.lk1 = (const float*)d_in[10]; p.lq2 = (const float*)d_in[11]; p.lk2 = (const float*)d_in[12];
  p.subln_g = (const float*)d_in[13]; p.w_out = (const float*)d_in[14]; p.ln_g = (const float*)d_in[15]; p.ln_b = (const float*)d_in[16];
  p.out = (float*)d_out; p.ws = (char*)d_ws;
  (void)hipMemsetAsync((char*)d_ws + OFF_CTR, 0, 4096, stream);
  (void)hipMemsetAsync((char*)d_ws + OFF_BAR, 0, CTL_ZERO_BYTES - OFF_BAR, stream);
#if COOP
  void* args[] = {&p};
  hipError_t e = hipLaunchCooperativeKernel((void*)fwd_kernel, dim3(grid_blocks), dim3(NTHREADS), args, 0, stream);
  if (e != hipSuccess) fprintf(stderr, "cooperative launch failed: %s (grid %d)\n", hipGetErrorString(e), grid_blocks);
#else
  const dim3 g(grid_blocks), b(NTHREADS);
  hipLaunchKernelGGL(phase_kernel<0>, g, b, 0, stream, p, 0);
  for (int l = 0; l < DEPTH; ++l) {
    hipLaunchKernelGGL(phase_kernel<1>, g, b, 0, stream, p, l);
    hipLaunchKernelGGL(phase_kernel<2>, g, b, 0, stream, p, l);
    hipLaunchKernelGGL(phase_kernel<4>, g, b, 0, stream, p, l);
    hipLaunchKernelGGL(phase_kernel<5>, g, b, 0, stream, p, l);
  }
#endif
}
```

```cpp
#include <hip/hip_runtime.h>
#include <hip/hip_cooperative_groups.h>
#include <stdint.h>
#include <cstdio>
namespace cg = cooperative_groups;

#ifndef COOP
#define COOP 1
#endif
#ifndef REPEAT
#define REPEAT 0
#endif

#define DI __device__ __forceinline__
typedef unsigned short bf16_t;
typedef short bf16x8 __attribute__((ext_vector_type(8)));
typedef short s16x4 __attribute__((ext_vector_type(4)));
typedef float f32x16 __attribute__((ext_vector_type(16)));
typedef float f32x4 __attribute__((ext_vector_type(4)));
typedef float f32x2 __attribute__((ext_vector_type(2)));
typedef unsigned u32x4 __attribute__((ext_vector_type(4)));
typedef unsigned u32x2 __attribute__((ext_vector_type(2)));
typedef __bf16 bf16x2_t __attribute__((ext_vector_type(2)));

#define MFMA32(a, b, c) __builtin_amdgcn_mfma_f32_32x32x16_bf16((a), (b), (c), 0, 0, 0)

constexpr int BATCH = 2, SEQ = 8192, DMODEL = 1024, MTOK = BATCH * SEQ, NIN = 3868, NPAD = 3968, DEPTH = 2;
constexpr float LOG2E = 1.4426950408889634f;
constexpr float NEGBIG = -1e30f;
constexpr float MINIT = -1e20f;
constexpr int NTHREADS = 256;

constexpr size_t MiB = 1u << 20;
constexpr size_t OFF_CTR = 0, OFF_LAM = 4096, OFF_B1 = 8192, OFF_BAR = 16384, CTL_ZERO_BYTES = 32768;
constexpr size_t OFF_ROPE64 = 1 * MiB, OFF_ROPE32 = 3 * MiB, OFF_WIN = 4 * MiB, OFF_WOUT = 20 * MiB, OFF_W1T = 24 * MiB;
constexpr size_t OFF_XB = 26 * MiB, OFF_G = 58 * MiB, OFF_MIX = 90 * MiB;
constexpr size_t OFF_QF = 122 * MiB, OFF_KF = 130 * MiB, OFF_VFT = 138 * MiB, OFF_QN = 146 * MiB;
constexpr size_t OFF_KCT = 162 * MiB, OFF_VCT = 166 * MiB, OFF_KS = 170 * MiB, OFF_VST = 174 * MiB, OFF_KW = 178 * MiB, OFF_VWT = 182 * MiB;
constexpr size_t OFF_QD = 186 * MiB, OFF_KD = 194 * MiB, OFF_VDT = 202 * MiB;
constexpr size_t OFF_LOGF = 210 * MiB, OFF_CUM = 210 * MiB + 256 * 1024, OFF_GATES = 211 * MiB;
constexpr size_t OFF_KC = 213 * MiB, OFF_VCC = 213 * MiB + 256 * 1024, WS_NEED = 214 * MiB;

constexpr int LDS_BYTES = 73728, LDS_CTL = 32;
constexpr int ATT_BUF = 18944, ATT_V = 9216, ATT_C = 18432;
constexpr int LDS_IMP = 3 * ATT_BUF, LDS_SEL = LDS_BYTES - 512;
static_assert(LDS_IMP + 16384 <= LDS_SEL, "LDS map");
constexpr int GEMM_AB = 18432;

struct Params {
  const float *x, *w_in, *b_fox_f, *pos_k, *pos_v, *w1_k, *w2_k, *w1_v, *w2_v, *lq1, *lk1, *lq2, *lk2, *subln_g, *w_out, *ln_g, *ln_b;
  float* out;
  char* ws;
  long pad_;
};

DI unsigned short f2bf(float f) { unsigned u = __float_as_uint(f); return (unsigned short)((u + 0x7fffu + ((u >> 16) & 1u)) >> 16); }
DI unsigned pk2(float lo, float hi) { f32x2 v = {lo, hi}; bf16x2_t b = __builtin_convertvector(v, bf16x2_t); return __builtin_bit_cast(unsigned, b); }
DI float silu(float x) { return x / (1.f + __expf(-x)); }
DI float sigmoidf(float x) { return 1.f / (1.f + __expf(-x)); }
DI float ex2(float x) { return __builtin_amdgcn_exp2f(x); }
DI float xhalf_max(float v) { auto rr = __builtin_amdgcn_permlane32_swap(__float_as_uint(v), __float_as_uint(v), false, false); return fmaxf(__uint_as_float(rr[0]), __uint_as_float(rr[1])); }
DI float xhalf_sum(float v) { auto rr = __builtin_amdgcn_permlane32_swap(__float_as_uint(v), __float_as_uint(v), false, false); return __uint_as_float(rr[0]) + __uint_as_float(rr[1]); }
DI int crow(int i, int h) { return (i & 3) + 8 * (i >> 2) + 4 * h; }

DI int get_tid() { int t = threadIdx.x; asm volatile("" : "+v"(t)); return t; }
DI int orig_col(int n) {
  int s = n >> 6, c = n & 63;
  if (s < 4) return s * 64 + c;
  if (s < 8) return 256 + (s - 4) * 64 + c;
  if (s < 12) return 512 + (s - 8) * 64 + c;
  if (s < 16) return 772 + (s - 12) * 64 + c;
  if (s < 24) return 1028 + (s - 16) * 64 + c;
  if (s < 36) return 1540 + (s - 24) * 64 + c;
  if (s < 44) return 2332 + (s - 36) * 64 + c;
  if (s < 52) { int base = 2844 + (s - 44) * 64; int nt = c >> 5, r = c & 31, comp = r >> 4, i = r & 15; return base + comp * 32 + nt * 16 + i; }
  if (s < 60) return 3356 + (s - 52) * 64 + c;
  if (s == 60) { if (c < 4) return 768 + c; if (c < 28) return 2308 + (c - 4); return -1; }
  return -1;
}

DI void p0_prologue(const Params& P) {
  const long gtid = (long)blockIdx.x * NTHREADS + get_tid(), gsz = (long)gridDim.x * NTHREADS;
  char* ws = P.ws;
  if (gtid < DEPTH) {
    int l = (int)gtid; float a = 0.f, b = 0.f;
    for (int i = 0; i < 32; ++i) { a += P.lq1[l * 32 + i] * P.lk1[l * 32 + i]; b += P.lq2[l * 32 + i] * P.lk2[l * 32 + i]; }
    float lam_init = 0.8f - 0.6f * expf(-0.3f * (float)l);
    ((float*)(ws + OFF_LAM))[l] = expf(a) - expf(b) + lam_init;
    ((float*)(ws + OFF_LAM))[2 + l] = lam_init;
  }
  for (long it = gtid; it < DEPTH * 2 * 128; it += gsz) {
    int j = it & 127, kv = (it >> 7) & 1, l = (int)(it >> 8);
    const float* pos = (kv ? P.pos_v : P.pos_k) + (size_t)l * 2048;
    const float* w1 = (kv ? P.w1_v : P.w1_k) + (size_t)l * 2048 * 128;
    float a = 0.f;
    for (int k = 0; k < 2048; ++k) a += pos[k] * w1[(size_t)k * 128 + j];
    ((float*)(ws + OFF_B1))[it] = a;
  }
  for (long it = gtid; it < (long)DEPTH * 128 * NPAD; it += gsz) {
    int n = (int)(it % NPAD); int k8 = (int)((it / NPAD) & 127); int l = (int)(it / ((long)NPAD * 128));
    int oc = orig_col(n);
    u32x4 v = {0u, 0u, 0u, 0u};
    if (oc >= 0) { const float* src = P.w_in + (size_t)l * DMODEL * NIN + (size_t)(k8 * 8) * NIN + oc;
      float f[8];
#pragma unroll
      for (int j = 0; j < 8; ++j) f[j] = src[(size_t)j * NIN];
      v.x = pk2(f[0], f[1]); v.y = pk2(f[2], f[3]); v.z = pk2(f[4], f[5]); v.w = pk2(f[6], f[7]); }
    *(u32x4*)((bf16_t*)(ws + OFF_WIN) + ((size_t)l * NPAD + n) * DMODEL + k8 * 8) = v;
  }
  for (long it = gtid; it < (long)DEPTH * 128 * 1024; it += gsz) {
    int n = (int)(it & 1023); int k8 = (int)((it >> 10) & 127); int l = (int)(it >> 17);
    const float* src = P.w_out + (size_t)l * 1024 * 1024 + (size_t)(k8 * 8) * 1024 + n;
    float f[8];
#pragma unroll
    for (int j = 0; j < 8; ++j) f[j] = src[(size_t)j * 1024];
    u32x4 v; v.x = pk2(f[0], f[1]); v.y = pk2(f[2], f[3]); v.z = pk2(f[4], f[5]); v.w = pk2(f[6], f[7]);
    *(u32x4*)((bf16_t*)(ws + OFF_WOUT) + ((size_t)l * 1024 + n) * 1024 + k8 * 8) = v;
  }
  for (long it = gtid; it < (long)DEPTH * 2 * 256 * 128; it += gsz) {
    int j = (int)(it & 127); int k8 = (int)((it >> 7) & 255); int kv = (int)((it >> 15) & 1); int l = (int)(it >> 16);
    const float* src = (kv ? P.w1_v : P.w1_k) + (size_t)l * 2048 * 128 + (size_t)(k8 * 8) * 128 + j;
    float f[8];
#pragma unroll
    for (int jj = 0; jj < 8; ++jj) f[jj] = src[(size_t)jj * 128];
    u32x4 v; v.x = pk2(f[0], f[1]); v.y = pk2(f[2], f[3]); v.z = pk2(f[4], f[5]); v.w = pk2(f[6], f[7]);
    *(u32x4*)((bf16_t*)(ws + OFF_W1T) + (((size_t)l * 2 + kv) * 128 + j) * 2048 + k8 * 8) = v;
  }
  for (long it = gtid; it < (long)MTOK * DMODEL / 8; it += gsz) {
    const f32x4* src = (const f32x4*)P.x + it * 2; f32x4 a = src[0], b = src[1];
    u32x4 v; v.x = pk2(a[0], a[1]); v.y = pk2(a[2], a[3]); v.z = pk2(b[0], b[1]); v.w = pk2(b[2], b[3]);
    *((u32x4*)(ws + OFF_XB) + it) = v;
  }
}

#define LDSAS __attribute__((address_space(3)))
DI void glds16(const char* gsrc, char* ldst) {
  __builtin_amdgcn_global_load_lds((const unsigned*)gsrc, (LDSAS unsigned*)ldst, 16, 0, 0);
}
DI void gemm_mainloop(const bf16_t* A, long lda, int a_row_max, const bf16_t* Bt, long ldb, int K, char* lds, f32x16 (&acc)[2][2]) {
  const int tid = get_tid(), lane = tid & 63, wave = __builtin_amdgcn_readfirstlane(tid >> 6), wm = wave >> 1, wn = wave & 1, r = lane & 31, h = lane >> 5;
#pragma unroll
  for (int a = 0; a < 2; ++a)
#pragma unroll
    for (int b = 0; b < 2; ++b)
#pragma unroll
      for (int i = 0; i < 16; ++i) acc[a][b][i] = 0.f;
  const char* ga[4]; const char* gb[4];
#pragma unroll
  for (int i = 0; i < 4; ++i) { const int row = 32 * wave + 8 * i + (lane >> 3), ch = (lane & 7) ^ ((row >> 1) & 7); const int ar = row < a_row_max ? row : a_row_max;
    ga[i] = (const char*)(A + (long)ar * lda) + ch * 16; gb[i] = (const char*)(Bt + (long)row * ldb) + ch * 16; }
  char* const ldw = lds + (32 * wave) * 128;
  const int nk = K >> 6;
#define GEMM_STAGE(BUF, KT) do { _Pragma("unroll") for (int i = 0; i < 4; ++i) { \
    glds16(ga[i] + (long)(KT) * 128, ldw + (BUF) * 32768 + i * 1024); glds16(gb[i] + (long)(KT) * 128, ldw + (BUF) * 32768 + 16384 + i * 1024); } } while (0)
  __syncthreads();
  GEMM_STAGE(0, 0);
  asm volatile("s_waitcnt vmcnt(0)" ::: "memory");
  __syncthreads();
  const int sw = (r >> 1) & 7;
  const unsigned lds0 = (unsigned)(uintptr_t)lds;
  unsigned aa[4], ab[4];
#pragma unroll
  for (int ks = 0; ks < 4; ++ks) { const unsigned xo = (unsigned)(((2 * ks + h) ^ sw) * 16);
    aa[ks] = lds0 + (unsigned)((64 * wm + r) * 128) + xo; ab[ks] = lds0 + 16384u + (unsigned)((64 * wn + r) * 128) + xo; }
  bf16x8 xa0, xa1, xb0, xb1, ya0, ya1, yb0, yb1, za0, za1, zb0, zb1;
#define KT_RD(S, K, O0, O1) \
    "ds_read_b128 %[" #S "a0], %[aa" #K "] offset:" O0 "\n\tds_read_b128 %[" #S "b0], %[ab" #K "] offset:" O0 "\n\t" \
    "ds_read_b128 %[" #S "a1], %[aa" #K "] offset:" O1 "\n\tds_read_b128 %[" #S "b1], %[ab" #K "] offset:" O1 "\n\t"
#define KT_MM(S) \
    "v_mfma_f32_32x32x16_bf16 %[c00], %[" #S "a0], %[" #S "b0], %[c00]\n\tv_mfma_f32_32x32x16_bf16 %[c01], %[" #S "a0], %[" #S "b1], %[c01]\n\t" \
    "v_mfma_f32_32x32x16_bf16 %[c10], %[" #S "a1], %[" #S "b0], %[c10]\n\tv_mfma_f32_32x32x16_bf16 %[c11], %[" #S "a1], %[" #S "b1], %[c11]\n\t"
#define KT_ASM(O0, O1) asm volatile( \
    "s_waitcnt lgkmcnt(0)\n\t" \
    KT_RD(x, 0, O0, O1) KT_RD(y, 1, O0, O1) \
    "s_waitcnt lgkmcnt(4)\n\t" KT_MM(x) KT_RD(z, 2, O0, O1) \
    "s_waitcnt lgkmcnt(4)\n\t" KT_MM(y) KT_RD(x, 3, O0, O1) \
    "s_waitcnt lgkmcnt(4)\n\t" KT_MM(z) \
    "s_waitcnt lgkmcnt(0)\n\t" KT_MM(x) \
    : [c00] "+v"(acc[0][0]), [c01] "+v"(acc[0][1]), [c10] "+v"(acc[1][0]), [c11] "+v"(acc[1][1]), \
      [xa0] "=&v"(xa0), [xa1] "=&v"(xa1), [xb0] "=&v"(xb0), [xb1] "=&v"(xb1), [ya0] "=&v"(ya0), [ya1] "=&v"(ya1), [yb0] "=&v"(yb0), [yb1] "=&v"(yb1), \
      [za0] "=&v"(za0), [za1] "=&v"(za1), [zb0] "=&v"(zb0), [zb1] "=&v"(zb1) \
    : [aa0] "v"(aa[0]), [aa1] "v"(aa[1]), [aa2] "v"(aa[2]), [aa3] "v"(aa[3]), [ab0] "v"(ab[0]), [ab1] "v"(ab[1]), [ab2] "v"(ab[2]), [ab3] "v"(ab[3]) \
    : "memory")
  for (int kt = 0; kt < nk; kt += 2) {
    GEMM_STAGE(1, kt + 1);
    KT_ASM("0", "4096");
    asm volatile("s_waitcnt vmcnt(0)" ::: "memory");
    __syncthreads();
    if (kt + 2 < nk) GEMM_STAGE(0, kt + 2);
    KT_ASM("32768", "36864");
    asm volatile("s_waitcnt vmcnt(0)" ::: "memory");
    __syncthreads();
  }
  asm volatile("s_nop 15\n\ts_nop 7" : "+v"(acc[0][0]), "+v"(acc[0][1]), "+v"(acc[1][0]), "+v"(acc[1][1]));
#undef KT_RD
#undef KT_MM
#undef KT_ASM
#undef GEMM_STAGE
}

DI bool xcd_tile(int i, int NT, int& mt, int& nt) {
  const int G = gridDim.x;
  if ((G & 7) == 0 && G >= 8) {
    const int x = blockIdx.x & 7, j = blockIdx.x >> 3, per = G >> 3;
    const int u = j + per * i; if (u >= 16 * NT) return false;
    const int grp = u / (8 * NT), v = u - grp * (8 * NT);
    mt = 16 * x + 8 * grp + (v & 7); nt = v >> 3; return true;
  }
  const int t = blockIdx.x + G * i; if (t >= 128 * NT) return false;
  mt = t / NT; nt = t - mt * NT; return true;
}

DI void epi_inproj(const Params& P, int l, const f32x16 (&acc)[2][2], int m0, int n0, char* lds) {
  const int tid = get_tid(), lane = tid & 63, wave = tid >> 6, wm = wave >> 1, wn = wave & 1, r = lane & 31, h = lane >> 5;
  char* ws = P.ws;
  const int slot = (n0 >> 6) + wn;
  const int b = m0 >> 13;
  const int srow0 = (m0 & (SEQ - 1)) + 64 * wm;
  int cat = 0;
  int rope = 0; float scale = 1.f; bf16_t* dst = nullptr; int gcol = 0;
  const float QS = 0.125f * LOG2E;
  if (slot < 4) { cat = 1; scale = QS; dst = (bf16_t*)(ws + OFF_QF) + (size_t)(b * 4 + slot) * SEQ * 64; }
  else if (slot < 8) { cat = 1; dst = (bf16_t*)(ws + OFF_KF) + (size_t)(b * 4 + slot - 4) * SEQ * 64; }
  else if (slot < 12) { cat = 2; dst = (bf16_t*)(ws + OFF_VFT) + (size_t)(b * 4 + slot - 8) * SEQ * 64; }
  else if (slot < 16) { cat = 3; gcol = (slot - 12) * 64; }
  else if (slot < 24) { cat = 1; rope = 1; scale = QS; dst = (bf16_t*)(ws + OFF_QN) + (size_t)(b * 8 + slot - 16) * SEQ * 64; }
  else if (slot < 26) { cat = 1; rope = 1; dst = (bf16_t*)(ws + OFF_KCT) + (size_t)(b * 2 + slot - 24) * SEQ * 64; }
  else if (slot < 28) { cat = 1; dst = (bf16_t*)(ws + OFF_VCT) + (size_t)(b * 2 + slot - 26) * SEQ * 64; }
  else if (slot < 30) { cat = 1; rope = 1; dst = (bf16_t*)(ws + OFF_KS) + (size_t)(b * 2 + slot - 28) * SEQ * 64; }
  else if (slot < 32) { cat = 2; dst = (bf16_t*)(ws + OFF_VST) + (size_t)(b * 2 + slot - 30) * SEQ * 64; }
  else if (slot < 34) { cat = 1; rope = 1; dst = (bf16_t*)(ws + OFF_KW) + (size_t)(b * 2 + slot - 32) * SEQ * 64; }
  else if (slot < 36) { cat = 2; dst = (bf16_t*)(ws + OFF_VWT) + (size_t)(b * 2 + slot - 34) * SEQ * 64; }
  else if (slot < 44) { cat = 3; gcol = 256 + (slot - 36) * 64; }
  else if (slot < 48) { cat = 1; rope = 2; scale = 0.17677669529663687f * LOG2E; dst = (bf16_t*)(ws + OFF_QD) + (size_t)(b * 4 + slot - 44) * SEQ * 64; }
  else if (slot < 52) { cat = 1; rope = 2; dst = (bf16_t*)(ws + OFF_KD) + (size_t)(b * 4 + slot - 48) * SEQ * 64; }
  else if (slot < 56) { cat = 2; dst = (bf16_t*)(ws + OFF_VDT) + (size_t)(b * 4 + slot - 52) * SEQ * 64; }
  else if (slot < 60) { cat = 3; gcol = 768 + (slot - 56) * 64; }
  else if (slot == 60) cat = 4;

  if (cat == 1 || cat == 3) {
    unsigned short* wl = (unsigned short*)(lds + wave * 8192);
    int c0 = r, c1 = 32 + r;
    float crev = 0.f;
    if (rope == 1) crev = __builtin_amdgcn_exp2f(-(float)r * (13.287712379549449f / 32.f)) * 0.15915494309189535f;
    if (rope == 2) { int comp = r >> 4, ii = r & 15; c0 = comp * 32 + ii; c1 = comp * 32 + 16 + ii; crev = __builtin_amdgcn_exp2f(-(float)ii * (13.287712379549449f / 16.f)) * 0.15915494309189535f; }
#pragma unroll
    for (int mt = 0; mt < 2; ++mt)
#pragma unroll
      for (int i = 0; i < 16; ++i) {
        const int rowl = 32 * mt + crow(i, h);
        float v0 = acc[mt][0][i], v1 = acc[mt][1][i];
        if (cat == 3) { v0 = silu(v0); v1 = silu(v1); }
        else {
          if (rope) { const float fr = __builtin_amdgcn_fractf((float)(srow0 + rowl) * crev); const float cs = __builtin_amdgcn_cosf(fr), sn = __builtin_amdgcn_sinf(fr);
            const float y0 = v0 * cs - v1 * sn, y1 = v1 * cs + v0 * sn; v0 = y0; v1 = y1; }
          v0 *= scale; v1 *= scale;
        }
        wl[rowl * 64 + c0] = f2bf(v0); wl[rowl * 64 + c1] = f2bf(v1);
      }
    bf16_t* obase = (cat == 1) ? (dst + (size_t)srow0 * 64) : ((bf16_t*)(ws + OFF_G) + ((size_t)m0 + 64 * wm) * 1024 + gcol);
    const size_t opitch = (cat == 1) ? 64 : 1024;
#pragma unroll
    for (int k = 0; k < 8; ++k) { const int rowl = (lane >> 3) + 8 * k, ch = lane & 7;
      const u32x4 v = *(const u32x4*)((const char*)wl + rowl * 128 + ch * 16);
      *(u32x4*)(obase + (size_t)rowl * opitch + ch * 8) = v; }
  } else if (cat == 2) {
#pragma unroll
    for (int mt = 0; mt < 2; ++mt)
#pragma unroll
      for (int g = 0; g < 4; ++g) {
        int s = srow0 + 32 * mt + 8 * g + 4 * h;
#pragma unroll
        for (int nt = 0; nt < 2; ++nt) {
          u32x2 v; v.x = pk2(acc[mt][nt][4 * g], acc[mt][nt][4 * g + 1]); v.y = pk2(acc[mt][nt][4 * g + 2], acc[mt][nt][4 * g + 3]);
          *(u32x2*)(dst + (size_t)(32 * nt + r) * SEQ + s) = v;
        }
      }
  } else if (cat == 4) {
    if (r < 28) {
      float bias = (r < 4) ? P.b_fox_f[l * 4 + r] : 0.f;
#pragma unroll
      for (int mt = 0; mt < 2; ++mt)
#pragma unroll
        for (int i = 0; i < 16; ++i) {
          int s = srow0 + 32 * mt + crow(i, h);
          float v = acc[mt][0][i];
          if (r < 4) { float xx = v + bias; float ls = fminf(xx, 0.f) - log1pf(expf(-fabsf(xx)));
            ((float*)(ws + OFF_LOGF))[(size_t)(b * 4 + r) * SEQ + s] = ls * LOG2E; }
          else ((float*)(ws + OFF_GATES))[((size_t)b * SEQ + s) * 24 + (r - 4)] = sigmoidf(v);
        }
    }
  }
}

DI void p1_inproj(const Params& P, int l, char* lds) {
  const bf16_t* A = (const bf16_t*)(P.ws + OFF_XB);
  const bf16_t* Bt = (const bf16_t*)(P.ws + OFF_WIN) + (size_t)l * NPAD * DMODEL;
  const int NT = NPAD / 128;
  int mt, nt;
  for (int i = 0; xcd_tile(i, NT, mt, nt); ++i) {
    f32x16 acc[2][2];
    gemm_mainloop(A + (size_t)mt * 128 * DMODEL, DMODEL, 127, Bt + (size_t)nt * 128 * DMODEL, DMODEL, DMODEL, lds, acc);
    epi_inproj(P, l, acc, mt * 128, nt * 128, lds);
  }
}

DI void p4_outproj(const Params& P, int l, char* lds) {
  const bf16_t* A = (const bf16_t*)(P.ws + OFF_MIX);
  const bf16_t* Bt = (const bf16_t*)(P.ws + OFF_WOUT) + (size_t)l * 1024 * 1024;
  const float* xres = (l == 0) ? P.x : P.out;
  const float alpha = 1.4142135623730951f;
  const int tid = get_tid(), lane = tid & 63, wave = tid >> 6, wm = wave >> 1, wn = wave & 1, r = lane & 31, h = lane >> 5;
  int mt, nt;
  for (int i = 0; xcd_tile(i, 8, mt, nt); ++i) {
    f32x16 acc[2][2];
    gemm_mainloop(A + (size_t)mt * 128 * 1024, 1024, 127, Bt + (size_t)nt * 128 * 1024, 1024, 1024, lds, acc);
    { float* wl = (float*)(lds + wave * 16384);
#pragma unroll
      for (int a = 0; a < 2; ++a)
#pragma unroll
        for (int bb = 0; bb < 2; ++bb)
#pragma unroll
          for (int i = 0; i < 16; ++i) wl[(32 * a + crow(i, h)) * 64 + 32 * bb + r] = acc[a][bb][i];
      const size_t gbase = ((size_t)mt * 128 + 64 * wm) * 1024 + nt * 128 + 64 * wn;
#pragma unroll
      for (int k = 0; k < 16; ++k) { const int rowl = (lane >> 4) + 4 * k, ch = lane & 15;
        const f32x4 m = *(const f32x4*)(wl + rowl * 64 + ch * 4);
        const f32x4 x = *(const f32x4*)(xres + gbase + (size_t)rowl * 1024 + ch * 4);
        *(f32x4*)(P.out + gbase + (size_t)rowl * 1024 + ch * 4) = alpha * x + m; }
    }
  }
}

DI void p5_ln(const Params& P, int l) {
  const int lane = get_tid() & 63, wave = get_tid() >> 6;
  const float* g = P.ln_g + l * 1024; const float* bb = P.ln_b + l * 1024;
  for (int row = blockIdx.x * 4 + wave; row < MTOK; row += gridDim.x * 4) {
    float* p = P.out + (size_t)row * 1024;
    f32x4 v[4]; float s = 0.f;
#pragma unroll
    for (int k = 0; k < 4; ++k) { v[k] = *(const f32x4*)(p + k * 256 + lane * 4); s += v[k][0] + v[k][1] + v[k][2] + v[k][3]; }
#pragma unroll
    for (int o = 32; o >= 1; o >>= 1) s += __shfl_xor(s, o);
    float mean = s * (1.f / 1024.f); float q = 0.f;
#pragma unroll
    for (int k = 0; k < 4; ++k)
#pragma unroll
      for (int e = 0; e < 4; ++e) { float d = v[k][e] - mean; q += d * d; }
#pragma unroll
    for (int o = 32; o >= 1; o >>= 1) q += __shfl_xor(q, o);
    float rstd = rsqrtf(q * (1.f / 1024.f) + 1e-5f);
#pragma unroll
    for (int k = 0; k < 4; ++k) {
      int c = k * 256 + lane * 4; f32x4 gg = *(const f32x4*)(g + c), bv = *(const f32x4*)(bb + c); f32x4 o;
#pragma unroll
      for (int e = 0; e < 4; ++e) o[e] = (v[k][e] - mean) * rstd * gg[e] + bv[e];
      *(f32x4*)(p + c) = o;
      if (l + 1 < DEPTH) {
        u32x2 w; w.x = pk2(o[0], o[1]); w.y = pk2(o[2], o[3]);
        *(u32x2*)((bf16_t*)(P.ws + OFF_XB) + (size_t)row * 1024 + c) = w; }
    }
  }
}

enum { M_FOX = 0, M_DIFF = 1, M_CMP1 = 2, M_CMP2 = 3, M_SEL = 4, M_WIN = 5 };
struct AttnState { f32x16 o[2]; float m, l; };
struct TileSrc { const bf16_t* K; const bf16_t* Vt; long vstride; const float* C; };

template <bool HASV, bool HASC>
DI void tile_gload(const TileSrc& s, int T, u32x4 (&rk)[2], u32x4 (&rv)[2], f32x4& rc, int tid) {
#pragma unroll
  for (int p = 0; p < 2; ++p) { int id = tid + 256 * p, row = id >> 3, ch = id & 7;
    rk[p] = *(const u32x4*)(s.K + ((long)(64 * T + row)) * 64 + ch * 8);
    if (HASV) rv[p] = *(const u32x4*)(s.Vt + (long)row * s.vstride + 64 * T + ch * 8); }
  if (HASC) { if (tid < 16) rc = *(const f32x4*)(s.C + 64 * T + 4 * tid); }
}
template <bool HASV, bool HASC>
DI void tile_sstore(char* buf, const u32x4 (&rk)[2], const u32x4 (&rv)[2], const f32x4& rc, int tid) {
#pragma unroll
  for (int p = 0; p < 2; ++p) { int id = tid + 256 * p, row = id >> 3, ch = id & 7;
    *(u32x4*)(buf + row * 144 + ch * 16) = rk[p];
    if (HASV) { char* d = buf + ATT_V + row * 136 + ch * 16; u32x2 a = {rv[p].x, rv[p].y}, b = {rv[p].z, rv[p].w}; *(u32x2*)d = a; *(u32x2*)(d + 8) = b; } }
  if (HASC) { if (tid < 16) *(f32x4*)(buf + ATT_C + tid * 16) = -rc; }
}

constexpr float MREF0 = -32.f;
constexpr float RSUM = 1099511627776.f;

template <int MODE>
DI void qk_part(f32x16 (&p)[2], const bf16x8* qf, const char* buf, int koffb, const f32x16& negm, int r, int h) {
  constexpr int ND0 = (MODE == M_DIFF) ? 2 : 4;
  const char* kl = buf; const float* cl = (const float*)(buf + ATT_C);
  if (MODE == M_FOX) {
    const float nm = negm[0];
#pragma unroll
    for (int c = 0; c < 2; ++c)
#pragma unroll
      for (int g = 0; g < 4; ++g) { f32x4 ck = *(const f32x4*)(cl + 32 * c + 8 * g + 4 * h);
#pragma unroll
        for (int e = 0; e < 4; ++e) p[c][4 * g + e] = ck[e] + nm; }
  }
#pragma unroll
  for (int d0 = 0; d0 < ND0; ++d0) {
    const char* kp = kl + r * 144 + koffb + (16 * d0 + 8 * h) * 2;
    bf16x8 k0 = *(const bf16x8*)kp; bf16x8 k1 = *(const bf16x8*)(kp + 32 * 144);
    if (MODE != M_FOX && d0 == 0) { p[0] = MFMA32(k0, qf[d0], negm); p[1] = MFMA32(k1, qf[d0], negm); }
    else { p[0] = MFMA32(k0, qf[d0], p[0]); p[1] = MFMA32(k1, qf[d0], p[1]); }
  }
}

template <int MODE>
DI void sp_part(AttnState& st, f32x16 (&p)[2], f32x16& negm, const char* buf, int T, int tq, unsigned selbit,
                float inv_l, unsigned* imp_q, int r, int h) {
  const char* vl = buf + ATT_V;
  const int kvb = 64 * T + 4 * h;
  int lim, lo;
  if (MODE == M_CMP1 || MODE == M_CMP2) { lim = (tq - 31) >> 4; lo = -(1 << 30); }
  else if (MODE == M_SEL) { lim = selbit ? tq : -1; lo = -(1 << 30); }
  else if (MODE == M_WIN) { lim = tq; lo = tq - 511; }
  else { lim = tq; lo = -(1 << 30); }
  const bool full = (lim >= 64 * T + 63) && (lo <= 64 * T);
  bool lane_on = true; bool sel_interior = false;
  if (MODE == M_SEL) sel_interior = __all(tq >= 64 * T + 63) != 0;
  if (sel_interior) lane_on = (selbit != 0u);
  else if (!__all(full)) {
#pragma unroll
    for (int c = 0; c < 2; ++c)
#pragma unroll
      for (int i = 0; i < 16; ++i) { int kv = kvb + 32 * c + 8 * (i >> 2) + (i & 3); if (kv > lim || kv < lo) p[c][i] = NEGBIG; }
  }
  float tile_sum = 0.f;
  if (MODE == M_CMP2) {
#pragma unroll
    for (int c = 0; c < 2; ++c)
#pragma unroll
      for (int i = 0; i < 16; ++i) p[c][i] = ex2(p[c][i]) * inv_l;
#pragma unroll
    for (int c = 0; c < 2; ++c)
#pragma unroll
      for (int g = 0; g < 4; ++g) {
        int j = 16 * T + 8 * c + 2 * g + h;
        float bq = 0.5f * p[c][4 * g + 3]; float aq = p[c][4 * g] + p[c][4 * g + 1] + p[c][4 * g + 2] + bq;
        atomicAdd(&imp_q[j * 32], (unsigned)(aq * 4194304.f + 0.5f));
        if (j + 1 < 128) atomicAdd(&imp_q[(j + 1) * 32], (unsigned)(bq * 4194304.f + 0.5f));
      }
  } else {
    float sum = 0.f;
#pragma unroll
    for (int c = 0; c < 2; ++c)
#pragma unroll
      for (int i = 0; i < 16; ++i) { float e = ex2(p[c][i]); p[c][i] = e; sum += e; }
    if (MODE == M_SEL) sum = lane_on ? sum : 0.f;
    st.l += sum;
    tile_sum = sum;
  }
  if (MODE != M_CMP1) {
#pragma unroll
    for (int c = 0; c < 2; ++c)
#pragma unroll
      for (int s2 = 0; s2 < 2; ++s2) {
        u32x4 pw; pw.x = pk2(p[c][8 * s2], p[c][8 * s2 + 1]); pw.y = pk2(p[c][8 * s2 + 2], p[c][8 * s2 + 3]);
        pw.z = pk2(p[c][8 * s2 + 4], p[c][8 * s2 + 5]); pw.w = pk2(p[c][8 * s2 + 6], p[c][8 * s2 + 7]);
        if (MODE == M_SEL) { if (!lane_on) { pw.x = 0u; pw.y = 0u; pw.z = 0u; pw.w = 0u; } }
        bf16x8 pf = __builtin_bit_cast(bf16x8, pw);
#pragma unroll
        for (int dt = 0; dt < 2; ++dt) {
          const char* vp = vl + (32 * dt + r) * 136 + (32 * c + 16 * s2 + 4 * h) * 2;
          s16x4 lo4 = *(const s16x4*)vp; s16x4 hi4 = *(const s16x4*)(vp + 16);
          bf16x8 vf = __builtin_shufflevector(lo4, hi4, 0, 1, 2, 3, 4, 5, 6, 7);
          st.o[dt] = MFMA32(vf, pf, st.o[dt]);
        }
      }
  }
  if (MODE != M_CMP2) {
    if (__any(tile_sum > RSUM)) {
      const float tot = xhalf_sum(tile_sum);
      const float dl = (tot > RSUM) ? __builtin_amdgcn_logf(tot) : 0.f;
      st.m += dl;
      const float nm = -st.m;
#pragma unroll
      for (int i = 0; i < 16; ++i) negm[i] = nm;
      const float f = ex2(-dl);
      st.l *= f;
      if (MODE != M_CMP1) {
#pragma unroll
        for (int i = 0; i < 16; ++i) { st.o[0][i] *= f; st.o[1][i] *= f; }
      }
    }
  }
}

template <int MODE>
DI bool tile_active(int T, int twmax, int qspan, const unsigned* selmask_q) {
  bool a;
  if (MODE == M_CMP1 || MODE == M_CMP2) a = (16 * (64 * T) + 31 <= twmax);
  else a = (64 * T <= twmax);
  if (MODE == M_WIN) a = a && (64 * T + 63 >= twmax - qspan - 511);
  if (MODE == M_SEL) { if (a) a = __any((int)((selmask_q[T >> 5] >> (T & 31)) & 1u)) != 0; }
  return a;
}

template <int MODE>
DI void run_tiles(AttnState& st, const bf16x8* qf, const TileSrc& src, int T0, int T1, int tq, int twmax_, int qspan, int koffb,
                  const unsigned* selmask_q, float m_fin, float inv_l, unsigned* imp_q, char* lds, int tid, int r, int h) {
  constexpr bool HASV = (MODE != M_CMP1), HASC = (MODE == M_FOX);
  const int twmax = __builtin_amdgcn_readfirstlane(twmax_);
  const float m0 = (MODE == M_CMP2) ? m_fin : MREF0;
  u32x4 rk[2], rv[2]; f32x4 rc;
  st.m = m0;
  f32x16 negm;
#pragma unroll
  for (int i = 0; i < 16; ++i) negm[i] = -m0;
  __syncthreads();
  if (T0 < T1) { tile_gload<HASV, HASC>(src, T0, rk, rv, rc, tid); tile_sstore<HASV, HASC>(lds, rk, rv, rc, tid); }
  if (T0 + 1 < T1) tile_gload<HASV, HASC>(src, T0 + 1, rk, rv, rc, tid);
  int slot = 0;
  for (int T = T0; T < T1; ++T) {
    const char* buf = lds + slot * ATT_BUF;
    slot = (slot == 2) ? 0 : slot + 1;
    if (T + 1 < T1) tile_sstore<HASV, HASC>(lds + slot * ATT_BUF, rk, rv, rc, tid);
    if (T + 2 < T1) tile_gload<HASV, HASC>(src, T + 2, rk, rv, rc, tid);
    __syncthreads();
    if (tile_active<MODE>(T, twmax, qspan, selmask_q)) {
      unsigned selbit = 0;
      if (MODE == M_SEL) selbit = (selmask_q[T >> 5] >> (T & 31)) & 1u;
      f32x16 p[2];
      qk_part<MODE>(p, qf, buf, koffb, negm, r, h);
      sp_part<MODE>(st, p, negm, buf, T, tq, selbit, inv_l, imp_q, r, h);
    }
  }
}

DI void st_init(AttnState& st) {
#pragma unroll
  for (int i = 0; i < 16; ++i) { st.o[0][i] = 0.f; st.o[1][i] = 0.f; }
  st.m = MREF0; st.l = 0.f;
}
DI float st_invl(const AttnState& st) { float lt = xhalf_sum(st.l); return lt > 0.f ? 1.f / lt : 0.f; }

DI void store_mix(const Params& P, size_t token, int col, float a, float b, float c, float d) {
  const bf16_t* G = (const bf16_t*)(P.ws + OFF_G) + token * 1024 + col;
  u32x2 gv = *(const u32x2*)G;
  float g0 = __uint_as_float(gv.x << 16), g1 = __uint_as_float(gv.x & 0xffff0000u), g2 = __uint_as_float(gv.y << 16), g3 = __uint_as_float(gv.y & 0xffff0000u);
  u32x2 w; w.x = pk2(a * g0, b * g1); w.y = pk2(c * g2, d * g3);
  *(u32x2*)((bf16_t*)(P.ws + OFF_MIX) + token * 1024 + col) = w;
}

DI void fox_unit(const Params& P, int bh, int qt, char* lds) {
  const int tid = get_tid(), lane = tid & 63, wave = tid >> 6, r = lane & 31, h = lane >> 5;
  const int t0 = 128 * qt, tq = t0 + 32 * wave + r, twmax = t0 + 32 * wave + 31;
  const bf16_t* Q = (const bf16_t*)(P.ws + OFF_QF) + (size_t)bh * SEQ * 64;
  TileSrc src; src.K = (const bf16_t*)(P.ws + OFF_KF) + (size_t)bh * SEQ * 64; src.Vt = (const bf16_t*)(P.ws + OFF_VFT) + (size_t)bh * SEQ * 64; src.vstride = SEQ;
  src.C = (const float*)(P.ws + OFF_CUM) + (size_t)bh * SEQ;
  bf16x8 qf[4];
#pragma unroll
  for (int d0 = 0; d0 < 4; ++d0) qf[d0] = *(const bf16x8*)(Q + (size_t)tq * 64 + 16 * d0 + 8 * h);
  AttnState st; st_init(st);
  run_tiles<M_FOX>(st, qf, src, 0, 2 * qt + 2, tq, twmax, 31, 0, nullptr, 0.f, 0.f, nullptr, lds, tid, r, h);
  const float inv = st_invl(st);
  const size_t token = (size_t)(bh >> 2) * SEQ + tq; const int hd = bh & 3;
#pragma unroll
  for (int dt = 0; dt < 2; ++dt)
#pragma unroll
    for (int g = 0; g < 4; ++g)
      store_mix(P, token, hd * 64 + 32 * dt + 8 * g + 4 * h, st.o[dt][4 * g] * inv, st.o[dt][4 * g + 1] * inv, st.o[dt][4 * g + 2] * inv, st.o[dt][4 * g + 3] * inv);
}

DI void diff_unit(const Params& P, int l, int bh, int qt, char* lds) {
  const int tid = get_tid(), lane = tid & 63, wave = tid >> 6, r = lane & 31, h = lane >> 5;
  const int comp = wave & 1, qs = wave >> 1;
  const int t0 = 64 * qt, tq = t0 + 32 * qs + r, twmax = t0 + 32 * qs + 31;
  const bf16_t* Q = (const bf16_t*)(P.ws + OFF_QD) + (size_t)bh * SEQ * 64;
  TileSrc src; src.K = (const bf16_t*)(P.ws + OFF_KD) + (size_t)bh * SEQ * 64; src.Vt = (const bf16_t*)(P.ws + OFF_VDT) + (size_t)bh * SEQ * 64; src.vstride = SEQ; src.C = nullptr;
  bf16x8 qf[2];
#pragma unroll
  for (int d0 = 0; d0 < 2; ++d0) qf[d0] = *(const bf16x8*)(Q + (size_t)tq * 64 + comp * 32 + 16 * d0 + 8 * h);
  AttnState st; st_init(st);
  run_tiles<M_DIFF>(st, qf, src, 0, qt + 1, tq, twmax, 31, comp * 64, nullptr, 0.f, 0.f, nullptr, lds, tid, r, h);
  const float inv = st_invl(st);
  float* exch = (float*)(lds + LDS_IMP);
  __syncthreads();
  if (comp == 1) {
#pragma unroll
    for (int dt = 0; dt < 2; ++dt)
#pragma unroll
      for (int i = 0; i < 16; ++i) exch[(qs * 64 + 32 * dt + crow(i, h)) * 32 + r] = st.o[dt][i] * inv;
  }
  __syncthreads();
  if (comp == 0) {
    const float lam = ((const float*)(P.ws + OFF_LAM))[l], lam_init = ((const float*)(P.ws + OFF_LAM))[2 + l];
    float ss = 0.f;
#pragma unroll
    for (int dt = 0; dt < 2; ++dt)
#pragma unroll
      for (int i = 0; i < 16; ++i) { float a = st.o[dt][i] * inv - lam * exch[(qs * 64 + 32 * dt + crow(i, h)) * 32 + r]; st.o[dt][i] = a; ss += a * a; }
    ss = xhalf_sum(ss);
    const float rms = rsqrtf(ss * (1.f / 64.f) + 1e-5f) * (1.f - lam_init);
    const size_t token = (size_t)(bh >> 2) * SEQ + tq; const int hd = bh & 3;
    const float* sg = P.subln_g + l * 64;
#pragma unroll
    for (int dt = 0; dt < 2; ++dt)
#pragma unroll
      for (int g = 0; g < 4; ++g) { int d = 32 * dt + 8 * g + 4 * h; f32x4 gg = *(const f32x4*)(sg + d);
        store_mix(P, token, 768 + hd * 64 + d, st.o[dt][4 * g] * rms * gg[0], st.o[dt][4 * g + 1] * rms * gg[1], st.o[dt][4 * g + 2] * rms * gg[2], st.o[dt][4 * g + 3] * rms * gg[3]); }
  }
}

DI void nsa_unit(const Params& P, int bg, int qt, char* lds) {
  const int tid = get_tid(), lane = tid & 63, wave = tid >> 6, r = lane & 31, h = lane >> 5;
  const int b = bg >> 1, g2 = bg & 1, head8 = g2 * 4 + (r & 3);
  const int t0 = 32 * qt, ql = 8 * wave + (r >> 2), tq = t0 + ql, tmax = t0 + 31, twmax = t0 + 8 * wave + 7;
  const bf16_t* Q = (const bf16_t*)(P.ws + OFF_QN) + (size_t)(b * 8 + head8) * SEQ * 64;
  bf16x8 qf[4];
#pragma unroll
  for (int d0 = 0; d0 < 4; ++d0) qf[d0] = *(const bf16x8*)(Q + (size_t)tq * 64 + 16 * d0 + 8 * h);
  unsigned* imp = (unsigned*)(lds + LDS_IMP);
  unsigned* selm = (unsigned*)(lds + LDS_SEL);
#pragma unroll
  for (int k = 0; k < 16; ++k) imp[tid + 256 * k] = 0u;
  const float* gates = (const float*)(P.ws + OFF_GATES) + ((size_t)b * SEQ + tq) * 24 + 3 * head8;
  const float gc = gates[0], gs = gates[1], gw = gates[2];
  unsigned* stash = (unsigned*)(lds + LDS_IMP) + wave * 16 * 64 + lane;
  TileSrc src; src.K = (const bf16_t*)(P.ws + OFF_KC) + (size_t)bg * 512 * 64; src.Vt = (const bf16_t*)(P.ws + OFF_VCC) + (size_t)bg * 64 * 512; src.vstride = 512; src.C = nullptr;
  int nvis = (t0 >> 4) + 1; if (nvis > 511) nvis = 511;
  const int ntc = (nvis + 63) >> 6;
  AttnState st; st_init(st);
  run_tiles<M_CMP1>(st, qf, src, 0, ntc, tq, twmax, 7, 0, nullptr, 0.f, 0.f, nullptr, lds, tid, r, h);
  {
    const float m_fin = st.m, inv_l = st_invl(st);
    st_init(st);
    run_tiles<M_CMP2>(st, qf, src, 0, ntc, tq, twmax, 7, 0, nullptr, m_fin, inv_l, imp + ql, lds, tid, r, h);
  }
  __syncthreads();
  {
    const int q = tid >> 3, jg = tid & 7; const int t = t0 + q, cur = t >> 6;
    unsigned key[16];
#pragma unroll
    for (int e = 0; e < 16; ++e) { int j = 16 * jg + e; unsigned v = imp[j * 32 + q];
      bool valid = j <= cur, forced = (j == 0) || (j == cur) || (j == cur - 1);
      key[e] = !valid ? 0u : (forced ? (0xFFFFFF80u | (unsigned)(127 - j)) : ((v << 7) | (unsigned)(127 - j))); }
    unsigned sel = 0;
    for (int round = 0; round < 16; ++round) {
      unsigned m = key[0];
#pragma unroll
      for (int e = 1; e < 16; ++e) m = m > key[e] ? m : key[e];
      unsigned o;
      o = __shfl_xor(m, 1); m = m > o ? m : o; o = __shfl_xor(m, 2); m = m > o ? m : o; o = __shfl_xor(m, 4); m = m > o ? m : o;
      if (m != 0u) {
#pragma unroll
        for (int e = 0; e < 16; ++e) if (key[e] == m) { sel |= 1u << e; key[e] = 0u; }
      }
    }
    ((unsigned short*)selm)[q * 8 + jg] = (unsigned short)sel;
  }
  __syncthreads();
#pragma unroll
  for (int i = 0; i < 8; ++i) { stash[i * 64] = pk2(gc * st.o[0][2 * i], gc * st.o[0][2 * i + 1]); stash[(8 + i) * 64] = pk2(gc * st.o[1][2 * i], gc * st.o[1][2 * i + 1]); }
  src.K = (const bf16_t*)(P.ws + OFF_KS) + (size_t)bg * SEQ * 64; src.Vt = (const bf16_t*)(P.ws + OFF_VST) + (size_t)bg * SEQ * 64; src.vstride = SEQ;
  st_init(st);
  run_tiles<M_SEL>(st, qf, src, 0, (tmax >> 6) + 1, tq, twmax, 7, 0, selm + ql * 4, 0.f, 0.f, nullptr, lds, tid, r, h);
  { const float inv = st_invl(st) * gs;
#pragma unroll
    for (int i = 0; i < 8; ++i) { unsigned a = stash[i * 64], bq = stash[(8 + i) * 64];
      stash[i * 64] = pk2(__uint_as_float(a << 16) + inv * st.o[0][2 * i], __uint_as_float(a & 0xffff0000u) + inv * st.o[0][2 * i + 1]);
      stash[(8 + i) * 64] = pk2(__uint_as_float(bq << 16) + inv * st.o[1][2 * i], __uint_as_float(bq & 0xffff0000u) + inv * st.o[1][2 * i + 1]); } }
  src.K = (const bf16_t*)(P.ws + OFF_KW) + (size_t)bg * SEQ * 64; src.Vt = (const bf16_t*)(P.ws + OFF_VWT) + (size_t)bg * SEQ * 64;
  st_init(st);
  { int lo_t = t0 - 511; int T0 = lo_t > 0 ? (lo_t >> 6) : 0;
    run_tiles<M_WIN>(st, qf, src, T0, (tmax >> 6) + 1, tq, twmax, 7, 0, nullptr, 0.f, 0.f, nullptr, lds, tid, r, h); }
  { const float inv = st_invl(st) * gw;
#pragma unroll
    for (int i = 0; i < 8; ++i) { unsigned a = stash[i * 64], bq = stash[(8 + i) * 64];
      st.o[0][2 * i] = __uint_as_float(a << 16) + inv * st.o[0][2 * i]; st.o[0][2 * i + 1] = __uint_as_float(a & 0xffff0000u) + inv * st.o[0][2 * i + 1];
      st.o[1][2 * i] = __uint_as_float(bq << 16) + inv * st.o[1][2 * i]; st.o[1][2 * i + 1] = __uint_as_float(bq & 0xffff0000u) + inv * st.o[1][2 * i + 1]; } }
  const size_t token = (size_t)b * SEQ + tq;
#pragma unroll
  for (int dt = 0; dt < 2; ++dt)
#pragma unroll
    for (int g = 0; g < 4; ++g)
      store_mix(P, token, 256 + head8 * 64 + 32 * dt + 8 * g + 4 * h, st.o[dt][4 * g], st.o[dt][4 * g + 1], st.o[dt][4 * g + 2], st.o[dt][4 * g + 3]);
}

DI void compress_tile(const Params& P, int l, int id, char* lds) {
  const int tid = get_tid(), lane = tid & 63, wave = tid >> 6, wm = wave >> 1, wn = wave & 1, r = lane & 31, h = lane >> 5;
  const int kv = id >> 4, bg = (id >> 2) & 3, mt = id & 3;
  const bf16_t* tok = (const bf16_t*)(P.ws + (kv ? OFF_VCT : OFF_KCT)) + (size_t)bg * SEQ * 64;
  const bf16_t* Bt = (const bf16_t*)(P.ws + OFF_W1T) + ((size_t)l * 2 + kv) * 128 * 2048;
  f32x16 acc[2][2];
  int rowmax = 510 - 128 * mt; if (rowmax > 127) rowmax = 127;
  gemm_mainloop(tok + (size_t)mt * 128 * 1024, 1024, rowmax, Bt, 2048, 2048, lds, acc);
  __syncthreads();
  float* H = (float*)lds;
  const float* bias = (const float*)(P.ws + OFF_B1) + (l * 2 + kv) * 128;
#pragma unroll
  for (int a = 0; a < 2; ++a)
#pragma unroll
    for (int bb = 0; bb < 2; ++bb) { int col = 64 * wn + 32 * bb + r; float bv = bias[col];
#pragma unroll
      for (int i = 0; i < 16; ++i) { int row = 64 * wm + 32 * a + crow(i, h); H[row * 129 + col] = silu(acc[a][bb][i] + bv); } }
  __syncthreads();
  const float* w2 = (kv ? P.w2_v : P.w2_k) + (size_t)l * 128 * 64;
  const int c = tid & 63, rg = tid >> 6;
  float o[32];
#pragma unroll
  for (int i = 0; i < 32; ++i) o[i] = 0.f;
  for (int j = 0; j < 128; ++j) { float w = w2[j * 64 + c];
#pragma unroll
    for (int i = 0; i < 32; ++i) o[i] += H[(rg * 32 + i) * 129 + j] * w; }
  if (kv == 0) { bf16_t* dst = (bf16_t*)(P.ws + OFF_KC) + (size_t)bg * 512 * 64;
#pragma unroll
    for (int i = 0; i < 32; ++i) { int n = 128 * mt + rg * 32 + i; dst[(size_t)n * 64 + c] = f2bf(o[i]); } }
  else { bf16_t* dst = (bf16_t*)(P.ws + OFF_VCC) + (size_t)bg * 64 * 512;
#pragma unroll
    for (int i = 0; i < 32; ++i) { int n = 128 * mt + rg * 32 + i; dst[(size_t)c * 512 + n] = f2bf(o[i]); } }
  __syncthreads();
}

DI void cumsum_seq(const Params& P, int bh, char* lds) {
  const int tid = get_tid();
  const float* src = (const float*)(P.ws + OFF_LOGF) + (size_t)bh * SEQ + tid * 32;
  float* dst = (float*)(P.ws + OFF_CUM) + (size_t)bh * SEQ + tid * 32;
  float* tot = (float*)lds;
  f32x4 v[8]; float s = 0.f;
#pragma unroll
  for (int k = 0; k < 8; ++k) { v[k] = *(const f32x4*)(src + 4 * k);
#pragma unroll
    for (int e = 0; e < 4; ++e) { s += v[k][e]; v[k][e] = s; } }
  __syncthreads();
  tot[tid] = s;
  __syncthreads();
  float base = 0.f;
  for (int i = 0; i < tid; ++i) base += tot[i];
#pragma unroll
  for (int k = 0; k < 8; ++k) { f32x4 o;
#pragma unroll
    for (int e = 0; e < 4; ++e) o[e] = v[k][e] + base;
    *(f32x4*)(dst + 4 * k) = o; }
  __syncthreads();
}

DI int next_unit(unsigned* ctr, int* s_unit) {
  __syncthreads();
  if (get_tid() == 0) *s_unit = (int)atomicAdd(ctr, 1u);
  __syncthreads();
  return *s_unit;
}

DI void p23_phase(const Params& P, int l, char* lds, int* s_unit, int rep = 0) {
  unsigned* ctr = (unsigned*)(P.ws + OFF_CTR) + (l * 4 + 0 + 16 * rep);
  unsigned* done = (unsigned*)(P.ws + OFF_CTR) + (40 + l + 4 * rep);
  bool acquired = false;
  for (;;) {
    int u = next_unit(ctr, s_unit);
    if (u >= 40 + 1024 + 512 + 1024) break;
    if (u < 40) {
      if (u < 32) compress_tile(P, l, u, lds); else cumsum_seq(P, u - 32, lds);
      asm volatile("s_waitcnt vmcnt(0)" ::: "memory");
      __syncthreads();
      if (get_tid() == 0) { __builtin_amdgcn_fence(__ATOMIC_RELEASE, "agent"); asm volatile("s_waitcnt vmcnt(0)" ::: "memory");
        __hip_atomic_fetch_add(done, 1u, __ATOMIC_RELAXED, __HIP_MEMORY_SCOPE_AGENT); }
    } else if (u < 40 + 1024) { int v = u - 40; diff_unit(P, l, v & 7, 127 - (v >> 3), lds); }
    else {
      if (!acquired) {
        if (get_tid() == 0) {
          unsigned sp = 0;
          while (__hip_atomic_load(done, __ATOMIC_RELAXED, __HIP_MEMORY_SCOPE_AGENT) < 40u) { __builtin_amdgcn_s_sleep(4); if (++sp > (1u << 24)) break; }
          __builtin_amdgcn_fence(__ATOMIC_ACQUIRE, "agent"); asm volatile("s_waitcnt vmcnt(0)" ::: "memory");
        }
        __syncthreads();
        acquired = true;
      }
      const int w = u - (40 + 1024);
      if (w < 384) fox_unit(P, w & 7, 63 - (w >> 3), lds);
      else if (w < 384 + 1024) { int v = w - 384; nsa_unit(P, v & 3, 255 - (v >> 2), lds); }
      else { int v = w - (384 + 1024); fox_unit(P, v & 7, 15 - (v >> 3), lds); }
    }
  }
}

template <int KIND> DI void run_phase(const Params& P, int l, char* lds, int* s_unit, int rep = 0) {
  if constexpr (KIND == 0) p0_prologue(P);
  else if constexpr (KIND == 1) p1_inproj(P, l, lds);
  else if constexpr (KIND == 2) p23_phase(P, l, lds, s_unit, rep);
  else if constexpr (KIND == 3) { }
  else if constexpr (KIND == 4) p4_outproj(P, l, lds);
  else p5_ln(P, l);
}
template <int KIND> __global__ void __launch_bounds__(NTHREADS, 2) phase_kernel(Params P, int l) {
  __shared__ __attribute__((aligned(16))) char lds[LDS_BYTES + LDS_CTL];
  run_phase<KIND>(P, l, lds, (int*)(lds + LDS_BYTES));
}
#if COOP
#define GSYNC() do { asm volatile("" ::: "memory"); cg::this_grid().sync(); asm volatile("" ::: "memory"); } while (0)
#define XB_TMO      128
#define XB_XCNT(j)  (256  + 64 * (j))
#define XB_XSUB(j)  (1280 + 64 * (j))
#define XB_XGEN(j)  (2304 + 64 * (j))
#define XB_TOP      3328
#define XB_TOPGEN   3392
#define XCD_BAR_WORDS 3456
#define XB_SPIN_CAP (1u << 22)
#define LAS __attribute__((address_space(3)))
DI unsigned xb_ld(unsigned* p) { return __hip_atomic_load(p, __ATOMIC_RELAXED, __HIP_MEMORY_SCOPE_AGENT); }
DI unsigned xb_add(unsigned* p, unsigned v) { return __hip_atomic_fetch_add(p, v, __ATOMIC_RELAXED, __HIP_MEMORY_SCOPE_AGENT); }
DI unsigned xb_xcc_id() { return (unsigned)__builtin_amdgcn_s_getreg((3 << 11) | 20) & 0xFu; }
#define XB_SPIN(cond, bar) do { unsigned _sp = 0; while (cond) { __builtin_amdgcn_s_sleep(1); \
    if ((++_sp & 255u) == 0u) { if (xb_ld(&(bar)[XB_TMO])) break; if (_sp > XB_SPIN_CAP) { atomicAdd(&(bar)[XB_TMO], 1u); break; } } } } while (0)
struct XcdBarrier { unsigned* bar; unsigned x; volatile LAS unsigned* st; };
DI XcdBarrier xcd_barrier_post(unsigned* bar, volatile LAS unsigned* st) {
  XcdBarrier b; b.bar = bar; b.x = xb_xcc_id(); b.st = st;
  if (threadIdx.x == 0) (void)xb_add(&bar[XB_XCNT(b.x)], 1u);
  return b;
}
DI void xcd_barrier_complete(unsigned* bar, unsigned x, unsigned& nloc, unsigned& nx) {
  const unsigned G = gridDim.x * gridDim.y * gridDim.z;
  unsigned sum, cnt, mine, sp = 0u;
  for (;;) {
    sum = 0u; cnt = 0u; mine = 0u;
#pragma unroll
    for (unsigned j = 0; j < 16; ++j) { const unsigned c = xb_ld(&bar[XB_XCNT(j)]); sum += c; cnt += (c > 0u) ? 1u : 0u; mine = (j == x) ? c : mine; }
    if (sum == G) break;
    __builtin_amdgcn_s_sleep(1);
    if ((++sp & 255u) == 0u) { if (xb_ld(&bar[XB_TMO])) break; if (sp > XB_SPIN_CAP) { atomicAdd(&bar[XB_TMO], 1u); break; } }
  }
  nloc = mine > 0u ? mine : 1u; nx = cnt > 0u ? cnt : 1u;
}
DI void xcd_barrier(const XcdBarrier& b) {
  asm volatile("s_waitcnt vmcnt(0)" ::: "memory");
  __syncthreads();
  if (threadIdx.x == 0) {
    unsigned* bar = b.bar;
    __builtin_amdgcn_s_waitcnt(0);
    unsigned nloc = b.st[0], nx = b.st[1];
    if (nloc == 0u) { xcd_barrier_complete(bar, b.x, nloc, nx); b.st[0] = nloc; b.st[1] = nx; }
    const unsigned old = xb_add(&bar[XB_XSUB(b.x)], 1u);
    const unsigned gen = old / nloc;
    if (old + 1u == (gen + 1u) * nloc) {
      __builtin_amdgcn_fence(__ATOMIC_RELEASE, "agent");
      asm volatile("s_waitcnt vmcnt(0)" ::: "memory");
      const unsigned og = xb_add(&bar[XB_TOP], 1u);
      const unsigned tg = og / nx;
      if (og + 1u == (tg + 1u) * nx) xb_add(&bar[XB_TOPGEN], 1u);
      else XB_SPIN(xb_ld(&bar[XB_TOPGEN]) == tg, bar);
      __builtin_amdgcn_fence(__ATOMIC_ACQUIRE, "agent");
      xb_add(&bar[XB_XGEN(b.x)], 1u);
      asm volatile("s_waitcnt vmcnt(0)" ::: "memory");
    } else {
      XB_SPIN(xb_ld(&bar[XB_XGEN(b.x)]) == gen, bar);
      __builtin_amdgcn_fence(__ATOMIC_ACQUIRE, "agent");
      asm volatile("s_waitcnt vmcnt(0)" ::: "memory");
    }
  }
  __syncthreads();
}
#ifndef CG_ALL
#define BSYNC() do { asm volatile("" ::: "memory"); xcd_barrier(xb); asm volatile("" ::: "memory"); } while (0)
#else
#define BSYNC() GSYNC()
#endif
__global__ void __launch_bounds__(NTHREADS, 2) fwd_kernel(Params P) {
  __shared__ __attribute__((aligned(16))) char lds[LDS_BYTES + LDS_CTL];
  int* const s_unit_p = (int*)(lds + LDS_BYTES);
  if (threadIdx.x == 0) *(uint4*)(lds + LDS_BYTES + 16) = make_uint4(0u, 0u, 0u, 0u);
  __syncthreads();
  const XcdBarrier xb = xcd_barrier_post((unsigned*)(P.ws + OFF_BAR), (volatile LAS unsigned*)(lds + LDS_BYTES + 16));
  if (P.pad_ == 0x5eed) GSYNC();
  run_phase<0>(P, 0, lds, s_unit_p); BSYNC();
  for (int l = 0; l < DEPTH; ++l) {
    run_phase<1>(P, l, lds, s_unit_p); BSYNC();
#if REPEAT == 1
    run_phase<1>(P, l, lds, s_unit_p, 1); BSYNC();
#endif
    run_phase<2>(P, l, lds, s_unit_p); BSYNC();
    run_phase<4>(P, l, lds, s_unit_p); BSYNC();
    run_phase<5>(P, l, lds, s_unit_p); if (l + 1 < DEPTH) BSYNC();
  }
}
#endif

extern "C" void kernel_launch(void* const* d_in, const int* in_sizes, int n_in, void* d_out, int out_size, void* d_ws, size_t ws_size, hipStream_t stream) {
  static int grid_blocks = 0;
  if (!grid_blocks) {
    int dev = 0, cus = 0, per_cu = 0;
    (void)hipGetDevice(&dev);
    (void)hipDeviceGetAttribute(&cus, hipDeviceAttributeMultiprocessorCount, dev);
#if COOP
    (void)hipOccupancyMaxActiveBlocksPerMultiprocessor(&per_cu, fwd_kernel, NTHREADS, 0);
#else
    per_cu = 2;
#endif
    if (per_cu < 1) per_cu = 1;
    if (per_cu > 2) per_cu = 2;
    if (cus < 1) cus = 256;
    grid_blocks = cus * per_cu;
  }
  if (n_in != 17 || ws_size < WS_NEED) { fprintf(stderr, "kernel_launch: unexpected inputs (%d) or workspace (%zu)\n", n_in, ws_size); return; }
  Params p{};
  p.x = (const float*)d_in[0]; p.w_in = (const float*)d_in[1]; p.b_fox_f = (const float*)d_in[2]; p.pos_k = (const float*)d_in[3]; p.pos_v = (const float*)d_in[4];
  p.w1_k = (const float*)d_in[5]; p.w2_k = (const float*)d_in[6]; p.w1_v = (const float*)d_in[7]; p.w2_v = (const float*)d_in[8];
  p.lq1 = (const float*)d_in[9]; p.lk1 = (const float*)d_in[10]; p.lq2 = (const float*)d_in[11]; p.lk2 = (const float*)d_in[12];
  p.subln_g = (const float*)d_in[13]; p.w_out = (const float*)d_in[14]; p.ln_g = (const float*)d_in[15]; p.ln_b = (const float*)d_in[16];
  p.out = (float*)d_out; p.ws = (char*)d_ws;
  (void)hipMemsetAsync((char*)d_ws + OFF_CTR, 0, 4096, stream);
  (void)hipMemsetAsync((char*)d_ws + OFF_BAR, 0, CTL_ZERO_BYTES - OFF_BAR, stream);
#if COOP
  void* args[] = {&p};
  hipError_t e = hipLaunchCooperativeKernel((void*)fwd_kernel, dim3(grid_blocks), dim3(NTHREADS), args, 0, stream);
  if (e != hipSuccess) fprintf(stderr, "cooperative launch failed: %s (grid %d)\n", hipGetErrorString(e), grid_blocks);
#else
  const dim3 g(grid_blocks), b(NTHREADS);
  hipLaunchKernelGGL(phase_kernel<0>, g, b, 0, stream, p, 0);
  for (int l = 0; l < DEPTH; ++l) {
    hipLaunchKernelGGL(phase_kernel<1>, g, b, 0, stream, p, l);
    hipLaunchKernelGGL(phase_kernel<2>, g, b, 0, stream, p, l);
    hipLaunchKernelGGL(phase_kernel<4>, g, b, 0, stream, p, l);
    hipLaunchKernelGGL(phase_kernel<5>, g, b, 0, stream, p, l);
  }
#endif
}
```

```cpp
#include <hip/hip_runtime.h>
#include <hip/hip_cooperative_groups.h>
#include <stdint.h>
#include <cstdio>
namespace cg = cooperative_groups;

#ifndef COOP
#define COOP 1
#endif
#ifndef REPEAT
#define REPEAT 0
#endif

#define DI __device__ __forceinline__
typedef unsigned short bf16_t;
typedef short bf16x8 __attribute__((ext_vector_type(8)));
typedef short s16x4 __attribute__((ext_vector_type(4)));
typedef float f32x16 __attribute__((ext_vector_type(16)));
typedef float f32x4 __attribute__((ext_vector_type(4)));
typedef float f32x2 __attribute__((ext_vector_type(2)));
typedef unsigned u32x4 __attribute__((ext_vector_type(4)));
typedef unsigned u32x2 __attribute__((ext_vector_type(2)));
typedef __bf16 bf16x2_t __attribute__((ext_vector_type(2)));

#define MFMA32(a, b, c) __builtin_amdgcn_mfma_f32_32x32x16_bf16((a), (b), (c), 0, 0, 0)

constexpr int BATCH = 2, SEQ = 8192, DMODEL = 1024, MTOK = BATCH * SEQ, NIN = 3868, NPAD = 3968, DEPTH = 2;
constexpr float LOG2E = 1.4426950408889634f;
constexpr float NEGBIG = -1e30f;
constexpr float MINIT = -1e20f;
constexpr int NTHREADS = 256;

constexpr size_t MiB = 1u << 20;
constexpr size_t OFF_CTR = 0, OFF_LAM = 4096, OFF_B1 = 8192, OFF_BAR = 16384, CTL_ZERO_BYTES = 32768;
constexpr size_t OFF_ROPE64 = 1 * MiB, OFF_ROPE32 = 3 * MiB, OFF_WIN = 4 * MiB, OFF_WOUT = 20 * MiB, OFF_W1T = 24 * MiB;
constexpr size_t OFF_XB = 26 * MiB, OFF_G = 58 * MiB, OFF_MIX = 90 * MiB;
constexpr size_t OFF_QF = 122 * MiB, OFF_KF = 130 * MiB, OFF_VFT = 138 * MiB, OFF_QN = 146 * MiB;
constexpr size_t OFF_KCT = 162 * MiB, OFF_VCT = 166 * MiB, OFF_KS = 170 * MiB, OFF_VST = 174 * MiB, OFF_KW = 178 * MiB, OFF_VWT = 182 * MiB;
constexpr size_t OFF_QD = 186 * MiB, OFF_KD = 194 * MiB, OFF_VDT = 202 * MiB;
constexpr size_t OFF_LOGF = 210 * MiB, OFF_CUM = 210 * MiB + 256 * 1024, OFF_GATES = 211 * MiB;
constexpr size_t OFF_KC = 213 * MiB, OFF_VCC = 213 * MiB + 256 * 1024, WS_NEED = 214 * MiB;

constexpr int LDS_BYTES = 73728, LDS_CTL = 32;
constexpr int ATT_BUF = 18944, ATT_V = 9216, ATT_C = 18432;
constexpr int LDS_IMP = 3 * ATT_BUF, LDS_SEL = LDS_BYTES - 512;
static_assert(LDS_IMP + 16384 <= LDS_SEL, "LDS map");
constexpr int GEMM_AB = 18432;

struct Params {
  const float *x, *w_in, *b_fox_f, *pos_k, *pos_v, *w1_k, *w2_k, *w1_v, *w2_v, *lq1, *lk1, *lq2, *lk2, *subln_g, *w_out, *ln_g, *ln_b;
  float* out;
  char* ws;
  long pad_;
};

DI unsigned short f2bf(float f) { unsigned u = __float_as_uint(f); return (unsigned short)((u + 0x7fffu + ((u >> 16) & 1u)) >> 16); }
DI unsigned pk2(float lo, float hi) { f32x2 v = {lo, hi}; bf16x2_t b = __builtin_convertvector(v, bf16x2_t); return __builtin_bit_cast(unsigned, b); }
DI float silu(float x) { return x / (1.f + __expf(-x)); }
DI float sigmoidf(float x) { return 1.f / (1.f + __expf(-x)); }
DI float ex2(float x) { return __builtin_amdgcn_exp2f(x); }
DI float xhalf_max(float v) { auto rr = __builtin_amdgcn_permlane32_swap(__float_as_uint(v), __float_as_uint(v), false, false); return fmaxf(__uint_as_float(rr[0]), __uint_as_float(rr[1])); }
DI float xhalf_sum(float v) { auto rr = __builtin_amdgcn_permlane32_swap(__float_as_uint(v), __float_as_uint(v), false, false); return __uint_as_float(rr[0]) + __uint_as_float(rr[1]); }
DI int crow(int i, int h) { return (i & 3) + 8 * (i >> 2) + 4 * h; }

DI int get_tid() { int t = threadIdx.x; asm volatile("" : "+v"(t)); return t; }
DI int orig_col(int n) {
  int s = n >> 6, c = n & 63;
  if (s < 4) return s * 64 + c;
  if (s < 8) return 256 + (s - 4) * 64 + c;
  if (s < 12) return 512 + (s - 8) * 64 + c;
  if (s < 16) return 772 + (s - 12) * 64 + c;
  if (s < 24) return 1028 + (s - 16) * 64 + c;
  if (s < 36) return 1540 + (s - 24) * 64 + c;
  if (s < 44) return 2332 + (s - 36) * 64 + c;
  if (s < 52) { int base = 2844 + (s - 44) * 64; int nt = c >> 5, r = c & 31, comp = r >> 4, i = r & 15; return base + comp * 32 + nt * 16 + i; }
  if (s < 60) return 3356 + (s - 52) * 64 + c;
  if (s == 60) { if (c < 4) return 768 + c; if (c < 28) return 2308 + (c - 4); return -1; }
  return -1;
}

DI void p0_prologue(const Params& P) {
  const long gtid = (long)blockIdx.x * NTHREADS + get_tid(), gsz = (long)gridDim.x * NTHREADS;
  char* ws = P.ws;
  if (gtid < DEPTH) {
    int l = (int)gtid; float a = 0.f, b = 0.f;
    for (int i = 0; i < 32; ++i) { a += P.lq1[l * 32 + i] * P.lk1[l * 32 + i]; b += P.lq2[l * 32 + i] * P.lk2[l * 32 + i]; }
    float lam_init = 0.8f - 0.6f * expf(-0.3f * (float)l);
    ((float*)(ws + OFF_LAM))[l] = expf(a) - expf(b) + lam_init;
    ((float*)(ws + OFF_LAM))[2 + l] = lam_init;
  }
  if (gtid < DEPTH * 2 * 128 * 16) {
    const int it = (int)(gtid >> 4), part = (int)(gtid & 15);
    const int j = it & 127, kv = (it >> 7) & 1, l = it >> 8;
    const float* pos = (kv ? P.pos_v : P.pos_k) + (size_t)l * 2048 + part * 128;
    const float* w1 = (kv ? P.w1_v : P.w1_k) + (size_t)l * 2048 * 128 + (size_t)part * 128 * 128 + j;
    float a = 0.f;
#pragma unroll 16
    for (int k = 0; k < 128; ++k) a += pos[k] * w1[(size_t)k * 128];
    a += __shfl_xor(a, 1); a += __shfl_xor(a, 2); a += __shfl_xor(a, 4); a += __shfl_xor(a, 8);
    if (part == 0) ((float*)(ws + OFF_B1))[it] = a;
  }
  { const long NIT = (long)DEPTH * 128 * NPAD;
    for (long it0 = gtid; it0 < NIT; it0 += 2 * gsz) {
      float f[2][8]; int ocs[2]; size_t dsto[2]; bool ok[2];
#pragma unroll
      for (int q = 0; q < 2; ++q) { const long it = it0 + q * gsz; ok[q] = it < NIT; const long itc = ok[q] ? it : it0;
        const int n = (int)(itc % NPAD); const int k8 = (int)((itc / NPAD) & 127); const int l = (int)(itc / ((long)NPAD * 128));
        ocs[q] = orig_col(n); dsto[q] = ((size_t)l * NPAD + n) * DMODEL + k8 * 8;
        const float* src = P.w_in + (size_t)l * DMODEL * NIN + (size_t)(k8 * 8) * NIN + (ocs[q] >= 0 ? ocs[q] : 0);
#pragma unroll
        for (int j = 0; j < 8; ++j) f[q][j] = src[(size_t)j * NIN]; }
#pragma unroll
      for (int q = 0; q < 2; ++q) if (ok[q]) { u32x4 v = {0u, 0u, 0u, 0u};
        if (ocs[q] >= 0) { v.x = pk2(f[q][0], f[q][1]); v.y = pk2(f[q][2], f[q][3]); v.z = pk2(f[q][4], f[q][5]); v.w = pk2(f[q][6], f[q][7]); }
        *(u32x4*)((bf16_t*)(ws + OFF_WIN) + dsto[q]) = v; }
    } }
  for (long it = gtid; it < (long)DEPTH * 128 * 1024; it += gsz) {
    int n = (int)(it & 1023); int k8 = (int)((it >> 10) & 127); int l = (int)(it >> 17);
    const float* src = P.w_out + (size_t)l * 1024 * 1024 + (size_t)(k8 * 8) * 1024 + n;
    float f[8];
#pragma unroll
    for (int j = 0; j < 8; ++j) f[j] = src[(size_t)j * 1024];
    u32x4 v; v.x = pk2(f[0], f[1]); v.y = pk2(f[2], f[3]); v.z = pk2(f[4], f[5]); v.w = pk2(f[6], f[7]);
    *(u32x4*)((bf16_t*)(ws + OFF_WOUT) + ((size_t)l * 1024 + n) * 1024 + k8 * 8) = v;
  }
  for (long it = gtid; it < (long)DEPTH * 2 * 256 * 128; it += gsz) {
    int j = (int)(it & 127); int k8 = (int)((it >> 7) & 255); int kv = (int)((it >> 15) & 1); int l = (int)(it >> 16);
    const float* src = (kv ? P.w1_v : P.w1_k) + (size_t)l * 2048 * 128 + (size_t)(k8 * 8) * 128 + j;
    float f[8];
#pragma unroll
    for (int jj = 0; jj < 8; ++jj) f[jj] = src[(size_t)jj * 128];
    u32x4 v; v.x = pk2(f[0], f[1]); v.y = pk2(f[2], f[3]); v.z = pk2(f[4], f[5]); v.w = pk2(f[6], f[7]);
    *(u32x4*)((bf16_t*)(ws + OFF_W1T) + (((size_t)l * 2 + kv) * 128 + j) * 2048 + k8 * 8) = v;
  }
  { const long NIT = (long)MTOK * DMODEL / 8;
    for (long it0 = gtid; it0 < NIT; it0 += 4 * gsz) {
      f32x4 a[4], b[4];
#pragma unroll
      for (int q = 0; q < 4; ++q) { const long it = it0 + q * gsz; const long itc = it < NIT ? it : it0; const f32x4* src = (const f32x4*)P.x + itc * 2; a[q] = src[0]; b[q] = src[1]; }
#pragma unroll
      for (int q = 0; q < 4; ++q) { const long it = it0 + q * gsz; if (it < NIT) {
        u32x4 v; v.x = pk2(a[q][0], a[q][1]); v.y = pk2(a[q][2], a[q][3]); v.z = pk2(b[q][0], b[q][1]); v.w = pk2(b[q][2], b[q][3]);
        *((u32x4*)(ws + OFF_XB) + it) = v; } }
    } }
}

#define LDSAS __attribute__((address_space(3)))
DI void glds16(const char* gsrc, char* ldst) {
  __builtin_amdgcn_global_load_lds((const unsigned*)gsrc, (LDSAS unsigned*)ldst, 16, 0, 0);
}
DI void gemm_mainloop(const bf16_t* A, long lda, int a_row_max, const bf16_t* Bt, long ldb, int K, char* lds, f32x16 (&acc)[2][2]) {
  const int tid = get_tid(), lane = tid & 63, wave = __builtin_amdgcn_readfirstlane(tid >> 6), wm = wave >> 1, wn = wave & 1, r = lane & 31, h = lane >> 5;
#pragma unroll
  for (int a = 0; a < 2; ++a)
#pragma unroll
    for (int b = 0; b < 2; ++b)
#pragma unroll
      for (int i = 0; i < 16; ++i) acc[a][b][i] = 0.f;
  const char* ga[4]; const char* gb[4];
#pragma unroll
  for (int i = 0; i < 4; ++i) { const int row = 32 * wave + 8 * i + (lane >> 3), ch = (lane & 7) ^ ((row >> 1) & 7); const int ar = row < a_row_max ? row : a_row_max;
    ga[i] = (const char*)(A + (long)ar * lda) + ch * 16; gb[i] = (const char*)(Bt + (long)row * ldb) + ch * 16; }
  char* const ldw = lds + (32 * wave) * 128;
  const int nk = K >> 6;
#define GEMM_STAGE(BUF, KT) do { _Pragma("unroll") for (int i = 0; i < 4; ++i) { \
    glds16(ga[i] + (long)(KT) * 128, ldw + (BUF) * 32768 + i * 1024); glds16(gb[i] + (long)(KT) * 128, ldw + (BUF) * 32768 + 16384 + i * 1024); } } while (0)
  __syncthreads();
  GEMM_STAGE(0, 0);
  asm volatile("s_waitcnt vmcnt(0)" ::: "memory");
  __syncthreads();
  const int sw = (r >> 1) & 7;
  const unsigned lds0 = (unsigned)(uintptr_t)lds;
  unsigned aa[4], ab[4];
#pragma unroll
  for (int ks = 0; ks < 4; ++ks) { const unsigned xo = (unsigned)(((2 * ks + h) ^ sw) * 16);
    aa[ks] = lds0 + (unsigned)((64 * wm + r) * 128) + xo; ab[ks] = lds0 + 16384u + (unsigned)((64 * wn + r) * 128) + xo; }
  bf16x8 xa0, xa1, xb0, xb1, ya0, ya1, yb0, yb1, za0, za1, zb0, zb1;
#define KT_RD(S, K, O0, O1) \
    "ds_read_b128 %[" #S "a0], %[aa" #K "] offset:" O0 "\n\tds_read_b128 %[" #S "b0], %[ab" #K "] offset:" O0 "\n\t" \
    "ds_read_b128 %[" #S "a1], %[aa" #K "] offset:" O1 "\n\tds_read_b128 %[" #S "b1], %[ab" #K "] offset:" O1 "\n\t"
#define KT_MM(S) \
    "v_mfma_f32_32x32x16_bf16 %[c00], %[" #S "a0], %[" #S "b0], %[c00]\n\tv_mfma_f32_32x32x16_bf16 %[c01], %[" #S "a0], %[" #S "b1], %[c01]\n\t" \
    "v_mfma_f32_32x32x16_bf16 %[c10], %[" #S "a1], %[" #S "b0], %[c10]\n\tv_mfma_f32_32x32x16_bf16 %[c11], %[" #S "a1], %[" #S "b1], %[c11]\n\t"
#define KT_ASM(O0, O1) asm volatile( \
    "s_waitcnt lgkmcnt(0)\n\t" \
    KT_RD(x, 0, O0, O1) KT_RD(y, 1, O0, O1) \
    "s_waitcnt lgkmcnt(4)\n\t" KT_MM(x) KT_RD(z, 2, O0, O1) \
    "s_waitcnt lgkmcnt(4)\n\t" KT_MM(y) KT_RD(x, 3, O0, O1) \
    "s_waitcnt lgkmcnt(4)\n\t" KT_MM(z) \
    "s_waitcnt lgkmcnt(0)\n\t" KT_MM(x) \
    : [c00] "+v"(acc[0][0]), [c01] "+v"(acc[0][1]), [c10] "+v"(acc[1][0]), [c11] "+v"(acc[1][1]), \
      [xa0] "=&v"(xa0), [xa1] "=&v"(xa1), [xb0] "=&v"(xb0), [xb1] "=&v"(xb1), [ya0] "=&v"(ya0), [ya1] "=&v"(ya1), [yb0] "=&v"(yb0), [yb1] "=&v"(yb1), \
      [za0] "=&v"(za0), [za1] "=&v"(za1), [zb0] "=&v"(zb0), [zb1] "=&v"(zb1) \
    : [aa0] "v"(aa[0]), [aa1] "v"(aa[1]), [aa2] "v"(aa[2]), [aa3] "v"(aa[3]), [ab0] "v"(ab[0]), [ab1] "v"(ab[1]), [ab2] "v"(ab[2]), [ab3] "v"(ab[3]) \
    : "memory")
  for (int kt = 0; kt < nk; kt += 2) {
    GEMM_STAGE(1, kt + 1);
    KT_ASM("0", "4096");
    asm volatile("s_waitcnt vmcnt(0)" ::: "memory");
    __syncthreads();
    if (kt + 2 < nk) GEMM_STAGE(0, kt + 2);
    KT_ASM("32768", "36864");
    asm volatile("s_waitcnt vmcnt(0)" ::: "memory");
    __syncthreads();
  }
  asm volatile("s_nop 15\n\ts_nop 7" : "+v"(acc[0][0]), "+v"(acc[0][1]), "+v"(acc[1][0]), "+v"(acc[1][1]));
#undef KT_RD
#undef KT_MM
#undef KT_ASM
#undef GEMM_STAGE
}

DI bool xcd_tile(int i, int NT, int& mt, int& nt) {
  const int G = gridDim.x;
  if ((G & 7) == 0 && G >= 8) {
    const int x = blockIdx.x & 7, j = blockIdx.x >> 3, per = G >> 3;
    const int u = j + per * i; if (u >= 16 * NT) return false;
    const int grp = u / (8 * NT), v = u - grp * (8 * NT);
    mt = 16 * x + 8 * grp + (v & 7); nt = v >> 3; return true;
  }
  const int t = blockIdx.x + G * i; if (t >= 128 * NT) return false;
  mt = t / NT; nt = t - mt * NT; return true;
}

DI void epi_inproj(const Params& P, int l, const f32x16 (&acc)[2][2], int m0, int n0, char* lds) {
  const int tid = get_tid(), lane = tid & 63, wave = tid >> 6, wm = wave >> 1, wn = wave & 1, r = lane & 31, h = lane >> 5;
  char* ws = P.ws;
  const int slot = (n0 >> 6) + wn;
  const int b = m0 >> 13;
  const int srow0 = (m0 & (SEQ - 1)) + 64 * wm;
  int cat = 0;
  int rope = 0; float scale = 1.f; bf16_t* dst = nullptr; int gcol = 0;
  const float QS = 0.125f * LOG2E;
  if (slot < 4) { cat = 1; scale = QS; dst = (bf16_t*)(ws + OFF_QF) + (size_t)(b * 4 + slot) * SEQ * 64; }
  else if (slot < 8) { cat = 1; dst = (bf16_t*)(ws + OFF_KF) + (size_t)(b * 4 + slot - 4) * SEQ * 64; }
  else if (slot < 12) { cat = 2; dst = (bf16_t*)(ws + OFF_VFT) + (size_t)(b * 4 + slot - 8) * SEQ * 64; }
  else if (slot < 16) { cat = 3; gcol = (slot - 12) * 64; }
  else if (slot < 24) { cat = 1; rope = 1; scale = QS; dst = (bf16_t*)(ws + OFF_QN) + (size_t)(b * 8 + slot - 16) * SEQ * 64; }
  else if (slot < 26) { cat = 1; rope = 1; dst = (bf16_t*)(ws + OFF_KCT) + (size_t)(b * 2 + slot - 24) * SEQ * 64; }
  else if (slot < 28) { cat = 1; dst = (bf16_t*)(ws + OFF_VCT) + (size_t)(b * 2 + slot - 26) * SEQ * 64; }
  else if (slot < 30) { cat = 1; rope = 1; dst = (bf16_t*)(ws + OFF_KS) + (size_t)(b * 2 + slot - 28) * SEQ * 64; }
  else if (slot < 32) { cat = 2; dst = (bf16_t*)(ws + OFF_VST) + (size_t)(b * 2 + slot - 30) * SEQ * 64; }
  else if (slot < 34) { cat = 1; rope = 1; dst = (bf16_t*)(ws + OFF_KW) + (size_t)(b * 2 + slot - 32) * SEQ * 64; }
  else if (slot < 36) { cat = 2; dst = (bf16_t*)(ws + OFF_VWT) + (size_t)(b * 2 + slot - 34) * SEQ * 64; }
  else if (slot < 44) { cat = 3; gcol = 256 + (slot - 36) * 64; }
  else if (slot < 48) { cat = 1; rope = 2; scale = 0.17677669529663687f * LOG2E; dst = (bf16_t*)(ws + OFF_QD) + (size_t)(b * 4 + slot - 44) * SEQ * 64; }
  else if (slot < 52) { cat = 1; rope = 2; dst = (bf16_t*)(ws + OFF_KD) + (size_t)(b * 4 + slot - 48) * SEQ * 64; }
  else if (slot < 56) { cat = 2; dst = (bf16_t*)(ws + OFF_VDT) + (size_t)(b * 4 + slot - 52) * SEQ * 64; }
  else if (slot < 60) { cat = 3; gcol = 768 + (slot - 56) * 64; }
  else if (slot == 60) cat = 4;

  if (cat == 1 || cat == 3) {
    unsigned short* wl = (unsigned short*)(lds + wave * 8192);
    int c0 = r, c1 = 32 + r;
    float crev = 0.f;
    if (rope == 1) crev = __builtin_amdgcn_exp2f(-(float)r * (13.287712379549449f / 32.f)) * 0.15915494309189535f;
    if (rope == 2) { int comp = r >> 4, ii = r & 15; c0 = comp * 32 + ii; c1 = comp * 32 + 16 + ii; crev = __builtin_amdgcn_exp2f(-(float)ii * (13.287712379549449f / 16.f)) * 0.15915494309189535f; }
#pragma unroll
    for (int mt = 0; mt < 2; ++mt)
#pragma unroll
      for (int i = 0; i < 16; ++i) {
        const int rowl = 32 * mt + crow(i, h);
        float v0 = acc[mt][0][i], v1 = acc[mt][1][i];
        if (cat == 3) { v0 = silu(v0); v1 = silu(v1); }
        else {
          if (rope) { const float fr = __builtin_amdgcn_fractf((float)(srow0 + rowl) * crev); const float cs = __builtin_amdgcn_cosf(fr), sn = __builtin_amdgcn_sinf(fr);
            const float y0 = v0 * cs - v1 * sn, y1 = v1 * cs + v0 * sn; v0 = y0; v1 = y1; }
          v0 *= scale; v1 *= scale;
        }
        wl[rowl * 64 + c0] = f2bf(v0); wl[rowl * 64 + c1] = f2bf(v1);
      }
    bf16_t* obase = (cat == 1) ? (dst + (size_t)srow0 * 64) : ((bf16_t*)(ws + OFF_G) + ((size_t)m0 + 64 * wm) * 1024 + gcol);
    const size_t opitch = (cat == 1) ? 64 : 1024;
#pragma unroll
    for (int k = 0; k < 8; ++k) { const int rowl = (lane >> 3) + 8 * k, ch = lane & 7;
      const u32x4 v = *(const u32x4*)((const char*)wl + rowl * 128 + ch * 16);
      *(u32x4*)(obase + (size_t)rowl * opitch + ch * 8) = v; }
  } else if (cat == 2) {
#pragma unroll
    for (int mt = 0; mt < 2; ++mt)
#pragma unroll
      for (int g = 0; g < 4; ++g) {
        int s = srow0 + 32 * mt + 8 * g + 4 * h;
#pragma unroll
        for (int nt = 0; nt < 2; ++nt) {
          u32x2 v; v.x = pk2(acc[mt][nt][4 * g], acc[mt][nt][4 * g + 1]); v.y = pk2(acc[mt][nt][4 * g + 2], acc[mt][nt][4 * g + 3]);
          *(u32x2*)(dst + (size_t)(32 * nt + r) * SEQ + s) = v;
        }
      }
  } else if (cat == 4) {
    if (r < 28) {
      float bias = (r < 4) ? P.b_fox_f[l * 4 + r] : 0.f;
#pragma unroll
      for (int mt = 0; mt < 2; ++mt)
#pragma unroll
        for (int i = 0; i < 16; ++i) {
          int s = srow0 + 32 * mt + crow(i, h);
          float v = acc[mt][0][i];
          if (r < 4) { float xx = v + bias; float ls = fminf(xx, 0.f) - log1pf(expf(-fabsf(xx)));
            ((float*)(ws + OFF_LOGF))[(size_t)(b * 4 + r) * SEQ + s] = ls * LOG2E; }
          else ((float*)(ws + OFF_GATES))[((size_t)b * SEQ + s) * 24 + (r - 4)] = sigmoidf(v);
        }
    }
  }
}

DI void p1_inproj(const Params& P, int l, char* lds) {
  const bf16_t* A = (const bf16_t*)(P.ws + OFF_XB);
  const bf16_t* Bt = (const bf16_t*)(P.ws + OFF_WIN) + (size_t)l * NPAD * DMODEL;
  const int NT = NPAD / 128;
  int mt, nt;
  for (int i = 0; xcd_tile(i, NT, mt, nt); ++i) {
    f32x16 acc[2][2];
    gemm_mainloop(A + (size_t)mt * 128 * DMODEL, DMODEL, 127, Bt + (size_t)nt * 128 * DMODEL, DMODEL, DMODEL, lds, acc);
    epi_inproj(P, l, acc, mt * 128, nt * 128, lds);
  }
}

DI void p4_outproj(const Params& P, int l, char* lds) {
  const bf16_t* A = (const bf16_t*)(P.ws + OFF_MIX);
  const bf16_t* Bt = (const bf16_t*)(P.ws + OFF_WOUT) + (size_t)l * 1024 * 1024;
  const float* xres = (l == 0) ? P.x : P.out;
  const float alpha = 1.4142135623730951f;
  const int tid = get_tid(), lane = tid & 63, wave = tid >> 6, wm = wave >> 1, wn = wave & 1, r = lane & 31, h = lane >> 5;
  int mt, nt;
  for (int i = 0; xcd_tile(i, 8, mt, nt); ++i) {
    f32x16 acc[2][2];
    gemm_mainloop(A + (size_t)mt * 128 * 1024, 1024, 127, Bt + (size_t)nt * 128 * 1024, 1024, 1024, lds, acc);
    { float* wl = (float*)(lds + wave * 16384);
#pragma unroll
      for (int a = 0; a < 2; ++a)
#pragma unroll
        for (int bb = 0; bb < 2; ++bb)
#pragma unroll
          for (int i = 0; i < 16; ++i) wl[(32 * a + crow(i, h)) * 64 + 32 * bb + r] = acc[a][bb][i];
      const size_t gbase = ((size_t)mt * 128 + 64 * wm) * 1024 + nt * 128 + 64 * wn;
#pragma unroll
      for (int k = 0; k < 16; ++k) { const int rowl = (lane >> 4) + 4 * k, ch = lane & 15;
        const f32x4 m = *(const f32x4*)(wl + rowl * 64 + ch * 4);
        const f32x4 x = *(const f32x4*)(xres + gbase + (size_t)rowl * 1024 + ch * 4);
        *(f32x4*)(P.out + gbase + (size_t)rowl * 1024 + ch * 4) = alpha * x + m; }
    }
  }
}

DI void p5_ln(const Params& P, int l) {
  const int lane = get_tid() & 63, wave = get_tid() >> 6;
  const float* g = P.ln_g + l * 1024; const float* bb = P.ln_b + l * 1024;
  for (int row = blockIdx.x * 4 + wave; row < MTOK; row += gridDim.x * 4) {
    float* p = P.out + (size_t)row * 1024;
    f32x4 v[4]; float s = 0.f;
#pragma unroll
    for (int k = 0; k < 4; ++k) { v[k] = *(const f32x4*)(p + k * 256 + lane * 4); s += v[k][0] + v[k][1] + v[k][2] + v[k][3]; }
#pragma unroll
    for (int o = 32; o >= 1; o >>= 1) s += __shfl_xor(s, o);
    float mean = s * (1.f / 1024.f); float q = 0.f;
#pragma unroll
    for (int k = 0; k < 4; ++k)
#pragma unroll
      for (int e = 0; e < 4; ++e) { float d = v[k][e] - mean; q += d * d; }
#pragma unroll
    for (int o = 32; o >= 1; o >>= 1) q += __shfl_xor(q, o);
    float rstd = rsqrtf(q * (1.f / 1024.f) + 1e-5f);
#pragma unroll
    for (int k = 0; k < 4; ++k) {
      int c = k * 256 + lane * 4; f32x4 gg = *(const f32x4*)(g + c), bv = *(const f32x4*)(bb + c); f32x4 o;
#pragma unroll
      for (int e = 0; e < 4; ++e) o[e] = (v[k][e] - mean) * rstd * gg[e] + bv[e];
      *(f32x4*)(p + c) = o;
      if (l + 1 < DEPTH) {
        u32x2 w; w.x = pk2(o[0], o[1]); w.y = pk2(o[2], o[3]);
        *(u32x2*)((bf16_t*)(P.ws + OFF_XB) + (size_t)row * 1024 + c) = w; }
    }
  }
}

enum { M_FOX = 0, M_DIFF = 1, M_CMP1 = 2, M_CMP2 = 3, M_SEL = 4, M_WIN = 5 };
struct AttnState { f32x16 o[2]; float m, l; };
struct TileSrc { const bf16_t* K; const bf16_t* Vt; long vstride; const float* C; };

template <bool HASV, bool HASC>
DI void tile_gload(const TileSrc& s, int T, u32x4 (&rk)[2], u32x4 (&rv)[2], f32x4& rc, int tid) {
#pragma unroll
  for (int p = 0; p < 2; ++p) { int id = tid + 256 * p, row = id >> 3, ch = id & 7;
    rk[p] = *(const u32x4*)(s.K + ((long)(64 * T + row)) * 64 + ch * 8);
    if (HASV) rv[p] = *(const u32x4*)(s.Vt + (long)row * s.vstride + 64 * T + ch * 8); }
  if (HASC) { if (tid < 16) rc = *(const f32x4*)(s.C + 64 * T + 4 * tid); }
}
template <bool HASV, bool HASC>
DI void tile_sstore(char* buf, const u32x4 (&rk)[2], const u32x4 (&rv)[2], const f32x4& rc, int tid) {
#pragma unroll
  for (int p = 0; p < 2; ++p) { int id = tid + 256 * p, row = id >> 3, ch = id & 7;
    *(u32x4*)(buf + row * 144 + ch * 16) = rk[p];
    if (HASV) { char* d = buf + ATT_V + row * 136 + ch * 16; u32x2 a = {rv[p].x, rv[p].y}, b = {rv[p].z, rv[p].w}; *(u32x2*)d = a; *(u32x2*)(d + 8) = b; } }
  if (HASC) { if (tid < 16) *(f32x4*)(buf + ATT_C + tid * 16) = -rc; }
}

constexpr float MREF0 = -32.f;
constexpr float RSUM = 1099511627776.f;

template <int MODE>
DI void qk_part(f32x16 (&p)[2], const bf16x8* qf, const char* buf, int koffb, const f32x16& negm, int r, int h) {
  constexpr int ND0 = (MODE == M_DIFF) ? 2 : 4;
  const char* kl = buf; const float* cl = (const float*)(buf + ATT_C);
  if (MODE == M_FOX) {
    const float nm = negm[0];
#pragma unroll
    for (int c = 0; c < 2; ++c)
#pragma unroll
      for (int g = 0; g < 4; ++g) { f32x4 ck = *(const f32x4*)(cl + 32 * c + 8 * g + 4 * h);
#pragma unroll
        for (int e = 0; e < 4; ++e) p[c][4 * g + e] = ck[e] + nm; }
  }
#pragma unroll
  for (int d0 = 0; d0 < ND0; ++d0) {
    const char* kp = kl + r * 144 + koffb + (16 * d0 + 8 * h) * 2;
    bf16x8 k0 = *(const bf16x8*)kp; bf16x8 k1 = *(const bf16x8*)(kp + 32 * 144);
    if (MODE != M_FOX && d0 == 0) { p[0] = MFMA32(k0, qf[d0], negm); p[1] = MFMA32(k1, qf[d0], negm); }
    else { p[0] = MFMA32(k0, qf[d0], p[0]); p[1] = MFMA32(k1, qf[d0], p[1]); }
  }
}

template <int MODE>
DI void sp_part(AttnState& st, f32x16 (&p)[2], f32x16& negm, const char* buf, int T, int tq, unsigned selbit,
                float inv_l, unsigned* imp_q, int r, int h) {
  const char* vl = buf + ATT_V;
  const int kvb = 64 * T + 4 * h;
  int lim, lo;
  if (MODE == M_CMP1 || MODE == M_CMP2) { lim = (tq - 31) >> 4; lo = -(1 << 30); }
  else if (MODE == M_SEL) { lim = selbit ? tq : -1; lo = -(1 << 30); }
  else if (MODE == M_WIN) { lim = tq; lo = tq - 511; }
  else { lim = tq; lo = -(1 << 30); }
  const bool full = (lim >= 64 * T + 63) && (lo <= 64 * T);
  bool lane_on = true; bool sel_interior = false;
  if (MODE == M_SEL) sel_interior = __all(tq >= 64 * T + 63) != 0;
  if (sel_interior) lane_on = (selbit != 0u);
  else if (!__all(full)) {
#pragma unroll
    for (int c = 0; c < 2; ++c)
#pragma unroll
      for (int i = 0; i < 16; ++i) { int kv = kvb + 32 * c + 8 * (i >> 2) + (i & 3); if (kv > lim || kv < lo) p[c][i] = NEGBIG; }
  }
  float tile_sum = 0.f;
  if (MODE == M_CMP2) {
#pragma unroll
    for (int c = 0; c < 2; ++c)
#pragma unroll
      for (int i = 0; i < 16; ++i) p[c][i] = ex2(p[c][i]) * inv_l;
#pragma unroll
    for (int c = 0; c < 2; ++c)
#pragma unroll
      for (int g = 0; g < 4; ++g) {
        int j = 16 * T + 8 * c + 2 * g + h;
        float bq = 0.5f * p[c][4 * g + 3]; float aq = p[c][4 * g] + p[c][4 * g + 1] + p[c][4 * g + 2] + bq;
        atomicAdd(&imp_q[j * 32], (unsigned)(aq * 4194304.f + 0.5f));
        if (j + 1 < 128) atomicAdd(&imp_q[(j + 1) * 32], (unsigned)(bq * 4194304.f + 0.5f));
      }
  } else {
    float sum = 0.f;
#pragma unroll
    for (int c = 0; c < 2; ++c)
#pragma unroll
      for (int i = 0; i < 16; ++i) { float e = ex2(p[c][i]); p[c][i] = e; sum += e; }
    if (MODE == M_SEL) sum = lane_on ? sum : 0.f;
    st.l += sum;
    tile_sum = sum;
  }
  if (MODE != M_CMP1) {
#pragma unroll
    for (int c = 0; c < 2; ++c)
#pragma unroll
      for (int s2 = 0; s2 < 2; ++s2) {
        u32x4 pw; pw.x = pk2(p[c][8 * s2], p[c][8 * s2 + 1]); pw.y = pk2(p[c][8 * s2 + 2], p[c][8 * s2 + 3]);
        pw.z = pk2(p[c][8 * s2 + 4], p[c][8 * s2 + 5]); pw.w = pk2(p[c][8 * s2 + 6], p[c][8 * s2 + 7]);
        if (MODE == M_SEL) { if (!lane_on) { pw.x = 0u; pw.y = 0u; pw.z = 0u; pw.w = 0u; } }
        bf16x8 pf = __builtin_bit_cast(bf16x8, pw);
#pragma unroll
        for (int dt = 0; dt < 2; ++dt) {
          const char* vp = vl + (32 * dt + r) * 136 + (32 * c + 16 * s2 + 4 * h) * 2;
          s16x4 lo4 = *(const s16x4*)vp; s16x4 hi4 = *(const s16x4*)(vp + 16);
          bf16x8 vf = __builtin_shufflevector(lo4, hi4, 0, 1, 2, 3, 4, 5, 6, 7);
          st.o[dt] = MFMA32(vf, pf, st.o[dt]);
        }
      }
  }
  if (MODE != M_CMP2) {
    if (__any(tile_sum > RSUM)) {
      const float tot = xhalf_sum(tile_sum);
      const float dl = (tot > RSUM) ? __builtin_amdgcn_logf(tot) : 0.f;
      st.m += dl;
      const float nm = -st.m;
#pragma unroll
      for (int i = 0; i < 16; ++i) negm[i] = nm;
      const float f = ex2(-dl);
      st.l *= f;
      if (MODE != M_CMP1) {
#pragma unroll
        for (int i = 0; i < 16; ++i) { st.o[0][i] *= f; st.o[1][i] *= f; }
      }
    }
  }
}

template <int MODE>
DI bool tile_active(int T, int twmax, int qspan, const unsigned* selmask_q) {
  bool a;
  if (MODE == M_CMP1 || MODE == M_CMP2) a = (16 * (64 * T) + 31 <= twmax);
  else a = (64 * T <= twmax);
  if (MODE == M_WIN) a = a && (64 * T + 63 >= twmax - qspan - 511);
  if (MODE == M_SEL) { if (a) a = __any((int)((selmask_q[T >> 5] >> (T & 31)) & 1u)) != 0; }
  return a;
}

template <int MODE>
DI void run_tiles(AttnState& st, const bf16x8* qf, const TileSrc& src, int T0, int T1, int tq, int twmax_, int qspan, int koffb,
                  const unsigned* selmask_q, float m_fin, float inv_l, unsigned* imp_q, char* lds, int tid, int r, int h) {
  constexpr bool HASV = (MODE != M_CMP1), HASC = (MODE == M_FOX);
  const int twmax = __builtin_amdgcn_readfirstlane(twmax_);
  const float m0 = (MODE == M_CMP2) ? m_fin : MREF0;
  u32x4 rk[2], rv[2]; f32x4 rc;
  st.m = m0;
  f32x16 negm;
#pragma unroll
  for (int i = 0; i < 16; ++i) negm[i] = -m0;
  __syncthreads();
  if (T0 < T1) { tile_gload<HASV, HASC>(src, T0, rk, rv, rc, tid); tile_sstore<HASV, HASC>(lds, rk, rv, rc, tid); }
  if (T0 + 1 < T1) tile_gload<HASV, HASC>(src, T0 + 1, rk, rv, rc, tid);
  int slot = 0;
  for (int T = T0; T < T1; ++T) {
    const char* buf = lds + slot * ATT_BUF;
    slot = (slot == 2) ? 0 : slot + 1;
    if (T + 1 < T1) tile_sstore<HASV, HASC>(lds + slot * ATT_BUF, rk, rv, rc, tid);
    if (T + 2 < T1) tile_gload<HASV, HASC>(src, T + 2, rk, rv, rc, tid);
    __syncthreads();
    if (tile_active<MODE>(T, twmax, qspan, selmask_q)) {
      unsigned selbit = 0;
      if (MODE == M_SEL) selbit = (selmask_q[T >> 5] >> (T & 31)) & 1u;
      f32x16 p[2];
      qk_part<MODE>(p, qf, buf, koffb, negm, r, h);
      sp_part<MODE>(st, p, negm, buf, T, tq, selbit, inv_l, imp_q, r, h);
    }
  }
}

DI void st_init(AttnState& st) {
#pragma unroll
  for (int i = 0; i < 16; ++i) { st.o[0][i] = 0.f; st.o[1][i] = 0.f; }
  st.m = MREF0; st.l = 0.f;
}
DI float st_invl(const AttnState& st) { float lt = xhalf_sum(st.l); return lt > 0.f ? 1.f / lt : 0.f; }

DI void store_mix(const Params& P, size_t token, int col, float a, float b, float c, float d) {
  const bf16_t* G = (const bf16_t*)(P.ws + OFF_G) + token * 1024 + col;
  u32x2 gv = *(const u32x2*)G;
  float g0 = __uint_as_float(gv.x << 16), g1 = __uint_as_float(gv.x & 0xffff0000u), g2 = __uint_as_float(gv.y << 16), g3 = __uint_as_float(gv.y & 0xffff0000u);
  u32x2 w; w.x = pk2(a * g0, b * g1); w.y = pk2(c * g2, d * g3);
  *(u32x2*)((bf16_t*)(P.ws + OFF_MIX) + token * 1024 + col) = w;
}

DI void fox_unit(const Params& P, int bh, int qt, char* lds) {
  const int tid = get_tid(), lane = tid & 63, wave = tid >> 6, r = lane & 31, h = lane >> 5;
  const int t0 = 128 * qt, tq = t0 + 32 * wave + r, twmax = t0 + 32 * wave + 31;
  const bf16_t* Q = (const bf16_t*)(P.ws + OFF_QF) + (size_t)bh * SEQ * 64;
  TileSrc src; src.K = (const bf16_t*)(P.ws + OFF_KF) + (size_t)bh * SEQ * 64; src.Vt = (const bf16_t*)(P.ws + OFF_VFT) + (size_t)bh * SEQ * 64; src.vstride = SEQ;
  src.C = (const float*)(P.ws + OFF_CUM) + (size_t)bh * SEQ;
  bf16x8 qf[4];
#pragma unroll
  for (int d0 = 0; d0 < 4; ++d0) qf[d0] = *(const bf16x8*)(Q + (size_t)tq * 64 + 16 * d0 + 8 * h);
  AttnState st; st_init(st);
  run_tiles<M_FOX>(st, qf, src, 0, 2 * qt + 2, tq, twmax, 31, 0, nullptr, 0.f, 0.f, nullptr, lds, tid, r, h);
  const float inv = st_invl(st);
  const size_t token = (size_t)(bh >> 2) * SEQ + tq; const int hd = bh & 3;
#pragma unroll
  for (int dt = 0; dt < 2; ++dt)
#pragma unroll
    for (int g = 0; g < 4; ++g)
      store_mix(P, token, hd * 64 + 32 * dt + 8 * g + 4 * h, st.o[dt][4 * g] * inv, st.o[dt][4 * g + 1] * inv, st.o[dt][4 * g + 2] * inv, st.o[dt][4 * g + 3] * inv);
}

DI void diff_unit(const Params& P, int l, int bh, int qt, char* lds) {
  const int tid = get_tid(), lane = tid & 63, wave = tid >> 6, r = lane & 31, h = lane >> 5;
  const int comp = wave & 1, qs = wave >> 1;
  const int t0 = 64 * qt, tq = t0 + 32 * qs + r, twmax = t0 + 32 * qs + 31;
  const bf16_t* Q = (const bf16_t*)(P.ws + OFF_QD) + (size_t)bh * SEQ * 64;
  TileSrc src; src.K = (const bf16_t*)(P.ws + OFF_KD) + (size_t)bh * SEQ * 64; src.Vt = (const bf16_t*)(P.ws + OFF_VDT) + (size_t)bh * SEQ * 64; src.vstride = SEQ; src.C = nullptr;
  bf16x8 qf[2];
#pragma unroll
  for (int d0 = 0; d0 < 2; ++d0) qf[d0] = *(const bf16x8*)(Q + (size_t)tq * 64 + comp * 32 + 16 * d0 + 8 * h);
  AttnState st; st_init(st);
  run_tiles<M_DIFF>(st, qf, src, 0, qt + 1, tq, twmax, 31, comp * 64, nullptr, 0.f, 0.f, nullptr, lds, tid, r, h);
  const float inv = st_invl(st);
  float* exch = (float*)(lds + LDS_IMP);
  __syncthreads();
  if (comp == 1) {
#pragma unroll
    for (int dt = 0; dt < 2; ++dt)
#pragma unroll
      for (int i = 0; i < 16; ++i) exch[(qs * 64 + 32 * dt + crow(i, h)) * 32 + r] = st.o[dt][i] * inv;
  }
  __syncthreads();
  if (comp == 0) {
    const float lam = ((const float*)(P.ws + OFF_LAM))[l], lam_init = ((const float*)(P.ws + OFF_LAM))[2 + l];
    float ss = 0.f;
#pragma unroll
    for (int dt = 0; dt < 2; ++dt)
#pragma unroll
      for (int i = 0; i < 16; ++i) { float a = st.o[dt][i] * inv - lam * exch[(qs * 64 + 32 * dt + crow(i, h)) * 32 + r]; st.o[dt][i] = a; ss += a * a; }
    ss = xhalf_sum(ss);
    const float rms = rsqrtf(ss * (1.f / 64.f) + 1e-5f) * (1.f - lam_init);
    const size_t token = (size_t)(bh >> 2) * SEQ + tq; const int hd = bh & 3;
    const float* sg = P.subln_g + l * 64;
#pragma unroll
    for (int dt = 0; dt < 2; ++dt)
#pragma unroll
      for (int g = 0; g < 4; ++g) { int d = 32 * dt + 8 * g + 4 * h; f32x4 gg = *(const f32x4*)(sg + d);
        store_mix(P, token, 768 + hd * 64 + d, st.o[dt][4 * g] * rms * gg[0], st.o[dt][4 * g + 1] * rms * gg[1], st.o[dt][4 * g + 2] * rms * gg[2], st.o[dt][4 * g + 3] * rms * gg[3]); }
  }
}

DI void nsa_unit(const Params& P, int bg, int qt, char* lds) {
  const int tid = get_tid(), lane = tid & 63, wave = tid >> 6, r = lane & 31, h = lane >> 5;
  const int b = bg >> 1, g2 = bg & 1, head8 = g2 * 4 + (r & 3);
  const int t0 = 32 * qt, ql = 8 * wave + (r >> 2), tq = t0 + ql, tmax = t0 + 31, twmax = t0 + 8 * wave + 7;
  const bf16_t* Q = (const bf16_t*)(P.ws + OFF_QN) + (size_t)(b * 8 + head8) * SEQ * 64;
  bf16x8 qf[4];
#pragma unroll
  for (int d0 = 0; d0 < 4; ++d0) qf[d0] = *(const bf16x8*)(Q + (size_t)tq * 64 + 16 * d0 + 8 * h);
  unsigned* imp = (unsigned*)(lds + LDS_IMP);
  unsigned* selm = (unsigned*)(lds + LDS_SEL);
#pragma unroll
  for (int k = 0; k < 16; ++k) imp[tid + 256 * k] = 0u;
  const float* gates = (const float*)(P.ws + OFF_GATES) + ((size_t)b * SEQ + tq) * 24 + 3 * head8;
  const float gc = gates[0], gs = gates[1], gw = gates[2];
  unsigned* stash = (unsigned*)(lds + LDS_IMP) + wave * 16 * 64 + lane;
  TileSrc src; src.K = (const bf16_t*)(P.ws + OFF_KC) + (size_t)bg * 512 * 64; src.Vt = (const bf16_t*)(P.ws + OFF_VCC) + (size_t)bg * 64 * 512; src.vstride = 512; src.C = nullptr;
  int nvis = (t0 >> 4) + 1; if (nvis > 511) nvis = 511;
  const int ntc = (nvis + 63) >> 6;
  AttnState st; st_init(st);
  run_tiles<M_CMP1>(st, qf, src, 0, ntc, tq, twmax, 7, 0, nullptr, 0.f, 0.f, nullptr, lds, tid, r, h);
  {
    const float m_fin = st.m, inv_l = st_invl(st);
    st_init(st);
    run_tiles<M_CMP2>(st, qf, src, 0, ntc, tq, twmax, 7, 0, nullptr, m_fin, inv_l, imp + ql, lds, tid, r, h);
  }
  __syncthreads();
  {
    const int q = tid >> 3, jg = tid & 7; const int t = t0 + q, cur = t >> 6;
    unsigned key[16];
#pragma unroll
    for (int e = 0; e < 16; ++e) { int j = 16 * jg + e; unsigned v = imp[j * 32 + q];
      bool valid = j <= cur, forced = (j == 0) || (j == cur) || (j == cur - 1);
      key[e] = !valid ? 0u : (forced ? (0xFFFFFF80u | (unsigned)(127 - j)) : ((v << 7) | (unsigned)(127 - j))); }
    unsigned sel = 0;
    for (int round = 0; round < 16; ++round) {
      unsigned m = key[0];
#pragma unroll
      for (int e = 1; e < 16; ++e) m = m > key[e] ? m : key[e];
      unsigned o;
      o = __shfl_xor(m, 1); m = m > o ? m : o; o = __shfl_xor(m, 2); m = m > o ? m : o; o = __shfl_xor(m, 4); m = m > o ? m : o;
      if (m != 0u) {
#pragma unroll
        for (int e = 0; e < 16; ++e) if (key[e] == m) { sel |= 1u << e; key[e] = 0u; }
      }
    }
    ((unsigned short*)selm)[q * 8 + jg] = (unsigned short)sel;
  }
  __syncthreads();
#pragma unroll
  for (int i = 0; i < 8; ++i) { stash[i * 64] = pk2(gc * st.o[0][2 * i], gc * st.o[0][2 * i + 1]); stash[(8 + i) * 64] = pk2(gc * st.o[1][2 * i], gc * st.o[1][2 * i + 1]); }
  src.K = (const bf16_t*)(P.ws + OFF_KS) + (size_t)bg * SEQ * 64; src.Vt = (const bf16_t*)(P.ws + OFF_VST) + (size_t)bg * SEQ * 64; src.vstride = SEQ;
  st_init(st);
  run_tiles<M_SEL>(st, qf, src, 0, (tmax >> 6) + 1, tq, twmax, 7, 0, selm + ql * 4, 0.f, 0.f, nullptr, lds, tid, r, h);
  { const float inv = st_invl(st) * gs;
#pragma unroll
    for (int i = 0; i < 8; ++i) { unsigned a = stash[i * 64], bq = stash[(8 + i) * 64];
      stash[i * 64] = pk2(__uint_as_float(a << 16) + inv * st.o[0][2 * i], __uint_as_float(a & 0xffff0000u) + inv * st.o[0][2 * i + 1]);
      stash[(8 + i) * 64] = pk2(__uint_as_float(bq << 16) + inv * st.o[1][2 * i], __uint_as_float(bq & 0xffff0000u) + inv * st.o[1][2 * i + 1]); } }
  src.K = (const bf16_t*)(P.ws + OFF_KW) + (size_t)bg * SEQ * 64; src.Vt = (const bf16_t*)(P.ws + OFF_VWT) + (size_t)bg * SEQ * 64;
  st_init(st);
  { int lo_t = t0 - 511; int T0 = lo_t > 0 ? (lo_t >> 6) : 0;
    run_tiles<M_WIN>(st, qf, src, T0, (tmax >> 6) + 1, tq, twmax, 7, 0, nullptr, 0.f, 0.f, nullptr, lds, tid, r, h); }
  { const float inv = st_invl(st) * gw;
#pragma unroll
    for (int i = 0; i < 8; ++i) { unsigned a = stash[i * 64], bq = stash[(8 + i) * 64];
      st.o[0][2 * i] = __uint_as_float(a << 16) + inv * st.o[0][2 * i]; st.o[0][2 * i + 1] = __uint_as_float(a & 0xffff0000u) + inv * st.o[0][2 * i + 1];
      st.o[1][2 * i] = __uint_as_float(bq << 16) + inv * st.o[1][2 * i]; st.o[1][2 * i + 1] = __uint_as_float(bq & 0xffff0000u) + inv * st.o[1][2 * i + 1]; } }
  const size_t token = (size_t)b * SEQ + tq;
#pragma unroll
  for (int dt = 0; dt < 2; ++dt)
#pragma unroll
    for (int g = 0; g < 4; ++g)
      store_mix(P, token, 256 + head8 * 64 + 32 * dt + 8 * g + 4 * h, st.o[dt][4 * g], st.o[dt][4 * g + 1], st.o[dt][4 * g + 2], st.o[dt][4 * g + 3]);
}

DI void compress_tile(const Params& P, int l, int id, char* lds) {
  const int tid = get_tid(), lane = tid & 63, wave = tid >> 6, wm = wave >> 1, wn = wave & 1, r = lane & 31, h = lane >> 5;
  const int kv = id >> 4, bg = (id >> 2) & 3, mt = id & 3;
  const bf16_t* tok = (const bf16_t*)(P.ws + (kv ? OFF_VCT : OFF_KCT)) + (size_t)bg * SEQ * 64;
  const bf16_t* Bt = (const bf16_t*)(P.ws + OFF_W1T) + ((size_t)l * 2 + kv) * 128 * 2048;
  f32x16 acc[2][2];
  int rowmax = 510 - 128 * mt; if (rowmax > 127) rowmax = 127;
  gemm_mainloop(tok + (size_t)mt * 128 * 1024, 1024, rowmax, Bt, 2048, 2048, lds, acc);
  __syncthreads();
  float* H = (float*)lds;
  const float* bias = (const float*)(P.ws + OFF_B1) + (l * 2 + kv) * 128;
#pragma unroll
  for (int a = 0; a < 2; ++a)
#pragma unroll
    for (int bb = 0; bb < 2; ++bb) { int col = 64 * wn + 32 * bb + r; float bv = bias[col];
#pragma unroll
      for (int i = 0; i < 16; ++i) { int row = 64 * wm + 32 * a + crow(i, h); H[row * 129 + col] = silu(acc[a][bb][i] + bv); } }
  __syncthreads();
  const float* w2 = (kv ? P.w2_v : P.w2_k) + (size_t)l * 128 * 64;
  const int c = tid & 63, rg = tid >> 6;
  float o[32];
#pragma unroll
  for (int i = 0; i < 32; ++i) o[i] = 0.f;
  for (int j = 0; j < 128; ++j) { float w = w2[j * 64 + c];
#pragma unroll
    for (int i = 0; i < 32; ++i) o[i] += H[(rg * 32 + i) * 129 + j] * w; }
  if (kv == 0) { bf16_t* dst = (bf16_t*)(P.ws + OFF_KC) + (size_t)bg * 512 * 64;
#pragma unroll
    for (int i = 0; i < 32; ++i) { int n = 128 * mt + rg * 32 + i; dst[(size_t)n * 64 + c] = f2bf(o[i]); } }
  else { bf16_t* dst = (bf16_t*)(P.ws + OFF_VCC) + (size_t)bg * 64 * 512;
#pragma unroll
    for (int i = 0; i < 32; ++i) { int n = 128 * mt + rg * 32 + i; dst[(size_t)c * 512 + n] = f2bf(o[i]); } }
  __syncthreads();
}

DI void cumsum_seq(const Params& P, int bh, char* lds) {
  const int tid = get_tid();
  const float* src = (const float*)(P.ws + OFF_LOGF) + (size_t)bh * SEQ + tid * 32;
  float* dst = (float*)(P.ws + OFF_CUM) + (size_t)bh * SEQ + tid * 32;
  float* tot = (float*)lds;
  f32x4 v[8]; float s = 0.f;
#pragma unroll
  for (int k = 0; k < 8; ++k) { v[k] = *(const f32x4*)(src + 4 * k);
#pragma unroll
    for (int e = 0; e < 4; ++e) { s += v[k][e]; v[k][e] = s; } }
  __syncthreads();
  tot[tid] = s;
  __syncthreads();
  float base = 0.f;
  for (int i = 0; i < tid; ++i) base += tot[i];
#pragma unroll
  for (int k = 0; k < 8; ++k) { f32x4 o;
#pragma unroll
    for (int e = 0; e < 4; ++e) o[e] = v[k][e] + base;
    *(f32x4*)(dst + 4 * k) = o; }
  __syncthreads();
}

DI int next_unit(unsigned* ctr, int* s_unit) {
  __syncthreads();
  if (get_tid() == 0) *s_unit = (int)atomicAdd(ctr, 1u);
  __syncthreads();
  return *s_unit;
}

DI void p23_phase(const Params& P, int l, char* lds, int* s_unit, int rep = 0) {
  unsigned* ctr = (unsigned*)(P.ws + OFF_CTR) + (l * 4 + 0 + 16 * rep);
  unsigned* done = (unsigned*)(P.ws + OFF_CTR) + (40 + l + 4 * rep);
  bool acquired = false;
  for (;;) {
    int u = next_unit(ctr, s_unit);
    if (u >= 40 + 1024 + 512 + 1024) break;
    if (u < 40) {
      if (u < 32) compress_tile(P, l, u, lds); else cumsum_seq(P, u - 32, lds);
      asm volatile("s_waitcnt vmcnt(0)" ::: "memory");
      __syncthreads();
      if (get_tid() == 0) { __builtin_amdgcn_fence(__ATOMIC_RELEASE, "agent"); asm volatile("s_waitcnt vmcnt(0)" ::: "memory");
        __hip_atomic_fetch_add(done, 1u, __ATOMIC_RELAXED, __HIP_MEMORY_SCOPE_AGENT); }
    } else if (u < 40 + 1024) { int v = u - 40; diff_unit(P, l, v & 7, 127 - (v >> 3), lds); }
    else {
      if (!acquired) {
        if (get_tid() == 0) {
          unsigned sp = 0;
          while (__hip_atomic_load(done, __ATOMIC_RELAXED, __HIP_MEMORY_SCOPE_AGENT) < 40u) { __builtin_amdgcn_s_sleep(4); if (++sp > (1u << 24)) break; }
          __builtin_amdgcn_fence(__ATOMIC_ACQUIRE, "agent"); asm volatile("s_waitcnt vmcnt(0)" ::: "memory");
        }
        __syncthreads();
        acquired = true;
      }
      const int w = u - (40 + 1024);
      if (w < 384) fox_unit(P, w & 7, 63 - (w >> 3), lds);
      else if (w < 384 + 1024) { int v = w - 384; nsa_unit(P, v & 3, 255 - (v >> 2), lds); }
      else { int v = w - (384 + 1024); fox_unit(P, v & 7, 15 - (v >> 3), lds); }
    }
  }
}

template <int KIND> DI void run_phase(const Params& P, int l, char* lds, int* s_unit, int rep = 0) {
  if constexpr (KIND == 0) p0_prologue(P);
  else if constexpr (KIND == 1) p1_inproj(P, l, lds);
  else if constexpr (KIND == 2) p23_phase(P, l, lds, s_unit, rep);
  else if constexpr (KIND == 3) { }
  else if constexpr (KIND == 4) p4_outproj(P, l, lds);
  else p5_ln(P, l);
}
template <int KIND> __global__ void __launch_bounds__(NTHREADS, 2) phase_kernel(Params P, int l) {
  __shared__ __attribute__((aligned(16))) char lds[LDS_BYTES + LDS_CTL];
  run_phase<KIND>(P, l, lds, (int*)(lds + LDS_BYTES));
}
#if COOP
#define GSYNC() do { asm volatile("" ::: "memory"); cg::this_grid().sync(); asm volatile("" ::: "memory"); } while (0)
#define XB_TMO      128
#define XB_XCNT(j)  (256  + 64 * (j))
#define XB_XSUB(j)  (1280 + 64 * (j))
#define XB_XGEN(j)  (2304 + 64 * (j))
#define XB_TOP      3328
#define XB_TOPGEN   3392
#define XCD_BAR_WORDS 3456
#define XB_SPIN_CAP (1u << 22)
#define LAS __attribute__((address_space(3)))
DI unsigned xb_ld(unsigned* p) { return __hip_atomic_load(p, __ATOMIC_RELAXED, __HIP_MEMORY_SCOPE_AGENT); }
DI unsigned xb_add(unsigned* p, unsigned v) { return __hip_atomic_fetch_add(p, v, __ATOMIC_RELAXED, __HIP_MEMORY_SCOPE_AGENT); }
DI unsigned xb_xcc_id() { return (unsigned)__builtin_amdgcn_s_getreg((3 << 11) | 20) & 0xFu; }
#define XB_SPIN(cond, bar) do { unsigned _sp = 0; while (cond) { __builtin_amdgcn_s_sleep(1); \
    if ((++_sp & 255u) == 0u) { if (xb_ld(&(bar)[XB_TMO])) break; if (_sp > XB_SPIN_CAP) { atomicAdd(&(bar)[XB_TMO], 1u); break; } } } } while (0)
struct XcdBarrier { unsigned* bar; unsigned x; volatile LAS unsigned* st; };
DI XcdBarrier xcd_barrier_post(unsigned* bar, volatile LAS unsigned* st) {
  XcdBarrier b; b.bar = bar; b.x = xb_xcc_id(); b.st = st;
  if (threadIdx.x == 0) (void)xb_add(&bar[XB_XCNT(b.x)], 1u);
  return b;
}
DI void xcd_barrier_complete(unsigned* bar, unsigned x, unsigned& nloc, unsigned& nx) {
  const unsigned G = gridDim.x * gridDim.y * gridDim.z;
  unsigned sum, cnt, mine, sp = 0u;
  for (;;) {
    sum = 0u; cnt = 0u; mine = 0u;
#pragma unroll
    for (unsigned j = 0; j < 16; ++j) { const unsigned c = xb_ld(&bar[XB_XCNT(j)]); sum += c; cnt += (c > 0u) ? 1u : 0u; mine = (j == x) ? c : mine; }
    if (sum == G) break;
    __builtin_amdgcn_s_sleep(1);
    if ((++sp & 255u) == 0u) { if (xb_ld(&bar[XB_TMO])) break; if (sp > XB_SPIN_CAP) { atomicAdd(&bar[XB_TMO], 1u); break; } }
  }
  nloc = mine > 0u ? mine : 1u; nx = cnt > 0u ? cnt : 1u;
}
DI void xcd_barrier(const XcdBarrier& b) {
  asm volatile("s_waitcnt vmcnt(0)" ::: "memory");
  __syncthreads();
  if (threadIdx.x == 0) {
    unsigned* bar = b.bar;
    __builtin_amdgcn_s_waitcnt(0);
    unsigned nloc = b.st[0], nx = b.st[1];
    if (nloc == 0u) { xcd_barrier_complete(bar, b.x, nloc, nx); b.st[0] = nloc; b.st[1] = nx; }
    const unsigned old = xb_add(&bar[XB_XSUB(b.x)], 1u);
    const unsigned gen = old / nloc;
    if (old + 1u == (gen + 1u) * nloc) {
      __builtin_amdgcn_fence(__ATOMIC_RELEASE, "agent");
      asm volatile("s_waitcnt vmcnt(0)" ::: "memory");
      const unsigned og = xb_add(&bar[XB_TOP], 1u);
      const unsigned tg = og / nx;
      if (og + 1u == (tg + 1u) * nx) xb_add(&bar[XB_TOPGEN], 1u);
      else XB_SPIN(xb_ld(&bar[XB_TOPGEN]) == tg, bar);
      __builtin_amdgcn_fence(__ATOMIC_ACQUIRE, "agent");
      xb_add(&bar[XB_XGEN(b.x)], 1u);
      asm volatile("s_waitcnt vmcnt(0)" ::: "memory");
    } else {
      XB_SPIN(xb_ld(&bar[XB_XGEN(b.x)]) == gen, bar);
      __builtin_amdgcn_fence(__ATOMIC_ACQUIRE, "agent");
      asm volatile("s_waitcnt vmcnt(0)" ::: "memory");
    }
  }
  __syncthreads();
}
#ifndef CG_ALL
#define BSYNC() do { asm volatile("" ::: "memory"); xcd_barrier(xb); asm volatile("" ::: "memory"); } while (0)
#else
#define BSYNC() GSYNC()
#endif
__global__ void __launch_bounds__(NTHREADS, 2) fwd_kernel(Params P) {
  __shared__ __attribute__((aligned(16))) char lds[LDS_BYTES + LDS_CTL];
  int* const s_unit_p = (int*)(lds + LDS_BYTES);
  if (threadIdx.x == 0) *(uint4*)(lds + LDS_BYTES + 16) = make_uint4(0u, 0u, 0u, 0u);
  __syncthreads();
  const XcdBarrier xb = xcd_barrier_post((unsigned*)(P.ws + OFF_BAR), (volatile LAS unsigned*)(lds + LDS_BYTES + 16));
  if (P.pad_ == 0x5eed) GSYNC();
  run_phase<0>(P, 0, lds, s_unit_p); BSYNC();
  for (int l = 0; l < DEPTH; ++l) {
    run_phase<1>(P, l, lds, s_unit_p); BSYNC();
#if REPEAT == 1
    run_phase<1>(P, l, lds, s_unit_p, 1); BSYNC();
#endif
    run_phase<2>(P, l, lds, s_unit_p); BSYNC();
    run_phase<4>(P, l, lds, s_unit_p); BSYNC();
    run_phase<5>(P, l, lds, s_unit_p); if (l + 1 < DEPTH) BSYNC();
  }
}
#endif

extern "C" void kernel_launch(void* const* d_in, const int* in_sizes, int n_in, void* d_out, int out_size, void* d_ws, size_t ws_size, hipStream_t stream) {
  static int grid_blocks = 0;
  if (!grid_blocks) {
    int dev = 0, cus = 0, per_cu = 0;
    (void)hipGetDevice(&dev);
    (void)hipDeviceGetAttribute(&cus, hipDeviceAttributeMultiprocessorCount, dev);
#if COOP
    (void)hipOccupancyMaxActiveBlocksPerMultiprocessor(&per_cu, fwd_kernel, NTHREADS, 0);
#else
    per_cu = 2;
#endif
    if (per_cu < 1) per_cu = 1;
    if (per_cu > 2) per_cu = 2;
    if (cus < 1) cus = 256;
    grid_blocks = cus * per_cu;
  }
  if (n_in != 17 || ws_size < WS_NEED) { fprintf(stderr, "kernel_launch: unexpected inputs (%d) or workspace (%zu)\n", n_in, ws_size); return; }
  Params p{};
  p.x = (const float*)d_in[0]; p.w_in = (const float*)d_in[1]; p.b_fox_f = (const float*)d_in[2]; p.pos_k = (const float*)d_in[3]; p.pos_v = (const float*)d_in[4];
  p.w1_k = (const float*)d_in[5]; p.w2_k = (const float*)d_in[6]; p.w1_v = (const float*)d_in[7]; p.w2_v = (const float*)d_in[8];
  p.lq1 = (const float*)d_in[9]; p.lk1 = (const float*)d_in[10]; p.lq2 = (const float*)d_in[11]; p.lk2 = (const float*)d_in[12];
  p.subln_g = (const float*)d_in[13]; p.w_out = (const float*)d_in[14]; p.ln_g = (const float*)d_in[15]; p.ln_b = (const float*)d_in[16];
  p.out = (float*)d_out; p.ws = (char*)d_ws;
  (void)hipMemsetAsync((char*)d_ws + OFF_CTR, 0, 4096, stream);
  (void)hipMemsetAsync((char*)d_ws + OFF_BAR, 0, CTL_ZERO_BYTES - OFF_BAR, stream);
#if COOP
  void* args[] = {&p};
  hipError_t e = hipLaunchCooperativeKernel((void*)fwd_kernel, dim3(grid_blocks), dim3(NTHREADS), args, 0, stream);
  if (e != hipSuccess) fprintf(stderr, "cooperative launch failed: %s (grid %d)\n", hipGetErrorString(e), grid_blocks);
#else
  const dim3 g(grid_blocks), b(NTHREADS);
  hipLaunchKernelGGL(phase_kernel<0>, g, b, 0, stream, p, 0);
  for (int l = 0; l < DEPTH; ++l) {
    hipLaunchKernelGGL(phase_kernel<1>, g, b, 0, stream, p, l);
    hipLaunchKernelGGL(phase_kernel<2>, g, b, 0, stream, p, l);
    hipLaunchKernelGGL(phase_kernel<4>, g, b, 0, stream, p, l);
    hipLaunchKernelGGL(phase_kernel<5>, g, b, 0, stream, p, l);
  }
#endif
}
```

```cpp
#include <hip/hip_runtime.h>
#include <hip/hip_cooperative_groups.h>
#include <stdint.h>
#include <cstdio>
namespace cg = cooperative_groups;

#ifndef COOP
#define COOP 1
#endif
#ifndef REPEAT
#define REPEAT 0
#endif

#define DI __device__ __forceinline__
typedef unsigned short bf16_t;
typedef short bf16x8 __attribute__((ext_vector_type(8)));
typedef short s16x4 __attribute__((ext_vector_type(4)));
typedef float f32x16 __attribute__((ext_vector_type(16)));
typedef float f32x4 __attribute__((ext_vector_type(4)));
typedef float f32x2 __attribute__((ext_vector_type(2)));
typedef unsigned u32x4 __attribute__((ext_vector_type(4)));
typedef unsigned u32x2 __attribute__((ext_vector_type(2)));
typedef __bf16 bf16x2_t __attribute__((ext_vector_type(2)));

#define MFMA32(a, b, c) __builtin_amdgcn_mfma_f32_32x32x16_bf16((a), (b), (c), 0, 0, 0)

constexpr int BATCH = 2, SEQ = 8192, DMODEL = 1024, MTOK = BATCH * SEQ, NIN = 3868, NPAD = 3968, DEPTH = 2;
constexpr float LOG2E = 1.4426950408889634f;
constexpr float NEGBIG = -1e30f;
constexpr float MINIT = -1e20f;
constexpr int NTHREADS = 256;

constexpr size_t MiB = 1u << 20;
constexpr size_t OFF_CTR = 0, OFF_LAM = 4096, OFF_B1 = 8192, OFF_BAR = 16384, CTL_ZERO_BYTES = 32768;
constexpr size_t OFF_ROPE64 = 1 * MiB, OFF_ROPE32 = 3 * MiB, OFF_WIN = 4 * MiB, OFF_WOUT = 20 * MiB, OFF_W1T = 24 * MiB;
constexpr size_t OFF_XB = 26 * MiB, OFF_G = 58 * MiB, OFF_MIX = 90 * MiB;
constexpr size_t OFF_QF = 122 * MiB, OFF_KF = 130 * MiB, OFF_VFT = 138 * MiB, OFF_QN = 146 * MiB;
constexpr size_t OFF_KCT = 162 * MiB, OFF_VCT = 166 * MiB, OFF_KS = 170 * MiB, OFF_VST = 174 * MiB, OFF_KW = 178 * MiB, OFF_VWT = 182 * MiB;
constexpr size_t OFF_QD = 186 * MiB, OFF_KD = 194 * MiB, OFF_VDT = 202 * MiB;
constexpr size_t OFF_LOGF = 210 * MiB, OFF_CUM = 210 * MiB + 256 * 1024, OFF_GATES = 211 * MiB;
constexpr size_t OFF_KC = 213 * MiB, OFF_VCC = 213 * MiB + 256 * 1024, WS_NEED = 214 * MiB;

constexpr int LDS_BYTES = 73728, LDS_CTL = 32;
constexpr int ATT_BUF = 18944, ATT_V = 9216, ATT_C = 18432;
constexpr int LDS_IMP = 3 * ATT_BUF, LDS_SEL = LDS_BYTES - 512;
static_assert(LDS_IMP + 16384 <= LDS_SEL, "LDS map");
constexpr int GEMM_AB = 18432;

struct Params {
  const float *x, *w_in, *b_fox_f, *pos_k, *pos_v, *w1_k, *w2_k, *w1_v, *w2_v, *lq1, *lk1, *lq2, *lk2, *subln_g, *w_out, *ln_g, *ln_b;
  float* out;
  char* ws;
  long pad_;
};

DI unsigned short f2bf(float f) { unsigned u = __float_as_uint(f); return (unsigned short)((u + 0x7fffu + ((u >> 16) & 1u)) >> 16); }
DI unsigned pk2(float lo, float hi) { f32x2 v = {lo, hi}; bf16x2_t b = __builtin_convertvector(v, bf16x2_t); return __builtin_bit_cast(unsigned, b); }
DI float silu(float x) { return x / (1.f + __expf(-x)); }
DI float sigmoidf(float x) { return 1.f / (1.f + __expf(-x)); }
DI float ex2(float x) { return __builtin_amdgcn_exp2f(x); }
DI float xhalf_max(float v) { auto rr = __builtin_amdgcn_permlane32_swap(__float_as_uint(v), __float_as_uint(v), false, false); return fmaxf(__uint_as_float(rr[0]), __uint_as_float(rr[1])); }
DI float xhalf_sum(float v) { auto rr = __builtin_amdgcn_permlane32_swap(__float_as_uint(v), __float_as_uint(v), false, false); return __uint_as_float(rr[0]) + __uint_as_float(rr[1]); }
DI int crow(int i, int h) { return (i & 3) + 8 * (i >> 2) + 4 * h; }

DI int get_tid() { int t = threadIdx.x; asm volatile("" : "+v"(t)); return t; }
DI int orig_col(int n) {
  int s = n >> 6, c = n & 63;
  if (s < 4) return s * 64 + c;
  if (s < 8) return 256 + (s - 4) * 64 + c;
  if (s < 12) return 512 + (s - 8) * 64 + c;
  if (s < 16) return 772 + (s - 12) * 64 + c;
  if (s < 24) return 1028 + (s - 16) * 64 + c;
  if (s < 36) return 1540 + (s - 24) * 64 + c;
  if (s < 44) return 2332 + (s - 36) * 64 + c;
  if (s < 52) { int base = 2844 + (s - 44) * 64; int nt = c >> 5, r = c & 31, comp = r >> 4, i = r & 15; return base + comp * 32 + nt * 16 + i; }
  if (s < 60) return 3356 + (s - 52) * 64 + c;
  if (s == 60) { if (c < 4) return 768 + c; if (c < 28) return 2308 + (c - 4); return -1; }
  return -1;
}

DI void p0_prologue(const Params& P) {
  const long gtid = (long)blockIdx.x * NTHREADS + get_tid(), gsz = (long)gridDim.x * NTHREADS;
  char* ws = P.ws;
  if (gtid < DEPTH) {
    int l = (int)gtid; float a = 0.f, b = 0.f;
    for (int i = 0; i < 32; ++i) { a += P.lq1[l * 32 + i] * P.lk1[l * 32 + i]; b += P.lq2[l * 32 + i] * P.lk2[l * 32 + i]; }
    float lam_init = 0.8f - 0.6f * expf(-0.3f * (float)l);
    ((float*)(ws + OFF_LAM))[l] = expf(a) - expf(b) + lam_init;
    ((float*)(ws + OFF_LAM))[2 + l] = lam_init;
  }
  if (gtid < DEPTH * 2 * 128 * 16) {
    const int it = (int)(gtid >> 4), part = (int)(gtid & 15);
    const int j = it & 127, kv = (it >> 7) & 1, l = it >> 8;
    const float* pos = (kv ? P.pos_v : P.pos_k) + (size_t)l * 2048 + part * 128;
    const float* w1 = (kv ? P.w1_v : P.w1_k) + (size_t)l * 2048 * 128 + (size_t)part * 128 * 128 + j;
    float a = 0.f;
#pragma unroll 16
    for (int k = 0; k < 128; ++k) a += pos[k] * w1[(size_t)k * 128];
    a += __shfl_xor(a, 1); a += __shfl_xor(a, 2); a += __shfl_xor(a, 4); a += __shfl_xor(a, 8);
    if (part == 0) ((float*)(ws + OFF_B1))[it] = a;
  }
  { const long NIT = (long)DEPTH * 128 * NPAD;
    for (long it0 = gtid; it0 < NIT; it0 += 2 * gsz) {
      float f[2][8]; int ocs[2]; size_t dsto[2]; bool ok[2];
#pragma unroll
      for (int q = 0; q < 2; ++q) { const long it = it0 + q * gsz; ok[q] = it < NIT; const long itc = ok[q] ? it : it0;
        const int n = (int)(itc % NPAD); const int k8 = (int)((itc / NPAD) & 127); const int l = (int)(itc / ((long)NPAD * 128));
        ocs[q] = orig_col(n); dsto[q] = ((size_t)l * NPAD + n) * DMODEL + k8 * 8;
        const float* src = P.w_in + (size_t)l * DMODEL * NIN + (size_t)(k8 * 8) * NIN + (ocs[q] >= 0 ? ocs[q] : 0);
#pragma unroll
        for (int j = 0; j < 8; ++j) f[q][j] = src[(size_t)j * NIN]; }
#pragma unroll
      for (int q = 0; q < 2; ++q) if (ok[q]) { u32x4 v = {0u, 0u, 0u, 0u};
        if (ocs[q] >= 0) { v.x = pk2(f[q][0], f[q][1]); v.y = pk2(f[q][2], f[q][3]); v.z = pk2(f[q][4], f[q][5]); v.w = pk2(f[q][6], f[q][7]); }
        *(u32x4*)((bf16_t*)(ws + OFF_WIN) + dsto[q]) = v; }
    } }
  for (long it = gtid; it < (long)DEPTH * 128 * 1024; it += gsz) {
    int n = (int)(it & 1023); int k8 = (int)((it >> 10) & 127); int l = (int)(it >> 17);
    const float* src = P.w_out + (size_t)l * 1024 * 1024 + (size_t)(k8 * 8) * 1024 + n;
    float f[8];
#pragma unroll
    for (int j = 0; j < 8; ++j) f[j] = src[(size_t)j * 1024];
    u32x4 v; v.x = pk2(f[0], f[1]); v.y = pk2(f[2], f[3]); v.z = pk2(f[4], f[5]); v.w = pk2(f[6], f[7]);
    *(u32x4*)((bf16_t*)(ws + OFF_WOUT) + ((size_t)l * 1024 + n) * 1024 + k8 * 8) = v;
  }
  for (long it = gtid; it < (long)DEPTH * 2 * 256 * 128; it += gsz) {
    int j = (int)(it & 127); int k8 = (int)((it >> 7) & 255); int kv = (int)((it >> 15) & 1); int l = (int)(it >> 16);
    const float* src = (kv ? P.w1_v : P.w1_k) + (size_t)l * 2048 * 128 + (size_t)(k8 * 8) * 128 + j;
    float f[8];
#pragma unroll
    for (int jj = 0; jj < 8; ++jj) f[jj] = src[(size_t)jj * 128];
    u32x4 v; v.x = pk2(f[0], f[1]); v.y = pk2(f[2], f[3]); v.z = pk2(f[4], f[5]); v.w = pk2(f[6], f[7]);
    *(u32x4*)((bf16_t*)(ws + OFF_W1T) + (((size_t)l * 2 + kv) * 128 + j) * 2048 + k8 * 8) = v;
  }
  { const long NIT = (long)MTOK * DMODEL / 8;
    for (long it0 = gtid; it0 < NIT; it0 += 4 * gsz) {
      f32x4 a[4], b[4];
#pragma unroll
      for (int q = 0; q < 4; ++q) { const long it = it0 + q * gsz; const long itc = it < NIT ? it : it0; const f32x4* src = (const f32x4*)P.x + itc * 2; a[q] = src[0]; b[q] = src[1]; }
#pragma unroll
      for (int q = 0; q < 4; ++q) { const long it = it0 + q * gsz; if (it < NIT) {
        u32x4 v; v.x = pk2(a[q][0], a[q][1]); v.y = pk2(a[q][2], a[q][3]); v.z = pk2(b[q][0], b[q][1]); v.w = pk2(b[q][2], b[q][3]);
        *((u32x4*)(ws + OFF_XB) + it) = v; } }
    } }
}

#define LDSAS __attribute__((address_space(3)))
DI void glds16(const char* gsrc, char* ldst) {
  __builtin_amdgcn_global_load_lds((const unsigned*)gsrc, (LDSAS unsigned*)ldst, 16, 0, 0);
}
DI void gemm_mainloop(const bf16_t* A, long lda, int a_row_max, const bf16_t* Bt, long ldb, int K, char* lds, f32x16 (&acc)[2][2]) {
  const int tid = get_tid(), lane = tid & 63, wave = __builtin_amdgcn_readfirstlane(tid >> 6), wm = wave >> 1, wn = wave & 1, r = lane & 31, h = lane >> 5;
#pragma unroll
  for (int a = 0; a < 2; ++a)
#pragma unroll
    for (int b = 0; b < 2; ++b)
#pragma unroll
      for (int i = 0; i < 16; ++i) acc[a][b][i] = 0.f;
  const char* ga[4]; const char* gb[4];
#pragma unroll
  for (int i = 0; i < 4; ++i) { const int row = 32 * wave + 8 * i + (lane >> 3), ch = (lane & 7) ^ ((row >> 1) & 7); const int ar = row < a_row_max ? row : a_row_max;
    ga[i] = (const char*)(A + (long)ar * lda) + ch * 16; gb[i] = (const char*)(Bt + (long)row * ldb) + ch * 16; }
  char* const ldw = lds + (32 * wave) * 128;
  const int nk = K >> 6;
#define GEMM_STAGE(BUF, KT) do { _Pragma("unroll") for (int i = 0; i < 4; ++i) { \
    glds16(ga[i] + (long)(KT) * 128, ldw + (BUF) * 32768 + i * 1024); glds16(gb[i] + (long)(KT) * 128, ldw + (BUF) * 32768 + 16384 + i * 1024); } } while (0)
  __syncthreads();
  GEMM_STAGE(0, 0);
  asm volatile("s_waitcnt vmcnt(0)" ::: "memory");
  __syncthreads();
  const int sw = (r >> 1) & 7;
  const unsigned lds0 = (unsigned)(uintptr_t)lds;
  unsigned aa[4], ab[4];
#pragma unroll
  for (int ks = 0; ks < 4; ++ks) { const unsigned xo = (unsigned)(((2 * ks + h) ^ sw) * 16);
    aa[ks] = lds0 + (unsigned)((64 * wm + r) * 128) + xo; ab[ks] = lds0 + 16384u + (unsigned)((64 * wn + r) * 128) + xo; }
  bf16x8 xa0, xa1, xb0, xb1, ya0, ya1, yb0, yb1, za0, za1, zb0, zb1;
#define KT_RD(S, K, O0, O1) \
    "ds_read_b128 %[" #S "a0], %[aa" #K "] offset:" O0 "\n\tds_read_b128 %[" #S "b0], %[ab" #K "] offset:" O0 "\n\t" \
    "ds_read_b128 %[" #S "a1], %[aa" #K "] offset:" O1 "\n\tds_read_b128 %[" #S "b1], %[ab" #K "] offset:" O1 "\n\t"
#define KT_MM(S) \
    "v_mfma_f32_32x32x16_bf16 %[c00], %[" #S "a0], %[" #S "b0], %[c00]\n\tv_mfma_f32_32x32x16_bf16 %[c01], %[" #S "a0], %[" #S "b1], %[c01]\n\t" \
    "v_mfma_f32_32x32x16_bf16 %[c10], %[" #S "a1], %[" #S "b0], %[c10]\n\tv_mfma_f32_32x32x16_bf16 %[c11], %[" #S "a1], %[" #S "b1], %[c11]\n\t"
#define KT_ASM(O0, O1) asm volatile( \
    "s_waitcnt lgkmcnt(0)\n\t" \
    KT_RD(x, 0, O0, O1) KT_RD(y, 1, O0, O1) \
    "s_waitcnt lgkmcnt(4)\n\t" KT_MM(x) KT_RD(z, 2, O0, O1) \
    "s_waitcnt lgkmcnt(4)\n\t" KT_MM(y) KT_RD(x, 3, O0, O1) \
    "s_waitcnt lgkmcnt(4)\n\t" KT_MM(z) \
    "s_waitcnt lgkmcnt(0)\n\t" KT_MM(x) \
    : [c00] "+v"(acc[0][0]), [c01] "+v"(acc[0][1]), [c10] "+v"(acc[1][0]), [c11] "+v"(acc[1][1]), \
      [xa0] "=&v"(xa0), [xa1] "=&v"(xa1), [xb0] "=&v"(xb0), [xb1] "=&v"(xb1), [ya0] "=&v"(ya0), [ya1] "=&v"(ya1), [yb0] "=&v"(yb0), [yb1] "=&v"(yb1), \
      [za0] "=&v"(za0), [za1] "=&v"(za1), [zb0] "=&v"(zb0), [zb1] "=&v"(zb1) \
    : [aa0] "v"(aa[0]), [aa1] "v"(aa[1]), [aa2] "v"(aa[2]), [aa3] "v"(aa[3]), [ab0] "v"(ab[0]), [ab1] "v"(ab[1]), [ab2] "v"(ab[2]), [ab3] "v"(ab[3]) \
    : "memory")
  for (int kt = 0; kt < nk; kt += 2) {
    GEMM_STAGE(1, kt + 1);
    KT_ASM("0", "4096");
    asm volatile("s_waitcnt vmcnt(0)" ::: "memory");
    __syncthreads();
    if (kt + 2 < nk) GEMM_STAGE(0, kt + 2);
    KT_ASM("32768", "36864");
    asm volatile("s_waitcnt vmcnt(0)" ::: "memory");
    __syncthreads();
  }
  asm volatile("s_nop 15\n\ts_nop 7" : "+v"(acc[0][0]), "+v"(acc[0][1]), "+v"(acc[1][0]), "+v"(acc[1][1]));
#undef KT_RD
#undef KT_MM
#undef KT_ASM
#undef GEMM_STAGE
}

DI bool xcd_tile(int i, int NT, int& mt, int& nt) {
  const int G = gridDim.x;
  if ((G & 7) == 0 && G >= 8) {
    const int x = blockIdx.x & 7, j = blockIdx.x >> 3, per = G >> 3;
    const int u = j + per * i; if (u >= 16 * NT) return false;
    const int grp = u / (8 * NT), v = u - grp * (8 * NT);
    mt = 16 * x + 8 * grp + (v & 7); nt = v >> 3; return true;
  }
  const int t = blockIdx.x + G * i; if (t >= 128 * NT) return false;
  mt = t / NT; nt = t - mt * NT; return true;
}

DI void epi_inproj(const Params& P, int l, const f32x16 (&acc)[2][2], int m0, int n0, char* lds) {
  const int tid = get_tid(), lane = tid & 63, wave = tid >> 6, wm = wave >> 1, wn = wave & 1, r = lane & 31, h = lane >> 5;
  char* ws = P.ws;
  const int slot = (n0 >> 6) + wn;
  const int b = m0 >> 13;
  const int srow0 = (m0 & (SEQ - 1)) + 64 * wm;
  int cat = 0;
  int rope = 0; float scale = 1.f; bf16_t* dst = nullptr; int gcol = 0;
  const float QS = 0.125f * LOG2E;
  if (slot < 4) { cat = 1; scale = QS; dst = (bf16_t*)(ws + OFF_QF) + (size_t)(b * 4 + slot) * SEQ * 64; }
  else if (slot < 8) { cat = 1; dst = (bf16_t*)(ws + OFF_KF) + (size_t)(b * 4 + slot - 4) * SEQ * 64; }
  else if (slot < 12) { cat = 2; dst = (bf16_t*)(ws + OFF_VFT) + (size_t)(b * 4 + slot - 8) * SEQ * 64; }
  else if (slot < 16) { cat = 3; gcol = (slot - 12) * 64; }
  else if (slot < 24) { cat = 1; rope = 1; scale = QS; dst = (bf16_t*)(ws + OFF_QN) + (size_t)(b * 8 + slot - 16) * SEQ * 64; }
  else if (slot < 26) { cat = 1; rope = 1; dst = (bf16_t*)(ws + OFF_KCT) + (size_t)(b * 2 + slot - 24) * SEQ * 64; }
  else if (slot < 28) { cat = 1; dst = (bf16_t*)(ws + OFF_VCT) + (size_t)(b * 2 + slot - 26) * SEQ * 64; }
  else if (slot < 30) { cat = 1; rope = 1; dst = (bf16_t*)(ws + OFF_KS) + (size_t)(b * 2 + slot - 28) * SEQ * 64; }
  else if (slot < 32) { cat = 2; dst = (bf16_t*)(ws + OFF_VST) + (size_t)(b * 2 + slot - 30) * SEQ * 64; }
  else if (slot < 34) { cat = 1; rope = 1; dst = (bf16_t*)(ws + OFF_KW) + (size_t)(b * 2 + slot - 32) * SEQ * 64; }
  else if (slot < 36) { cat = 2; dst = (bf16_t*)(ws + OFF_VWT) + (size_t)(b * 2 + slot - 34) * SEQ * 64; }
  else if (slot < 44) { cat = 3; gcol = 256 + (slot - 36) * 64; }
  else if (slot < 48) { cat = 1; rope = 2; scale = 0.17677669529663687f * LOG2E; dst = (bf16_t*)(ws + OFF_QD) + (size_t)(b * 4 + slot - 44) * SEQ * 64; }
  else if (slot < 52) { cat = 1; rope = 2; dst = (bf16_t*)(ws + OFF_KD) + (size_t)(b * 4 + slot - 48) * SEQ * 64; }
  else if (slot < 56) { cat = 2; dst = (bf16_t*)(ws + OFF_VDT) + (size_t)(b * 4 + slot - 52) * SEQ * 64; }
  else if (slot < 60) { cat = 3; gcol = 768 + (slot - 56) * 64; }
  else if (slot == 60) cat = 4;

  if (cat == 1 || cat == 3) {
    unsigned short* wl = (unsigned short*)(lds + wave * 8192);
    int c0 = r, c1 = 32 + r;
    float crev = 0.f;
    if (rope == 1) crev = __builtin_amdgcn_exp2f(-(float)r * (13.287712379549449f / 32.f)) * 0.15915494309189535f;
    if (rope == 2) { int comp = r >> 4, ii = r & 15; c0 = comp * 32 + ii; c1 = comp * 32 + 16 + ii; crev = __builtin_amdgcn_exp2f(-(float)ii * (13.287712379549449f / 16.f)) * 0.15915494309189535f; }
#pragma unroll
    for (int mt = 0; mt < 2; ++mt)
#pragma unroll
      for (int i = 0; i < 16; ++i) {
        const int rowl = 32 * mt + crow(i, h);
        float v0 = acc[mt][0][i], v1 = acc[mt][1][i];
        if (cat == 3) { v0 = silu(v0); v1 = silu(v1); }
        else {
          if (rope) { const float fr = __builtin_amdgcn_fractf((float)(srow0 + rowl) * crev); const float cs = __builtin_amdgcn_cosf(fr), sn = __builtin_amdgcn_sinf(fr);
            const float y0 = v0 * cs - v1 * sn, y1 = v1 * cs + v0 * sn; v0 = y0; v1 = y1; }
          v0 *= scale; v1 *= scale;
        }
        wl[rowl * 64 + c0] = f2bf(v0); wl[rowl * 64 + c1] = f2bf(v1);
      }
    bf16_t* obase = (cat == 1) ? (dst + (size_t)srow0 * 64) : ((bf16_t*)(ws + OFF_G) + ((size_t)m0 + 64 * wm) * 1024 + gcol);
    const size_t opitch = (cat == 1) ? 64 : 1024;
#pragma unroll
    for (int k = 0; k < 8; ++k) { const int rowl = (lane >> 3) + 8 * k, ch = lane & 7;
      const u32x4 v = *(const u32x4*)((const char*)wl + rowl * 128 + ch * 16);
      *(u32x4*)(obase + (size_t)rowl * opitch + ch * 8) = v; }
  } else if (cat == 2) {
#pragma unroll
    for (int mt = 0; mt < 2; ++mt)
#pragma unroll
      for (int g = 0; g < 4; ++g) {
        int s = srow0 + 32 * mt + 8 * g + 4 * h;
#pragma unroll
        for (int nt = 0; nt < 2; ++nt) {
          u32x2 v; v.x = pk2(acc[mt][nt][4 * g], acc[mt][nt][4 * g + 1]); v.y = pk2(acc[mt][nt][4 * g + 2], acc[mt][nt][4 * g + 3]);
          *(u32x2*)(dst + (size_t)(32 * nt + r) * SEQ + s) = v;
        }
      }
  } else if (cat == 4) {
    if (r < 28) {
      float bias = (r < 4) ? P.b_fox_f[l * 4 + r] : 0.f;
#pragma unroll
      for (int mt = 0; mt < 2; ++mt)
#pragma unroll
        for (int i = 0; i < 16; ++i) {
          int s = srow0 + 32 * mt + crow(i, h);
          float v = acc[mt][0][i];
          if (r < 4) { float xx = v + bias; float ls = fminf(xx, 0.f) - log1pf(expf(-fabsf(xx)));
            ((float*)(ws + OFF_LOGF))[(size_t)(b * 4 + r) * SEQ + s] = ls * LOG2E; }
          else ((float*)(ws + OFF_GATES))[((size_t)b * SEQ + s) * 24 + (r - 4)] = sigmoidf(v);
        }
    }
  }
}

DI void p1_inproj(const Params& P, int l, char* lds) {
  const bf16_t* A = (const bf16_t*)(P.ws + OFF_XB);
  const bf16_t* Bt = (const bf16_t*)(P.ws + OFF_WIN) + (size_t)l * NPAD * DMODEL;
  const int NT = NPAD / 128;
  int mt, nt;
  for (int i = 0; xcd_tile(i, NT, mt, nt); ++i) {
    f32x16 acc[2][2];
    gemm_mainloop(A + (size_t)mt * 128 * DMODEL, DMODEL, 127, Bt + (size_t)nt * 128 * DMODEL, DMODEL, DMODEL, lds, acc);
    epi_inproj(P, l, acc, mt * 128, nt * 128, lds);
  }
}

DI void p4_outproj(const Params& P, int l, char* lds) {
  const bf16_t* A = (const bf16_t*)(P.ws + OFF_MIX);
  const bf16_t* Bt = (const bf16_t*)(P.ws + OFF_WOUT) + (size_t)l * 1024 * 1024;
  const float* xres = (l == 0) ? P.x : P.out;
  const float alpha = 1.4142135623730951f;
  const int tid = get_tid(), lane = tid & 63, wave = tid >> 6, wm = wave >> 1, wn = wave & 1, r = lane & 31, h = lane >> 5;
  int mt, nt;
  for (int i = 0; xcd_tile(i, 8, mt, nt); ++i) {
    f32x16 acc[2][2];
    gemm_mainloop(A + (size_t)mt * 128 * 1024, 1024, 127, Bt + (size_t)nt * 128 * 1024, 1024, 1024, lds, acc);
    { float* wl = (float*)(lds + wave * 16384);
#pragma unroll
      for (int a = 0; a < 2; ++a)
#pragma unroll
        for (int bb = 0; bb < 2; ++bb)
#pragma unroll
          for (int i = 0; i < 16; ++i) wl[(32 * a + crow(i, h)) * 64 + 32 * bb + r] = acc[a][bb][i];
      const size_t gbase = ((size_t)mt * 128 + 64 * wm) * 1024 + nt * 128 + 64 * wn;
#pragma unroll
      for (int k = 0; k < 16; ++k) { const int rowl = (lane >> 4) + 4 * k, ch = lane & 15;
        const f32x4 m = *(const f32x4*)(wl + rowl * 64 + ch * 4);
        const f32x4 x = *(const f32x4*)(xres + gbase + (size_t)rowl * 1024 + ch * 4);
        *(f32x4*)(P.out + gbase + (size_t)rowl * 1024 + ch * 4) = alpha * x + m; }
    }
  }
}

DI void p5_ln(const Params& P, int l) {
  const int lane = get_tid() & 63, wave = get_tid() >> 6;
  const float* g = P.ln_g + l * 1024; const float* bb = P.ln_b + l * 1024;
  for (int row = blockIdx.x * 4 + wave; row < MTOK; row += gridDim.x * 4) {
    float* p = P.out + (size_t)row * 1024;
    f32x4 v[4]; float s = 0.f;
#pragma unroll
    for (int k = 0; k < 4; ++k) { v[k] = *(const f32x4*)(p + k * 256 + lane * 4); s += v[k][0] + v[k][1] + v[k][2] + v[k][3]; }
#pragma unroll
    for (int o = 32; o >= 1; o >>= 1) s += __shfl_xor(s, o);
    float mean = s * (1.f / 1024.f); float q = 0.f;
#pragma unroll
    for (int k = 0; k < 4; ++k)
#pragma unroll
      for (int e = 0; e < 4; ++e) { float d = v[k][e] - mean; q += d * d; }
#pragma unroll
    for (int o = 32; o >= 1; o >>= 1) q += __shfl_xor(q, o);
    float rstd = rsqrtf(q * (1.f / 1024.f) + 1e-5f);
#pragma unroll
    for (int k = 0; k < 4; ++k) {
      int c = k * 256 + lane * 4; f32x4 gg = *(const f32x4*)(g + c), bv = *(const f32x4*)(bb + c); f32x4 o;
#pragma unroll
      for (int e = 0; e < 4; ++e) o[e] = (v[k][e] - mean) * rstd * gg[e] + bv[e];
      *(f32x4*)(p + c) = o;
      if (l + 1 < DEPTH) {
        u32x2 w; w.x = pk2(o[0], o[1]); w.y = pk2(o[2], o[3]);
        *(u32x2*)((bf16_t*)(P.ws + OFF_XB) + (size_t)row * 1024 + c) = w; }
    }
  }
}

enum { M_FOX = 0, M_DIFF = 1, M_CMP1 = 2, M_CMP2 = 3, M_SEL = 4, M_WIN = 5 };
struct AttnState { f32x16 o[2]; float m, l; };
struct TileSrc { const bf16_t* K; const bf16_t* Vt; long vstride; const float* C; };

template <bool HASV, bool HASC>
DI void tile_gload(const TileSrc& s, int T, u32x4 (&rk)[2], u32x4 (&rv)[2], f32x4& rc, int tid) {
#pragma unroll
  for (int p = 0; p < 2; ++p) { int id = tid + 256 * p, row = id >> 3, ch = id & 7;
    rk[p] = *(const u32x4*)(s.K + ((long)(64 * T + row)) * 64 + ch * 8);
    if (HASV) rv[p] = *(const u32x4*)(s.Vt + (long)row * s.vstride + 64 * T + ch * 8); }
  if (HASC) { if (tid < 16) rc = *(const f32x4*)(s.C + 64 * T + 4 * tid); }
}
template <bool HASV, bool HASC>
DI void tile_sstore(char* buf, const u32x4 (&rk)[2], const u32x4 (&rv)[2], const f32x4& rc, int tid) {
#pragma unroll
  for (int p = 0; p < 2; ++p) { int id = tid + 256 * p, row = id >> 3, ch = id & 7;
    *(u32x4*)(buf + row * 144 + ch * 16) = rk[p];
    if (HASV) { char* d = buf + ATT_V + row * 136 + ch * 16; u32x2 a = {rv[p].x, rv[p].y}, b = {rv[p].z, rv[p].w}; *(u32x2*)d = a; *(u32x2*)(d + 8) = b; } }
  if (HASC) { if (tid < 16) *(f32x4*)(buf + ATT_C + tid * 16) = -rc; }
}

constexpr float MREF0 = -32.f;
constexpr float RSUM = 1099511627776.f;

template <int MODE>
DI void qk_part(f32x16 (&p)[2], const bf16x8* qf, const char* buf, int koffb, const f32x16& negm, int r, int h) {
  constexpr int ND0 = (MODE == M_DIFF) ? 2 : 4;
  const char* kl = buf; const float* cl = (const float*)(buf + ATT_C);
  if (MODE == M_FOX) {
    const float nm = negm[0];
#pragma unroll
    for (int c = 0; c < 2; ++c)
#pragma unroll
      for (int g = 0; g < 4; ++g) { f32x4 ck = *(const f32x4*)(cl + 32 * c + 8 * g + 4 * h);
#pragma unroll
        for (int e = 0; e < 4; ++e) p[c][4 * g + e] = ck[e] + nm; }
  }
#pragma unroll
  for (int d0 = 0; d0 < ND0; ++d0) {
    const char* kp = kl + r * 144 + koffb + (16 * d0 + 8 * h) * 2;
    bf16x8 k0 = *(const bf16x8*)kp; bf16x8 k1 = *(const bf16x8*)(kp + 32 * 144);
    if (MODE != M_FOX && d0 == 0) { p[0] = MFMA32(k0, qf[d0], negm); p[1] = MFMA32(k1, qf[d0], negm); }
    else { p[0] = MFMA32(k0, qf[d0], p[0]); p[1] = MFMA32(k1, qf[d0], p[1]); }
  }
}

template <int MODE>
DI void sp_part(AttnState& st, f32x16 (&p)[2], f32x16& negm, const char* buf, int T, int tq, unsigned selbit,
                float inv_l, unsigned* imp_q, int r, int h) {
  const char* vl = buf + ATT_V;
  const int kvb = 64 * T + 4 * h;
  int lim, lo;
  if (MODE == M_CMP1 || MODE == M_CMP2) { lim = (tq - 31) >> 4; lo = -(1 << 30); }
  else if (MODE == M_SEL) { lim = selbit ? tq : -1; lo = -(1 << 30); }
  else if (MODE == M_WIN) { lim = tq; lo = tq - 511; }
  else { lim = tq; lo = -(1 << 30); }
  const bool full = (lim >= 64 * T + 63) && (lo <= 64 * T);
  bool lane_on = true; bool sel_interior = false;
  if (MODE == M_SEL) sel_interior = __all(tq >= 64 * T + 63) != 0;
  if (sel_interior) lane_on = (selbit != 0u);
  else if (!__all(full)) {
#pragma unroll
    for (int c = 0; c < 2; ++c)
#pragma unroll
      for (int i = 0; i < 16; ++i) { int kv = kvb + 32 * c + 8 * (i >> 2) + (i & 3); if (kv > lim || kv < lo) p[c][i] = NEGBIG; }
  }
  float tile_sum = 0.f;
  if (MODE == M_CMP2) {
#pragma unroll
    for (int c = 0; c < 2; ++c)
#pragma unroll
      for (int i = 0; i < 16; ++i) p[c][i] = ex2(p[c][i]) * inv_l;
#pragma unroll
    for (int c = 0; c < 2; ++c)
#pragma unroll
      for (int g = 0; g < 4; ++g) {
        int j = 16 * T + 8 * c + 2 * g + h;
        float bq = 0.5f * p[c][4 * g + 3]; float aq = p[c][4 * g] + p[c][4 * g + 1] + p[c][4 * g + 2] + bq;
        atomicAdd(&imp_q[j * 32], (unsigned)(aq * 4194304.f + 0.5f));
        if (j + 1 < 128) atomicAdd(&imp_q[(j + 1) * 32], (unsigned)(bq * 4194304.f + 0.5f));
      }
  } else {
    float sum = 0.f;
#pragma unroll
    for (int c = 0; c < 2; ++c)
#pragma unroll
      for (int i = 0; i < 16; ++i) { float e = ex2(p[c][i]); p[c][i] = e; sum += e; }
    if (MODE == M_SEL) sum = lane_on ? sum : 0.f;
    st.l += sum;
    tile_sum = sum;
  }
  if (MODE != M_CMP1) {
#pragma unroll
    for (int c = 0; c < 2; ++c)
#pragma unroll
      for (int s2 = 0; s2 < 2; ++s2) {
        u32x4 pw; pw.x = pk2(p[c][8 * s2], p[c][8 * s2 + 1]); pw.y = pk2(p[c][8 * s2 + 2], p[c][8 * s2 + 3]);
        pw.z = pk2(p[c][8 * s2 + 4], p[c][8 * s2 + 5]); pw.w = pk2(p[c][8 * s2 + 6], p[c][8 * s2 + 7]);
        if (MODE == M_SEL) { if (!lane_on) { pw.x = 0u; pw.y = 0u; pw.z = 0u; pw.w = 0u; } }
        bf16x8 pf = __builtin_bit_cast(bf16x8, pw);
#pragma unroll
        for (int dt = 0; dt < 2; ++dt) {
          const char* vp = vl + (32 * dt + r) * 136 + (32 * c + 16 * s2 + 4 * h) * 2;
          s16x4 lo4 = *(const s16x4*)vp; s16x4 hi4 = *(const s16x4*)(vp + 16);
          bf16x8 vf = __builtin_shufflevector(lo4, hi4, 0, 1, 2, 3, 4, 5, 6, 7);
          st.o[dt] = MFMA32(vf, pf, st.o[dt]);
        }
      }
  }
  if (MODE != M_CMP2) {
    if (__any(tile_sum > RSUM)) {
      const float tot = xhalf_sum(tile_sum);
      const float dl = (tot > RSUM) ? __builtin_amdgcn_logf(tot) : 0.f;
      st.m += dl;
      const float nm = -st.m;
#pragma unroll
      for (int i = 0; i < 16; ++i) negm[i] = nm;
      const float f = ex2(-dl);
      st.l *= f;
      if (MODE != M_CMP1) {
#pragma unroll
        for (int i = 0; i < 16; ++i) { st.o[0][i] *= f; st.o[1][i] *= f; }
      }
    }
  }
}

template <int MODE>
DI bool tile_active(int T, int twmax, int qspan, const unsigned* selmask_q) {
  bool a;
  if (MODE == M_CMP1 || MODE == M_CMP2) a = (16 * (64 * T) + 31 <= twmax);
  else a = (64 * T <= twmax);
  if (MODE == M_WIN) a = a && (64 * T + 63 >= twmax - qspan - 511);
  if (MODE == M_SEL) { if (a) a = __any((int)((selmask_q[T >> 5] >> (T & 31)) & 1u)) != 0; }
  return a;
}

template <int MODE>
DI void run_tiles(AttnState& st, const bf16x8* qf, const TileSrc& src, int T0, int T1, int tq, int twmax_, int qspan, int koffb,
                  const unsigned* selmask_q, float m_fin, float inv_l, unsigned* imp_q, char* lds, int tid, int r, int h) {
  constexpr bool HASV = (MODE != M_CMP1), HASC = (MODE == M_FOX);
  const int twmax = __builtin_amdgcn_readfirstlane(twmax_);
  const float m0 = (MODE == M_CMP2) ? m_fin : MREF0;
  u32x4 rk[2], rv[2]; f32x4 rc;
  st.m = m0;
  f32x16 negm;
#pragma unroll
  for (int i = 0; i < 16; ++i) negm[i] = -m0;
  __syncthreads();
  if (T0 < T1) { tile_gload<HASV, HASC>(src, T0, rk, rv, rc, tid); tile_sstore<HASV, HASC>(lds, rk, rv, rc, tid); }
  if (T0 + 1 < T1) tile_gload<HASV, HASC>(src, T0 + 1, rk, rv, rc, tid);
  int slot = 0;
  for (int T = T0; T < T1; ++T) {
    const char* buf = lds + slot * ATT_BUF;
    slot = (slot == 2) ? 0 : slot + 1;
    if (T + 1 < T1) tile_sstore<HASV, HASC>(lds + slot * ATT_BUF, rk, rv, rc, tid);
    if (T + 2 < T1) tile_gload<HASV, HASC>(src, T + 2, rk, rv, rc, tid);
    __syncthreads();
    if (tile_active<MODE>(T, twmax, qspan, selmask_q)) {
      unsigned selbit = 0;
      if (MODE == M_SEL) selbit = (selmask_q[T >> 5] >> (T & 31)) & 1u;
      f32x16 p[2];
      qk_part<MODE>(p, qf, buf, koffb, negm, r, h);
      sp_part<MODE>(st, p, negm, buf, T, tq, selbit, inv_l, imp_q, r, h);
    }
  }
}

DI void st_init(AttnState& st) {
#pragma unroll
  for (int i = 0; i < 16; ++i) { st.o[0][i] = 0.f; st.o[1][i] = 0.f; }
  st.m = MREF0; st.l = 0.f;
}
DI float st_invl(const AttnState& st) { float lt = xhalf_sum(st.l); return lt > 0.f ? 1.f / lt : 0.f; }

DI void mix_out(const Params& P, size_t token, int cb, const f32x16 (&o)[2]) {
  const bf16_t* G = (const bf16_t*)(P.ws + OFF_G) + token * 1024 + cb;
  bf16_t* M = (bf16_t*)(P.ws + OFF_MIX) + token * 1024 + cb;
  u32x2 gv[2][4];
#pragma unroll
  for (int dt = 0; dt < 2; ++dt)
#pragma unroll
    for (int g = 0; g < 4; ++g) gv[dt][g] = *(const u32x2*)(G + 32 * dt + 8 * g);
#pragma unroll
  for (int dt = 0; dt < 2; ++dt)
#pragma unroll
    for (int g = 0; g < 4; ++g) { const u32x2 q = gv[dt][g];
      u32x2 w; w.x = pk2(o[dt][4 * g] * __uint_as_float(q.x << 16), o[dt][4 * g + 1] * __uint_as_float(q.x & 0xffff0000u));
      w.y = pk2(o[dt][4 * g + 2] * __uint_as_float(q.y << 16), o[dt][4 * g + 3] * __uint_as_float(q.y & 0xffff0000u));
      *(u32x2*)(M + 32 * dt + 8 * g) = w; }
}
DI void store_mix(const Params& P, size_t token, int col, float a, float b, float c, float d) {
  const bf16_t* G = (const bf16_t*)(P.ws + OFF_G) + token * 1024 + col;
  u32x2 gv = *(const u32x2*)G;
  float g0 = __uint_as_float(gv.x << 16), g1 = __uint_as_float(gv.x & 0xffff0000u), g2 = __uint_as_float(gv.y << 16), g3 = __uint_as_float(gv.y & 0xffff0000u);
  u32x2 w; w.x = pk2(a * g0, b * g1); w.y = pk2(c * g2, d * g3);
  *(u32x2*)((bf16_t*)(P.ws + OFF_MIX) + token * 1024 + col) = w;
}

DI void fox_unit(const Params& P, int bh, int qt, char* lds) {
  const int tid = get_tid(), lane = tid & 63, wave = tid >> 6, r = lane & 31, h = lane >> 5;
  const int t0 = 128 * qt, tq = t0 + 32 * wave + r, twmax = t0 + 32 * wave + 31;
  const bf16_t* Q = (const bf16_t*)(P.ws + OFF_QF) + (size_t)bh * SEQ * 64;
  TileSrc src; src.K = (const bf16_t*)(P.ws + OFF_KF) + (size_t)bh * SEQ * 64; src.Vt = (const bf16_t*)(P.ws + OFF_VFT) + (size_t)bh * SEQ * 64; src.vstride = SEQ;
  src.C = (const float*)(P.ws + OFF_CUM) + (size_t)bh * SEQ;
  bf16x8 qf[4];
#pragma unroll
  for (int d0 = 0; d0 < 4; ++d0) qf[d0] = *(const bf16x8*)(Q + (size_t)tq * 64 + 16 * d0 + 8 * h);
  AttnState st; st_init(st);
  run_tiles<M_FOX>(st, qf, src, 0, 2 * qt + 2, tq, twmax, 31, 0, nullptr, 0.f, 0.f, nullptr, lds, tid, r, h);
  const float inv = st_invl(st);
  const size_t token = (size_t)(bh >> 2) * SEQ + tq; const int hd = bh & 3;
#pragma unroll
  for (int i = 0; i < 16; ++i) { st.o[0][i] *= inv; st.o[1][i] *= inv; }
  mix_out(P, token, hd * 64 + 4 * h, st.o);
}

DI void diff_unit(const Params& P, int l, int bh, int qt, char* lds) {
  const int tid = get_tid(), lane = tid & 63, wave = tid >> 6, r = lane & 31, h = lane >> 5;
  const int comp = wave & 1, qs = wave >> 1;
  const int t0 = 64 * qt, tq = t0 + 32 * qs + r, twmax = t0 + 32 * qs + 31;
  const bf16_t* Q = (const bf16_t*)(P.ws + OFF_QD) + (size_t)bh * SEQ * 64;
  TileSrc src; src.K = (const bf16_t*)(P.ws + OFF_KD) + (size_t)bh * SEQ * 64; src.Vt = (const bf16_t*)(P.ws + OFF_VDT) + (size_t)bh * SEQ * 64; src.vstride = SEQ; src.C = nullptr;
  bf16x8 qf[2];
#pragma unroll
  for (int d0 = 0; d0 < 2; ++d0) qf[d0] = *(const bf16x8*)(Q + (size_t)tq * 64 + comp * 32 + 16 * d0 + 8 * h);
  AttnState st; st_init(st);
  run_tiles<M_DIFF>(st, qf, src, 0, qt + 1, tq, twmax, 31, comp * 64, nullptr, 0.f, 0.f, nullptr, lds, tid, r, h);
  const float inv = st_invl(st);
  float* exch = (float*)(lds + LDS_IMP);
  __syncthreads();
  if (comp == 1) {
#pragma unroll
    for (int dt = 0; dt < 2; ++dt)
#pragma unroll
      for (int i = 0; i < 16; ++i) exch[(qs * 64 + 32 * dt + crow(i, h)) * 32 + r] = st.o[dt][i] * inv;
  }
  __syncthreads();
  if (comp == 0) {
    const float lam = ((const float*)(P.ws + OFF_LAM))[l], lam_init = ((const float*)(P.ws + OFF_LAM))[2 + l];
    float ss = 0.f;
#pragma unroll
    for (int dt = 0; dt < 2; ++dt)
#pragma unroll
      for (int i = 0; i < 16; ++i) { float a = st.o[dt][i] * inv - lam * exch[(qs * 64 + 32 * dt + crow(i, h)) * 32 + r]; st.o[dt][i] = a; ss += a * a; }
    ss = xhalf_sum(ss);
    const float rms = rsqrtf(ss * (1.f / 64.f) + 1e-5f) * (1.f - lam_init);
    const size_t token = (size_t)(bh >> 2) * SEQ + tq; const int hd = bh & 3;
    const float* sg = P.subln_g + l * 64;
#pragma unroll
    for (int dt = 0; dt < 2; ++dt)
#pragma unroll
      for (int g = 0; g < 4; ++g) { int d = 32 * dt + 8 * g + 4 * h; f32x4 gg = *(const f32x4*)(sg + d);
#pragma unroll
        for (int e = 0; e < 4; ++e) st.o[dt][4 * g + e] *= rms * gg[e]; }
    mix_out(P, token, 768 + hd * 64 + 4 * h, st.o);
  }
}

DI void nsa_unit(const Params& P, int bg, int qt, char* lds) {
  const int tid = get_tid(), lane = tid & 63, wave = tid >> 6, r = lane & 31, h = lane >> 5;
  const int b = bg >> 1, g2 = bg & 1, head8 = g2 * 4 + (r & 3);
  const int t0 = 32 * qt, ql = 8 * wave + (r >> 2), tq = t0 + ql, tmax = t0 + 31, twmax = t0 + 8 * wave + 7;
  const bf16_t* Q = (const bf16_t*)(P.ws + OFF_QN) + (size_t)(b * 8 + head8) * SEQ * 64;
  bf16x8 qf[4];
#pragma unroll
  for (int d0 = 0; d0 < 4; ++d0) qf[d0] = *(const bf16x8*)(Q + (size_t)tq * 64 + 16 * d0 + 8 * h);
  unsigned* imp = (unsigned*)(lds + LDS_IMP);
  unsigned* selm = (unsigned*)(lds + LDS_SEL);
#pragma unroll
  for (int k = 0; k < 16; ++k) imp[tid + 256 * k] = 0u;
  const float* gates = (const float*)(P.ws + OFF_GATES) + ((size_t)b * SEQ + tq) * 24 + 3 * head8;
  const float gc = gates[0], gs = gates[1], gw = gates[2];
  unsigned* stash = (unsigned*)(lds + LDS_IMP) + wave * 16 * 64 + lane;
  TileSrc src; src.K = (const bf16_t*)(P.ws + OFF_KC) + (size_t)bg * 512 * 64; src.Vt = (const bf16_t*)(P.ws + OFF_VCC) + (size_t)bg * 64 * 512; src.vstride = 512; src.C = nullptr;
  int nvis = (t0 >> 4) + 1; if (nvis > 511) nvis = 511;
  const int ntc = (nvis + 63) >> 6;
  AttnState st; st_init(st);
  run_tiles<M_CMP1>(st, qf, src, 0, ntc, tq, twmax, 7, 0, nullptr, 0.f, 0.f, nullptr, lds, tid, r, h);
  {
    const float m_fin = st.m, inv_l = st_invl(st);
    st_init(st);
    run_tiles<M_CMP2>(st, qf, src, 0, ntc, tq, twmax, 7, 0, nullptr, m_fin, inv_l, imp + ql, lds, tid, r, h);
  }
  __syncthreads();
  {
    const int q = tid >> 3, jg = tid & 7; const int t = t0 + q, cur = t >> 6;
    unsigned key[16];
#pragma unroll
    for (int e = 0; e < 16; ++e) { int j = 16 * jg + e; unsigned v = imp[j * 32 + q];
      bool valid = j <= cur, forced = (j == 0) || (j == cur) || (j == cur - 1);
      key[e] = !valid ? 0u : (forced ? (0xFFFFFF80u | (unsigned)(127 - j)) : ((v << 7) | (unsigned)(127 - j))); }
    unsigned sel = 0;
    for (int round = 0; round < 16; ++round) {
      unsigned m = key[0];
#pragma unroll
      for (int e = 1; e < 16; ++e) m = m > key[e] ? m : key[e];
      unsigned o;
      o = __shfl_xor(m, 1); m = m > o ? m : o; o = __shfl_xor(m, 2); m = m > o ? m : o; o = __shfl_xor(m, 4); m = m > o ? m : o;
      if (m != 0u) {
#pragma unroll
        for (int e = 0; e < 16; ++e) if (key[e] == m) { sel |= 1u << e; key[e] = 0u; }
      }
    }
    ((unsigned short*)selm)[q * 8 + jg] = (unsigned short)sel;
  }
  __syncthreads();
#pragma unroll
  for (int i = 0; i < 8; ++i) { stash[i * 64] = pk2(gc * st.o[0][2 * i], gc * st.o[0][2 * i + 1]); stash[(8 + i) * 64] = pk2(gc * st.o[1][2 * i], gc * st.o[1][2 * i + 1]); }
  src.K = (const bf16_t*)(P.ws + OFF_KS) + (size_t)bg * SEQ * 64; src.Vt = (const bf16_t*)(P.ws + OFF_VST) + (size_t)bg * SEQ * 64; src.vstride = SEQ;
  st_init(st);
  run_tiles<M_SEL>(st, qf, src, 0, (tmax >> 6) + 1, tq, twmax, 7, 0, selm + ql * 4, 0.f, 0.f, nullptr, lds, tid, r, h);
  { const float inv = st_invl(st) * gs;
#pragma unroll
    for (int i = 0; i < 8; ++i) { unsigned a = stash[i * 64], bq = stash[(8 + i) * 64];
      stash[i * 64] = pk2(__uint_as_float(a << 16) + inv * st.o[0][2 * i], __uint_as_float(a & 0xffff0000u) + inv * st.o[0][2 * i + 1]);
      stash[(8 + i) * 64] = pk2(__uint_as_float(bq << 16) + inv * st.o[1][2 * i], __uint_as_float(bq & 0xffff0000u) + inv * st.o[1][2 * i + 1]); } }
  src.K = (const bf16_t*)(P.ws + OFF_KW) + (size_t)bg * SEQ * 64; src.Vt = (const bf16_t*)(P.ws + OFF_VWT) + (size_t)bg * SEQ * 64;
  st_init(st);
  { int lo_t = t0 - 511; int T0 = lo_t > 0 ? (lo_t >> 6) : 0;
    run_tiles<M_WIN>(st, qf, src, T0, (tmax >> 6) + 1, tq, twmax, 7, 0, nullptr, 0.f, 0.f, nullptr, lds, tid, r, h); }
  { const float inv = st_invl(st) * gw;
#pragma unroll
    for (int i = 0; i < 8; ++i) { unsigned a = stash[i * 64], bq = stash[(8 + i) * 64];
      st.o[0][2 * i] = __uint_as_float(a << 16) + inv * st.o[0][2 * i]; st.o[0][2 * i + 1] = __uint_as_float(a & 0xffff0000u) + inv * st.o[0][2 * i + 1];
      st.o[1][2 * i] = __uint_as_float(bq << 16) + inv * st.o[1][2 * i]; st.o[1][2 * i + 1] = __uint_as_float(bq & 0xffff0000u) + inv * st.o[1][2 * i + 1]; } }
  const size_t token = (size_t)b * SEQ + tq;
  mix_out(P, token, 256 + head8 * 64 + 4 * h, st.o);
}

DI void compress_tile(const Params& P, int l, int id, char* lds) {
  const int tid = get_tid(), lane = tid & 63, wave = tid >> 6, wm = wave >> 1, wn = wave & 1, r = lane & 31, h = lane >> 5;
  const int kv = id >> 4, bg = (id >> 2) & 3, mt = id & 3;
  const bf16_t* tok = (const bf16_t*)(P.ws + (kv ? OFF_VCT : OFF_KCT)) + (size_t)bg * SEQ * 64;
  const bf16_t* Bt = (const bf16_t*)(P.ws + OFF_W1T) + ((size_t)l * 2 + kv) * 128 * 2048;
  f32x16 acc[2][2];
  int rowmax = 510 - 128 * mt; if (rowmax > 127) rowmax = 127;
  gemm_mainloop(tok + (size_t)mt * 128 * 1024, 1024, rowmax, Bt, 2048, 2048, lds, acc);
  __syncthreads();
  float* H = (float*)lds;
  const float* bias = (const float*)(P.ws + OFF_B1) + (l * 2 + kv) * 128;
#pragma unroll
  for (int a = 0; a < 2; ++a)
#pragma unroll
    for (int bb = 0; bb < 2; ++bb) { int col = 64 * wn + 32 * bb + r; float bv = bias[col];
#pragma unroll
      for (int i = 0; i < 16; ++i) { int row = 64 * wm + 32 * a + crow(i, h); H[row * 129 + col] = silu(acc[a][bb][i] + bv); } }
  __syncthreads();
  const float* w2 = (kv ? P.w2_v : P.w2_k) + (size_t)l * 128 * 64;
  const int c = tid & 63, rg = tid >> 6;
  float o[32];
#pragma unroll
  for (int i = 0; i < 32; ++i) o[i] = 0.f;
  for (int j = 0; j < 128; ++j) { float w = w2[j * 64 + c];
#pragma unroll
    for (int i = 0; i < 32; ++i) o[i] += H[(rg * 32 + i) * 129 + j] * w; }
  if (kv == 0) { bf16_t* dst = (bf16_t*)(P.ws + OFF_KC) + (size_t)bg * 512 * 64;
#pragma unroll
    for (int i = 0; i < 32; ++i) { int n = 128 * mt + rg * 32 + i; dst[(size_t)n * 64 + c] = f2bf(o[i]); } }
  else { bf16_t* dst = (bf16_t*)(P.ws + OFF_VCC) + (size_t)bg * 64 * 512;
#pragma unroll
    for (int i = 0; i < 32; ++i) { int n = 128 * mt + rg * 32 + i; dst[(size_t)c * 512 + n] = f2bf(o[i]); } }
  __syncthreads();
}

DI void cumsum_seq(const Params& P, int bh, char* lds) {
  const int tid = get_tid();
  const float* src = (const float*)(P.ws + OFF_LOGF) + (size_t)bh * SEQ + tid * 32;
  float* dst = (float*)(P.ws + OFF_CUM) + (size_t)bh * SEQ + tid * 32;
  float* tot = (float*)lds;
  f32x4 v[8]; float s = 0.f;
#pragma unroll
  for (int k = 0; k < 8; ++k) { v[k] = *(const f32x4*)(src + 4 * k);
#pragma unroll
    for (int e = 0; e < 4; ++e) { s += v[k][e]; v[k][e] = s; } }
  __syncthreads();
  tot[tid] = s;
  __syncthreads();
  float base = 0.f;
  for (int i = 0; i < tid; ++i) base += tot[i];
#pragma unroll
  for (int k = 0; k < 8; ++k) { f32x4 o;
#pragma unroll
    for (int e = 0; e < 4; ++e) o[e] = v[k][e] + base;
    *(f32x4*)(dst + 4 * k) = o; }
  __syncthreads();
}

DI int next_unit(unsigned* ctr, int* s_unit) {
  __syncthreads();
  if (get_tid() == 0) *s_unit = (int)atomicAdd(ctr, 1u);
  __syncthreads();
  return *s_unit;
}

DI void p23_phase(const Params& P, int l, char* lds, int* s_unit, int rep = 0) {
  unsigned* ctr = (unsigned*)(P.ws + OFF_CTR) + (l * 4 + 0 + 16 * rep);
  unsigned* done = (unsigned*)(P.ws + OFF_CTR) + (40 + l + 4 * rep);
  bool acquired = false;
  for (;;) {
    int u = next_unit(ctr, s_unit);
    if (u >= 40 + 1024 + 512 + 1024) break;
    if (u < 40) {
      if (u < 32) compress_tile(P, l, u, lds); else cumsum_seq(P, u - 32, lds);
      asm volatile("s_waitcnt vmcnt(0)" ::: "memory");
      __syncthreads();
      if (get_tid() == 0) { __builtin_amdgcn_fence(__ATOMIC_RELEASE, "agent"); asm volatile("s_waitcnt vmcnt(0)" ::: "memory");
        __hip_atomic_fetch_add(done, 1u, __ATOMIC_RELAXED, __HIP_MEMORY_SCOPE_AGENT); }
    } else if (u < 40 + 1024) { int v = u - 40; diff_unit(P, l, v & 7, 127 - (v >> 3), lds); }
    else {
      if (!acquired) {
        if (get_tid() == 0) {
          unsigned sp = 0;
          while (__hip_atomic_load(done, __ATOMIC_RELAXED, __HIP_MEMORY_SCOPE_AGENT) < 40u) { __builtin_amdgcn_s_sleep(4); if (++sp > (1u << 24)) break; }
          __builtin_amdgcn_fence(__ATOMIC_ACQUIRE, "agent"); asm volatile("s_waitcnt vmcnt(0)" ::: "memory");
        }
        __syncthreads();
        acquired = true;
      }
      const int w = u - (40 + 1024);
      if (w < 384) fox_unit(P, w & 7, 63 - (w >> 3), lds);
      else if (w < 384 + 1024) { int v = w - 384; nsa_unit(P, v & 3, 255 - (v >> 2), lds); }
      else { int v = w - (384 + 1024); fox_unit(P, v & 7, 15 - (v >> 3), lds); }
    }
  }
}

template <int KIND> DI void run_phase(const Params& P, int l, char* lds, int* s_unit, int rep = 0) {
  if constexpr (KIND == 0) p0_prologue(P);
  else if constexpr (KIND == 1) p1_inproj(P, l, lds);
  else if constexpr (KIND == 2) p23_phase(P, l, lds, s_unit, rep);
  else if constexpr (KIND == 3) { }
  else if constexpr (KIND == 4) p4_outproj(P, l, lds);
  else p5_ln(P, l);
}
template <int KIND> __global__ void __launch_bounds__(NTHREADS, 2) phase_kernel(Params P, int l) {
  __shared__ __attribute__((aligned(16))) char lds[LDS_BYTES + LDS_CTL];
  run_phase<KIND>(P, l, lds, (int*)(lds + LDS_BYTES));
}
#if COOP
#define GSYNC() do { asm volatile("" ::: "memory"); cg::this_grid().sync(); asm volatile("" ::: "memory"); } while (0)
#define XB_TMO      128
#define XB_XCNT(j)  (256  + 64 * (j))
#define XB_XSUB(j)  (1280 + 64 * (j))
#define XB_XGEN(j)  (2304 + 64 * (j))
#define XB_TOP      3328
#define XB_TOPGEN   3392
#define XCD_BAR_WORDS 3456
#define XB_SPIN_CAP (1u << 22)
#define LAS __attribute__((address_space(3)))
DI unsigned xb_ld(unsigned* p) { return __hip_atomic_load(p, __ATOMIC_RELAXED, __HIP_MEMORY_SCOPE_AGENT); }
DI unsigned xb_add(unsigned* p, unsigned v) { return __hip_atomic_fetch_add(p, v, __ATOMIC_RELAXED, __HIP_MEMORY_SCOPE_AGENT); }
DI unsigned xb_xcc_id() { return (unsigned)__builtin_amdgcn_s_getreg((3 << 11) | 20) & 0xFu; }
#define XB_SPIN(cond, bar) do { unsigned _sp = 0; while (cond) { __builtin_amdgcn_s_sleep(1); \
    if ((++_sp & 255u) == 0u) { if (xb_ld(&(bar)[XB_TMO])) break; if (_sp > XB_SPIN_CAP) { atomicAdd(&(bar)[XB_TMO], 1u); break; } } } } while (0)
struct XcdBarrier { unsigned* bar; unsigned x; volatile LAS unsigned* st; };
DI XcdBarrier xcd_barrier_post(unsigned* bar, volatile LAS unsigned* st) {
  XcdBarrier b; b.bar = bar; b.x = xb_xcc_id(); b.st = st;
  if (threadIdx.x == 0) (void)xb_add(&bar[XB_XCNT(b.x)], 1u);
  return b;
}
DI void xcd_barrier_complete(unsigned* bar, unsigned x, unsigned& nloc, unsigned& nx) {
  const unsigned G = gridDim.x * gridDim.y * gridDim.z;
  unsigned sum, cnt, mine, sp = 0u;
  for (;;) {
    sum = 0u; cnt = 0u; mine = 0u;
#pragma unroll
    for (unsigned j = 0; j < 16; ++j) { const unsigned c = xb_ld(&bar[XB_XCNT(j)]); sum += c; cnt += (c > 0u) ? 1u : 0u; mine = (j == x) ? c : mine; }
    if (sum == G) break;
    __builtin_amdgcn_s_sleep(1);
    if ((++sp & 255u) == 0u) { if (xb_ld(&bar[XB_TMO])) break; if (sp > XB_SPIN_CAP) { atomicAdd(&bar[XB_TMO], 1u); break; } }
  }
  nloc = mine > 0u ? mine : 1u; nx = cnt > 0u ? cnt : 1u;
}
DI void xcd_barrier(const XcdBarrier& b) {
  asm volatile("s_waitcnt vmcnt(0)" ::: "memory");
  __syncthreads();
  if (threadIdx.x == 0) {
    unsigned* bar = b.bar;
    __builtin_amdgcn_s_waitcnt(0);
    unsigned nloc = b.st[0], nx = b.st[1];
    if (nloc == 0u) { xcd_barrier_complete(bar, b.x, nloc, nx); b.st[0] = nloc; b.st[1] = nx; }
    const unsigned old = xb_add(&bar[XB_XSUB(b.x)], 1u);
    const unsigned gen = old / nloc;
    if (old + 1u == (gen + 1u) * nloc) {
      __builtin_amdgcn_fence(__ATOMIC_RELEASE, "agent");
      asm volatile("s_waitcnt vmcnt(0)" ::: "memory");
      const unsigned og = xb_add(&bar[XB_TOP], 1u);
      const unsigned tg = og / nx;
      if (og + 1u == (tg + 1u) * nx) xb_add(&bar[XB_TOPGEN], 1u);
      else XB_SPIN(xb_ld(&bar[XB_TOPGEN]) == tg, bar);
      __builtin_amdgcn_fence(__ATOMIC_ACQUIRE, "agent");
      xb_add(&bar[XB_XGEN(b.x)], 1u);
      asm volatile("s_waitcnt vmcnt(0)" ::: "memory");
    } else {
      XB_SPIN(xb_ld(&bar[XB_XGEN(b.x)]) == gen, bar);
      __builtin_amdgcn_fence(__ATOMIC_ACQUIRE, "agent");
      asm volatile("s_waitcnt vmcnt(0)" ::: "memory");
    }
  }
  __syncthreads();
}
#ifndef CG_ALL
#define BSYNC() do { asm volatile("" ::: "memory"); xcd_barrier(xb); asm volatile("" ::: "memory"); } while (0)
#else
#define BSYNC() GSYNC()
#endif
__global__ void __launch_bounds__(NTHREADS, 2) fwd_kernel(Params P) {
  __shared__ __attribute__((aligned(16))) char lds[LDS_BYTES + LDS_CTL];
  int* const s_unit_p = (int*)(lds + LDS_BYTES);
  if (threadIdx.x == 0) *(uint4*)(lds + LDS_BYTES + 16) = make_uint4(0u, 0u, 0u, 0u);
  __syncthreads();
  const XcdBarrier xb = xcd_barrier_post((unsigned*)(P.ws + OFF_BAR), (volatile LAS unsigned*)(lds + LDS_BYTES + 16));
  if (P.pad_ == 0x5eed) GSYNC();
  run_phase<0>(P, 0, lds, s_unit_p); BSYNC();
  for (int l = 0; l < DEPTH; ++l) {
    run_phase<1>(P, l, lds, s_unit_p); BSYNC();
#if REPEAT == 1
    run_phase<1>(P, l, lds, s_unit_p, 1); BSYNC();
#endif
    run_phase<2>(P, l, lds, s_unit_p); BSYNC();
    run_phase<4>(P, l, lds, s_unit_p); BSYNC();
    run_phase<5>(P, l, lds, s_unit_p); if (l + 1 < DEPTH) BSYNC();
  }
}
#endif

extern "C" void kernel_launch(void* const* d_in, const int* in_sizes, int n_in, void* d_out, int out_size, void* d_ws, size_t ws_size, hipStream_t stream) {
  static int grid_blocks = 0;
  if (!grid_blocks) {
    int dev = 0, cus = 0, per_cu = 0;
    (void)hipGetDevice(&dev);
    (void)hipDeviceGetAttribute(&cus, hipDeviceAttributeMultiprocessorCount, dev);
#if COOP
    (void)hipOccupancyMaxActiveBlocksPerMultiprocessor(&per_cu, fwd_kernel, NTHREADS, 0);
#else
    per_cu = 2;
#endif
    if (per_cu < 1) per_cu = 1;
    if (per_cu > 2) per_cu = 2;
    if (cus < 1) cus = 256;
    grid_blocks = cus * per_cu;
  }
  if (n_in != 17 || ws_size < WS_NEED) { fprintf(stderr, "kernel_launch: unexpected inputs (%d) or workspace (%zu)\n", n_in, ws_size); return; }
  Params p{};
  p.x = (const float*)d_in[0]; p.w_in = (const float*)d_in[1]; p.b_fox_f = (const float*)d_in[2]; p.pos_k = (const float*)d_in[3]; p.pos_v = (const float*)d_in[4];
  p.w1_k = (const float*)d_in[5]; p.w2_k = (const float*)d_in[6]; p.w1_v = (const float*)d_in[7]; p.w2_v = (const float*)d_in[8];
  p.lq1 = (const float*)d_in[9]; p.lk1 = (const float*)d_in[10]; p.lq2 = (const float*)d_in[11]; p.lk2 = (const float*)d_in[12];
  p.subln_g = (const float*)d_in[13]; p.w_out = (const float*)d_in[14]; p.ln_g = (const float*)d_in[15]; p.ln_b = (const float*)d_in[16];
  p.out = (float*)d_out; p.ws = (char*)d_ws;
  (void)hipMemsetAsync((char*)d_ws + OFF_CTR, 0, 4096, stream);
  (void)hipMemsetAsync((char*)d_ws + OFF_BAR, 0, CTL_ZERO_BYTES - OFF_BAR, stream);
#if COOP
  void* args[] = {&p};
  hipError_t e = hipLaunchCooperativeKernel((void*)fwd_kernel, dim3(grid_blocks), dim3(NTHREADS), args, 0, stream);
  if (e != hipSuccess) fprintf(stderr, "cooperative launch failed: %s (grid %d)\n", hipGetErrorString(e), grid_blocks);
#else
  const dim3 g(grid_blocks), b(NTHREADS);
  hipLaunchKernelGGL(phase_kernel<0>, g, b, 0, stream, p, 0);
  for (int l = 0; l < DEPTH; ++l) {
    hipLaunchKernelGGL(phase_kernel<1>, g, b, 0, stream, p, l);
    hipLaunchKernelGGL(phase_kernel<2>, g, b, 0, stream, p, l);
    hipLaunchKernelGGL(phase_kernel<4>, g, b, 0, stream, p, l);
    hipLaunchKernelGGL(phase_kernel<5>, g, b, 0, stream, p, l);
  }
#endif
}
```
